# Optimizing an MI355X kernel written in HIP

```python
import math
import jax
import jax.numpy as jnp
from jax import lax
import numpy as np

D_MODEL = 1024
BATCH = 16
SEQ = 4096
DEPTH = 2

GRID_W = 64
CTX_LEN = 256
QBLK = 128
EPS = 1e-6
ROPE_THETA = 10000.0

DA_HEADS = 4
DA_HD = 32
DA_W = DA_HEADS * 2 * DA_HD
GA_HEADS = 4
GA_KV = 2
GA_HD = 64
GA_W = GA_HEADS * GA_HD
GM_GROUPS = 4
GM_GW = 64
GM_CHUNK = 128
GM_W = GM_GROUPS * GM_GW
GD_HEADS = 4
GD_HD = 64
GD_W = GD_HEADS * GD_HD
GD_CONV = 5
GD_CHUNK = 64
N_BRANCH = 4
BR_W = 256
N_EXPERTS = 32
TOP_K = 4
D_FF = D_MODEL
SWIGLU_ALPHA = 1.702
SWIGLU_LIMIT = 7.0
EXPERT_BLK = 256

IN_SPLITS = (DA_W, DA_W, DA_W, GA_W, GA_KV * GA_HD, GA_KV * GA_HD, GM_W, GM_W, 3 * GD_W, GD_W, 2 * GD_HEADS, 2 * GD_HEADS, N_BRANCH * D_MODEL)
IN_COLS = sum(IN_SPLITS)

kernel_name = 'hybrid_diffusion_prefix_trunk'


def _rms(x, g):
    xf = x.astype(jnp.float32)
    y = xf * lax.rsqrt(jnp.mean(xf * xf, axis=-1, keepdims=True) + EPS)
    return (y * g.astype(jnp.float32)).astype(x.dtype)


def _l2n(x):
    xf = x.astype(jnp.float32)
    return xf * lax.rsqrt(jnp.sum(xf * xf, axis=-1, keepdims=True) + EPS)


def _modulate(h, shift, scale):
    return h * (1 + scale) + shift


def _adaln(cvec, w_mod, b_mod):
    m = (jax.nn.silu(cvec) @ w_mod + b_mod)[:, None, :]
    return jnp.split(m, 6, axis=-1)


def _heads(t, n, d):
    b, l, _ = t.shape
    return t.reshape(b, l, n, d).transpose(0, 2, 1, 3)


def _unheads(t):
    b, n, l, d = t.shape
    return t.transpose(0, 2, 1, 3).reshape(b, l, n * d)


def _axial_rope_tables(n_tok, head_dim):
    rows = n_tok // GRID_W
    row = jnp.broadcast_to(jnp.arange(rows)[:, None], (rows, GRID_W)).reshape(-1).astype(jnp.float32)
    col = jnp.broadcast_to(jnp.arange(GRID_W)[None, :], (rows, GRID_W)).reshape(-1).astype(jnp.float32)
    quarter = head_dim // 4
    inv = ROPE_THETA ** (-jnp.arange(quarter, dtype=jnp.float32) / quarter)
    ar = row[:, None] * inv
    ac = col[:, None] * inv
    return (jnp.cos(ar), jnp.sin(ar), jnp.cos(ac), jnp.sin(ac))


def _rope1(x, cos, sin):
    x1, x2 = jnp.split(x, 2, axis=-1)
    return jnp.concatenate([x1 * cos - x2 * sin, x2 * cos + x1 * sin], axis=-1)


def _axial_rope(x, tabs):
    cr, sr, cc, sc = tabs
    xr, xcol = jnp.split(x, 2, axis=-1)
    return jnp.concatenate([_rope1(xr, cr, sr), _rope1(xcol, cc, sc)], axis=-1).astype(x.dtype)


def _map_query_blocks(fn, q):
    b, n, l, d = q.shape
    nb = l // QBLK
    qb = jnp.moveaxis(q.reshape(b, n, nb, QBLK, d), 2, 0)
    o = jnp.moveaxis(lax.map(fn, qb), 0, 2)
    return o.reshape(o.shape[0], o.shape[1], l, o.shape[-1])


def _diff_attention(q, k, v, qc, kc, vc, q_g, k_g, lq1, lk1, lq2, lk2, sub_g, lam_init, rope, need_ctx):
    f32 = jnp.float32
    nsub = 2 * DA_HEADS
    q = _axial_rope(_rms(_heads(q, nsub, DA_HD), q_g), rope)
    k = _axial_rope(_rms(_heads(k, nsub, DA_HD), k_g), rope)
    v = _heads(v, DA_HEADS, 2 * DA_HD)
    qc = _rms(_heads(qc, nsub, DA_HD), q_g)
    kc = _rms(_heads(kc, nsub, DA_HD), k_g)
    vc = _heads(vc, DA_HEADS, 2 * DA_HD)
    lam = (jnp.exp(jnp.sum(lq1.astype(f32) * lk1.astype(f32)))
           - jnp.exp(jnp.sum(lq2.astype(f32) * lk2.astype(f32))) + lam_init)
    scale = DA_HD ** -0.5

    def attend(qb, kk, vv):
        s = jnp.einsum('bhqd,bhkd->bhqk', qb, kk).astype(f32) * scale
        p = jax.nn.softmax(s, axis=-1)
        b, _, lq, lk = p.shape
        p = p.reshape(b, DA_HEADS, 2, lq, lk)
        a = (p[:, :, 0] - lam * p[:, :, 1]).astype(vv.dtype)
        return jnp.einsum('bhqk,bhkd->bhqd', a, vv)

    k_all = jnp.concatenate([k, kc], axis=2)
    v_all = jnp.concatenate([v, vc], axis=2)
    o = _map_query_blocks(lambda qb: attend(qb, k_all, v_all), q)
    finish = lambda t: _unheads(_rms(t, sub_g) * (1.0 - lam_init))
    return finish(o), (finish(attend(qc, kc, vc)) if need_ctx else None)


def _gqa(q, k, v, qc, kc, vc, q_g, k_g, rope, need_ctx):
    f32 = jnp.float32
    grp = GA_HEADS // GA_KV
    q = _axial_rope(_rms(_heads(q, GA_HEADS, GA_HD), q_g), rope)
    k = _axial_rope(_rms(_heads(k, GA_KV, GA_HD), k_g), rope)
    v = _heads(v, GA_KV, GA_HD)
    qc = _rms(_heads(qc, GA_HEADS, GA_HD), q_g)
    kc = _rms(_heads(kc, GA_KV, GA_HD), k_g)
    vc = _heads(vc, GA_KV, GA_HD)
    scale = GA_HD ** -0.5

    def attend(qb, kk, vv):
        b, _, lq, d = qb.shape
        qg = qb.reshape(b, GA_KV, grp, lq, d)
        s = jnp.einsum('bkgqd,bksd->bkgqs', qg, kk).astype(f32) * scale
        p = jax.nn.softmax(s, axis=-1).astype(vv.dtype)
        return jnp.einsum('bkgqs,bksd->bkgqd', p, vv).reshape(b, GA_HEADS, lq, d)

    k_all = jnp.concatenate([k, kc], axis=2)
    v_all = jnp.concatenate([v, vc], axis=2)
    o = _map_query_blocks(lambda qb: attend(qb, k_all, v_all), q)
    return _unheads(o), (_unheads(attend(qc, kc, vc)) if need_ctx else None)


def _gmlp(u, v, v_g, w_s, b_s):
    b, l, _ = v.shape
    u = jax.nn.gelu(u, approximate=False)
    v = _rms(jax.nn.gelu(v, approximate=False), v_g)
    vr = v.reshape(b, l // GM_CHUNK, GM_CHUNK, GM_GROUPS, GM_GW)
    mixed = jnp.einsum('gpq,bnqgc->bnpgc', w_s, vr) + b_s.T[None, None, :, :, None]
    return u * mixed.reshape(b, l, GM_W)


def _short_conv(x, w):
    y = lax.conv_general_dilated(x, w[:, None, :], window_strides=(1,),
                                 padding=[(GD_CONV // 2, GD_CONV // 2)],
                                 dimension_numbers=('NWC', 'WIO', 'NWC'),
                                 feature_group_count=x.shape[-1])
    return jax.nn.silu(y)


def _gdn_prep(qkv, a, bb, conv_w, a_log, dt_bias):
    f32 = jnp.float32
    b, l, _ = qkv.shape
    qkv = _short_conv(qkv, conv_w).astype(f32)
    q, k, v = jnp.split(qkv, 3, axis=-1)
    q = (_l2n(q.reshape(b, l, GD_HEADS, GD_HD)) * GD_HD ** -0.5).transpose(0, 2, 1, 3)
    k = _l2n(k.reshape(b, l, GD_HEADS, GD_HD)).transpose(0, 2, 1, 3)
    v = v.reshape(b, l, GD_HEADS, GD_HD).transpose(0, 2, 1, 3)
    a = a.astype(f32).reshape(b, l, 2, GD_HEADS)
    g = -jnp.exp(a_log.astype(f32)) * jax.nn.softplus(a + dt_bias.astype(f32))
    beta = jax.nn.sigmoid(bb.astype(f32).reshape(b, l, 2, GD_HEADS))
    return q, k, v, g.transpose(2, 0, 3, 1), beta.transpose(2, 0, 3, 1)


def _gated_delta_chunked(q, k, v, g, beta, s0):
    f32 = jnp.float32
    b, h, l, d = q.shape
    n, cs = l // GD_CHUNK, GD_CHUNK
    rs = lambda t: t.reshape((b, h, n, cs) + t.shape[3:])
    q, k, v, g, beta = rs(q), rs(k), rs(v), rs(g), rs(beta)
    gc = jnp.cumsum(g, axis=-1)
    incl = jnp.tril(jnp.ones((cs, cs), dtype=bool))
    strict = jnp.tril(jnp.ones((cs, cs), dtype=bool), -1)
    diff = gc[..., :, None] - gc[..., None, :]
    decay = jnp.where(incl, jnp.exp(jnp.where(incl, diff, 0.0)), 0.0)
    kk = jnp.einsum('bhnid,bhnjd->bhnij', k, k)
    amat = jnp.where(strict, beta[..., :, None] * kk * decay, 0.0) + jnp.eye(cs, dtype=f32)
    rhs = jnp.concatenate([v * beta[..., None], k * (beta * jnp.exp(gc))[..., None]], axis=-1)
    sol = lax.linalg.triangular_solve(amat, rhs, left_side=True, lower=True, unit_diagonal=True)
    u, w = sol[..., :d], sol[..., d:]
    qk = jnp.einsum('bhnid,bhnjd->bhnij', q, k) * decay
    qdec = q * jnp.exp(gc)[..., None]
    kdec = k * jnp.exp(gc[..., -1:] - gc)[..., None]
    glast = jnp.exp(gc[..., -1])
    xs = tuple(jnp.moveaxis(t, 2, 0) for t in (qdec, kdec, u, w, qk, glast))

    def step(s, inp):
        qd, kd, uu, ww, qkm, gl = inp
        vnew = uu - jnp.einsum('bhck,bhkv->bhcv', ww, s)
        o = jnp.einsum('bhck,bhkv->bhcv', qd, s) + jnp.einsum('bhij,bhjv->bhiv', qkm, vnew)
        s = s * gl[..., None, None] + jnp.einsum('bhck,bhcv->bhkv', kd, vnew)
        return s, o

    s_fin, o = lax.scan(step, s0, xs)
    return s_fin, jnp.moveaxis(o, 0, 2).reshape(b, h, l, d)


def _gdn(qkv, gate, a, bb, qkv_c, gate_c, a_c, bb_c, conv_w, a_log, dt_bias, out_g, need_ctx):
    ql, kl, vl, gl, bl = _gdn_prep(qkv, a, bb, conv_w, a_log, dt_bias)
    qc, kc, vc, gcx, bcx = _gdn_prep(qkv_c, a_c, bb_c, conv_w, a_log, dt_bias)
    bsz = qkv.shape[0]
    o_lat = 0.0
    o_ctx = 0.0
    for dirn in range(2):
        if dirn == 1:
            fl = lambda t: jnp.flip(t, axis=2)
        else:
            fl = lambda t: t
        s0 = jnp.zeros((bsz, GD_HEADS, GD_HD, GD_HD), jnp.float32)
        s_c, oc = _gated_delta_chunked(fl(qc), fl(kc), fl(vc), fl(gcx[dirn]), fl(bcx[dirn]), s0)
        _, ol = _gated_delta_chunked(fl(ql), fl(kl), fl(vl), fl(gl[dirn]), fl(bl[dirn]), s_c)
        o_lat = o_lat + fl(ol)
        o_ctx = o_ctx + fl(oc)

    def finish(o, gt):
        b, h, l, d = o.shape
        y = _rms(o.transpose(0, 2, 1, 3), out_g) * jax.nn.silu(gt.astype(jnp.float32).reshape(b, l, h, d))
        return y.reshape(b, l, h * d).astype(gt.dtype)

    return finish(o_lat, gate), (finish(o_ctx, gate_c) if need_ctx else None)


def _merge(outs, gate_pre, b_gate, w_br, w_o):
    b, l, _ = outs[0].shape
    o_cat = jnp.stack(outs, axis=2)
    br = jnp.einsum('blnw,nwd->blnd', o_cat, w_br)
    g = jax.nn.sigmoid(gate_pre.reshape(b, l, N_BRANCH, D_MODEL) + b_gate)
    return jnp.einsum('bld,de->ble', jnp.sum(g * br, axis=2), w_o)


def _mixer_sublayer(h, hc, w_in, b_gate, da_q_g, da_k_g, da_lam_q1, da_lam_k1, da_lam_q2, da_lam_k2, da_sub_g,
                    ga_q_g, ga_k_g, gm_v_g, gm_ws, gm_bs, gd_conv_w, gd_a_log, gd_dt_bias, gd_out_g,
                    w_br, w_o, lam_init, rope_da, rope_ga, need_ctx):
    cuts = np.cumsum(IN_SPLITS)[:-1].tolist()
    (aq, ak, av, gq, gk, gv, mu, mv, dqkv, dgate, da, db, gpre) = jnp.split(h @ w_in, cuts, axis=-1)
    (aqc, akc, avc, gqc, gkc, gvc, muc, mvc, dqkvc, dgatec, dac, dbc, gprec) = jnp.split(hc @ w_in, cuts, axis=-1)
    oa, oac = _diff_attention(aq, ak, av, aqc, akc, avc, da_q_g, da_k_g, da_lam_q1, da_lam_k1,
                              da_lam_q2, da_lam_k2, da_sub_g, lam_init, rope_da, need_ctx)
    ob, obc = _gqa(gq, gk, gv, gqc, gkc, gvc, ga_q_g, ga_k_g, rope_ga, need_ctx)
    om = _gmlp(mu, mv, gm_v_g, gm_ws, gm_bs)
    od, odc = _gdn(dqkv, dgate, da, db, dqkvc, dgatec, dac, dbc, gd_conv_w, gd_a_log, gd_dt_bias, gd_out_g, need_ctx)
    y = _merge([oa, ob, om, od], gpre, b_gate, w_br, w_o)
    if not need_ctx:
        return y, None
    omc = _gmlp(muc, mvc, gm_v_g, gm_ws, gm_bs)
    yc = _merge([oac, obc, omc, odc], gprec, b_gate, w_br, w_o)
    return y, yc


def _moe(tok, w_router, b_router, w_up, b_up, w_down, b_down):
    n_tok, d = tok.shape
    logits = (tok @ w_router + b_router).astype(jnp.float32)
    top_val, top_idx = lax.top_k(logits, TOP_K)
    gates = jax.nn.softmax(top_val, axis=-1)
    n_asg = n_tok * TOP_K
    e_flat = top_idx.reshape(-1)
    tok_flat = jnp.arange(n_asg, dtype=jnp.int32) // TOP_K
    g_flat = gates.reshape(-1)
    order = jnp.argsort(e_flat, stable=True)
    e_sorted = e_flat[order]
    counts = jnp.bincount(e_flat, length=N_EXPERTS)
    padded = (counts + EXPERT_BLK - 1) // EXPERT_BLK * EXPERT_BLK
    start = jnp.cumsum(counts) - counts
    pend = jnp.cumsum(padded)
    pstart = pend - padded
    dest = pstart[e_sorted] + (jnp.arange(n_asg) - start[e_sorted])
    n_blocks = (n_asg + N_EXPERTS * (EXPERT_BLK - 1)) // EXPERT_BLK + 1
    n_rows = n_blocks * EXPERT_BLK
    row_tok = jnp.full((n_rows,), n_tok, jnp.int32).at[dest].set(tok_flat[order])
    row_gate = jnp.zeros((n_rows,), tok.dtype).at[dest].set(g_flat[order].astype(tok.dtype))
    blk_exp = jnp.minimum(jnp.searchsorted(pend, jnp.arange(n_blocks) * EXPERT_BLK, side='right'), N_EXPERTS - 1)
    tok_pad = jnp.concatenate([tok, jnp.zeros((1, d), tok.dtype)], axis=0)
    xs = tok_pad[row_tok].reshape(n_blocks, EXPERT_BLK, d)

    def expert_block(args):
        xb, e = args
        z = xb @ w_up[e] + b_up[e]
        glu, lin = jnp.split(z, 2, axis=-1)
        glu = jnp.minimum(glu, SWIGLU_LIMIT)
        lin = jnp.clip(lin, -SWIGLU_LIMIT, SWIGLU_LIMIT)
        act = glu * jax.nn.sigmoid(SWIGLU_ALPHA * glu) * (lin + 1)
        return act @ w_down[e] + b_down[e]

    ys = lax.map(expert_block, (xs, blk_exp)).reshape(n_rows, d)
    return jax.ops.segment_sum(ys * row_gate[:, None], row_tok, num_segments=n_tok + 1)[:n_tok]


def setup_inputs(seed: int = 0) -> dict:
    key = jax.random.key(seed)
    ks = iter(jax.random.split(key, 48))
    f32 = jnp.float32
    nrm = lambda shape, s: jax.random.normal(next(ks), shape, f32) * s
    gain = lambda shape: 1.0 + nrm(shape, 0.02)
    L, D, E, F = DEPTH, D_MODEL, N_EXPERTS, D_FF
    dt = jnp.exp(jax.random.uniform(next(ks), (L, 2, GD_HEADS), f32, math.log(1e-3), math.log(1e-1)))
    return {
        'x': nrm((BATCH, SEQ, D), 1.0),
        'c': nrm((BATCH, D), 1.0),
        'ctx': nrm((BATCH, CTX_LEN, D), 1.0),
        'c_ctx': nrm((D,), 1.0),
        'w_mod': nrm((L, D, 6 * D), D ** -0.5),
        'b_mod': nrm((L, 6 * D), 0.02),
        'norm1_g': gain((L, D)),
        'norm2_g': gain((L, D)),
        'w_in': nrm((L, D, IN_COLS), D ** -0.5),
        'b_gate': nrm((L, N_BRANCH, D), 0.02),
        'da_q_g': gain((L, DA_HD)),
        'da_k_g': gain((L, DA_HD)),
        'da_lam_q1': nrm((L, DA_HD), 0.1),
        'da_lam_k1': nrm((L, DA_HD), 0.1),
        'da_lam_q2': nrm((L, DA_HD), 0.1),
        'da_lam_k2': nrm((L, DA_HD), 0.1),
        'da_sub_g': gain((L, 2 * DA_HD)),
        'ga_q_g': gain((L, GA_HD)),
        'ga_k_g': gain((L, GA_HD)),
        'gm_v_g': gain((L, GM_W)),
        'gm_ws': nrm((L, GM_GROUPS, GM_CHUNK, GM_CHUNK), GM_CHUNK ** -0.5),
        'gm_bs': gain((L, GM_GROUPS, GM_CHUNK)),
        'gd_conv_w': nrm((L, GD_CONV, 3 * GD_W), GD_CONV ** -0.5),
        'gd_a_log': jnp.log(jax.random.uniform(next(ks), (L, 2, GD_HEADS), f32, 1.0, 16.0)),
        'gd_dt_bias': dt + jnp.log(-jnp.expm1(-dt)),
        'gd_out_g': gain((L, GD_HD)),
        'w_br': nrm((L, N_BRANCH, BR_W, D), BR_W ** -0.5),
        'w_o': nrm((L, D, D), D ** -0.5),
        'w_router': nrm((L, D, E), D ** -0.5),
        'b_router': nrm((L, E), 0.01),
        'w_up': nrm((L, E, D, 2 * F), D ** -0.5),
        'b_up': nrm((L, E, 2 * F), 0.02),
        'w_down': nrm((L, E, F, D), F ** -0.5),
        'b_down': nrm((L, E, D), 0.02),
    }


def reference(x, c, ctx, c_ctx, w_mod, b_mod, norm1_g, norm2_g, w_in, b_gate,
              da_q_g, da_k_g, da_lam_q1, da_lam_k1, da_lam_q2, da_lam_k2, da_sub_g,
              ga_q_g, ga_k_g, gm_v_g, gm_ws, gm_bs, gd_conv_w, gd_a_log, gd_dt_bias, gd_out_g,
              w_br, w_o, w_router, b_router, w_up, b_up, w_down, b_down):
    bsz, seq, _ = x.shape
    rope_da = _axial_rope_tables(seq, DA_HD)
    rope_ga = _axial_rope_tables(seq, GA_HD)
    xc = ctx
    for l in range(DEPTH):
        need_ctx = l < DEPTH - 1
        lam_init = 0.8 - 0.6 * math.exp(-0.3 * l)
        sh1, sc1, g1, sh2, sc2, g2 = _adaln(c, w_mod[l], b_mod[l])
        sh1c, sc1c, g1c, sh2c, sc2c, g2c = _adaln(c_ctx[None], w_mod[l], b_mod[l])
        h = _modulate(_rms(x, norm1_g[l]), sh1, sc1)
        hc = _modulate(_rms(xc, norm1_g[l]), sh1c, sc1c)
        y, yc = _mixer_sublayer(h, hc, w_in[l], b_gate[l], da_q_g[l], da_k_g[l], da_lam_q1[l], da_lam_k1[l],
                                da_lam_q2[l], da_lam_k2[l], da_sub_g[l], ga_q_g[l], ga_k_g[l], gm_v_g[l],
                                gm_ws[l], gm_bs[l], gd_conv_w[l], gd_a_log[l], gd_dt_bias[l], gd_out_g[l],
                                w_br[l], w_o[l], lam_init, rope_da, rope_ga, need_ctx)
        x = x + g1 * y
        h2 = _modulate(_rms(x, norm2_g[l]), sh2, sc2)
        if need_ctx:
            xc = xc + g1c * yc
            h2c = _modulate(_rms(xc, norm2_g[l]), sh2c, sc2c)
            tok = jnp.concatenate([h2.reshape(-1, D_MODEL), h2c.reshape(-1, D_MODEL)], axis=0)
        else:
            tok = h2.reshape(-1, D_MODEL)
        f = _moe(tok, w_router[l], b_router[l], w_up[l], b_up[l], w_down[l], b_down[l])
        x = x + g2 * f[:bsz * seq].reshape(bsz, seq, D_MODEL)
        if need_ctx:
            xc = xc + g2c * f[bsz * seq:].reshape(xc.shape)
    return x
```

```cpp
#include <hip/hip_runtime.h>
#include <stdint.h>
#include <stdio.h>
#include <math.h>
#include <string.h>

#define LAS __attribute__((address_space(3)))
typedef unsigned short bf16_t;
typedef short bf16x8 __attribute__((ext_vector_type(8)));
typedef short s16x4 __attribute__((ext_vector_type(4)));
typedef short v4i16_t __attribute__((ext_vector_type(4)));
typedef float f32x2 __attribute__((ext_vector_type(2)));
typedef float f32x4 __attribute__((ext_vector_type(4)));
typedef float f32x16 __attribute__((ext_vector_type(16)));
typedef unsigned u32x2 __attribute__((ext_vector_type(2)));
typedef unsigned u32x4 __attribute__((ext_vector_type(4)));

constexpr int D = 1024, NB = 16, SEQ = 4096, CTXL = 256, TPB = SEQ + CTXL;
constexpr int NR = NB * TPB;
constexpr int NRT = NR / 256;
constexpr int NPT = 28;
constexpr int NE = 32;
constexpr int GRID = 256;
constexpr int MAXT = 1120, MAXROWS = MAXT * 256;
#ifndef PROBE_REP
#define PROBE_REP 0
#endif
constexpr float EPS = 1e-6f;
constexpr float LOG2E = 1.4426950408889634f;
constexpr float QSC = 128.f / 32767.f;
constexpr int T_AQ = 0, T_AK = 1, T_AV = 2, T_GQ = 3, T_GKV = 4, T_MU = 5, T_MV = 6, T_DQ = 7, T_DK = 8, T_DV = 9, T_DG = 10, T_DAB = 11, T_GATE = 12;

constexpr size_t WS_CTL = 0;
constexpr size_t CTL_BYTES = 65536;
constexpr int CW_BAR = 0;
constexpr int CW_GCNT = 4096;
constexpr int CW_QUEUE = 4352;
constexpr size_t WS_MOD = 65536;
constexpr size_t WS_ROPE = WS_MOD + 2ull * 17 * 6144 * 4;
constexpr size_t WS_WIN = 1048576;
constexpr size_t WS_WBR = WS_WIN + 2ull * 7168 * 1024 * 2;
constexpr size_t WS_WO = WS_WBR + 2ull * 4 * 1024 * 256 * 2;
constexpr size_t WS_WUP = WS_WO + 2ull * 1024 * 1024 * 2;
constexpr size_t WS_WG8 = WS_WUP + 2ull * 32 * 2048 * 1024;
constexpr size_t WS_WDN = WS_WG8 + 2ull * 4096 * 1024;
constexpr size_t WS_GMWS = WS_WDN + 2ull * 32 * 1024 * 1024;
constexpr size_t WS_XB = WS_GMWS + 2ull * 4 * 128 * 128 * 2;
constexpr size_t WS_SELI = WS_XB + (size_t)NR * 1024 * 2;
constexpr size_t WS_SELG = WS_SELI + (size_t)NR * 4 * 4;
constexpr size_t WS_GB = WS_SELG + (size_t)NR * 4 * 4;
constexpr size_t WS_ROWMAP = WS_GB + (size_t)NR * 16 * 4;
constexpr size_t WS_GSLOT = WS_ROWMAP + (size_t)MAXROWS * 4;
constexpr size_t WS_CHG = WS_GSLOT + (size_t)MAXROWS * 4;
constexpr size_t WS_ARENA = (WS_CHG + 8704 * 4 + 4095) & ~(size_t)4095;
constexpr size_t PT_BYTES = (size_t)NR * 256 * 2;
constexpr size_t A_H = 0;
constexpr size_t A_P = (size_t)NR * 1024 * 2;
constexpr size_t A_CH = A_P + NPT * PT_BYTES;
constexpr size_t CH_ITEM = 40960;
constexpr size_t A_END = A_CH + 8704ull * CH_ITEM;
constexpr size_t A_MERGED = A_CH;
constexpr size_t A_H2 = 0;
constexpr size_t A_XS = A_P;
constexpr size_t A_ACT = A_XS + (size_t)MAXROWS * 1024 * 2;
constexpr size_t A_H2F8 = A_XS + (size_t)NR * 1024 * 2;
constexpr size_t A_YBUF = A_XS;
static_assert(A_ACT + (size_t)MAXROWS * 1024 * 2 <= A_END, "arena");
static_assert((size_t)NR * 4 * 1024 * 2 <= (size_t)MAXROWS * 1024 * 2, "ybuf fits xs");
constexpr size_t A_H8 = A_END;
constexpr size_t WS_NEED = WS_ARENA + A_END + (size_t)NR * 1024;

constexpr int RING_BYTES = 131072;
constexpr int MISC_OFF = 140544;
constexpr int LDS_BYTES = 147456;

typedef __bf16 bf16x2_t __attribute__((ext_vector_type(2)));
__device__ __forceinline__ unsigned cvt_pk(float lo, float hi) { const f32x2 v = {lo, hi}; const bf16x2_t b = __builtin_convertvector(v, bf16x2_t); return __builtin_bit_cast(unsigned, b); }
__device__ __forceinline__ float bf_lo(unsigned u) { return __uint_as_float(u << 16); }
__device__ __forceinline__ float bf_hi(unsigned u) { return __uint_as_float(u & 0xffff0000u); }
__device__ __forceinline__ float bf2f(bf16_t h) { return __uint_as_float(((unsigned)h) << 16); }
__device__ __forceinline__ bf16_t f2bf(float f) { return (bf16_t)(cvt_pk(f, 0.f) & 0xffffu); }
template <int O> __device__ __forceinline__ float xor_f(float v) { return __int_as_float(__builtin_amdgcn_ds_swizzle(__float_as_int(v), (O << 10) | 0x1f)); }
__device__ __forceinline__ float add_xor32(float v) { const auto rr = __builtin_amdgcn_permlane32_swap(__float_as_uint(v), __float_as_uint(v), false, false); return __uint_as_float(rr[0]) + __uint_as_float(rr[1]); }
__device__ __forceinline__ float sum16(float v) { v += xor_f<1>(v); v += xor_f<2>(v); v += xor_f<4>(v); v += xor_f<8>(v); return v; }
__device__ __forceinline__ float wave_sum(float v) { v = sum16(v); v += xor_f<16>(v); return add_xor32(v); }
__device__ __forceinline__ float sigmoidf_(float x) { return __builtin_amdgcn_rcpf(1.f + __builtin_amdgcn_exp2f(x * -LOG2E)); }
__device__ __forceinline__ float siluf_(float x) { return x * __builtin_amdgcn_rcpf(1.f + __builtin_amdgcn_exp2f(x * -LOG2E)); }
__device__ __forceinline__ float gelu_erf(float v) {
    const float av = fabsf(v), t = __builtin_amdgcn_rcpf(av * 0.2316418882f + 1.0f);
    float q = t * 0.5307027145f + (-0.7265760135f); q = q * t + 0.7107068705f; q = q * t + (-0.142248368f); q = q * t + 0.127414796f; q = q * t;
    const float e = __builtin_amdgcn_exp2f((v * v) * (-0.72134752044f));
    const float m = v * (q * e);
    return v < 0.f ? m : v - m;
}
#define VM_WAIT() asm volatile("s_waitcnt vmcnt(0)" ::: "memory")
#define LDS_WAIT() asm volatile("s_waitcnt lgkmcnt(0)" ::: "memory")

#define XB_TMO      128
#define XB_XCNT(j)  (256  + 64 * (j))
#define XB_XSUB(j)  (1280 + 64 * (j))
#define XB_XGEN(j)  (2304 + 64 * (j))
#define XB_TOP      3328
#define XB_TOPGEN   3392
#define XCD_BAR_WORDS 3456
#define XB_SPIN_CAP (1u << 18)
__device__ __forceinline__ unsigned xb_ld(unsigned* p)              { return __hip_atomic_load(p, __ATOMIC_RELAXED, __HIP_MEMORY_SCOPE_AGENT); }
__device__ __forceinline__ unsigned xb_add(unsigned* p, unsigned v) { return __hip_atomic_fetch_add(p, v, __ATOMIC_RELAXED, __HIP_MEMORY_SCOPE_AGENT); }
__device__ __forceinline__ unsigned xb_xcc_id() { return (unsigned)__builtin_amdgcn_s_getreg((3 << 11) | 20) & 0xFu; }
#define XB_SPIN(cond, bar) do { unsigned _sp = 0; while (cond) { __builtin_amdgcn_s_sleep(1); \
    if ((++_sp & 255u) == 0u) { if (xb_ld(&(bar)[XB_TMO])) break; if (_sp > XB_SPIN_CAP) { atomicAdd(&(bar)[XB_TMO], 1u); break; } } } } while (0)
struct XcdBarrier { unsigned* bar; unsigned x; volatile LAS unsigned* st; };
__device__ __forceinline__ XcdBarrier xcd_barrier_post(unsigned* bar, volatile LAS unsigned* st) {
    XcdBarrier b; b.bar = bar; b.x = xb_xcc_id(); b.st = st;
    if (threadIdx.x == 0) (void)xb_add(&bar[XB_XCNT(b.x)], 1u);
    return b;
}
__device__ __forceinline__ void xcd_barrier_complete(unsigned* bar, unsigned x, unsigned& nloc, unsigned& nx) {
    const unsigned G = gridDim.x * gridDim.y * gridDim.z;
    unsigned sum, cnt, mine, sp = 0u;
    for (;;) {
        sum = 0u; cnt = 0u; mine = 0u;
#pragma unroll
        for (unsigned j = 0; j < 16; ++j) { const unsigned c = xb_ld(&bar[XB_XCNT(j)]); sum += c; cnt += (c > 0u) ? 1u : 0u; mine = (j == x) ? c : mine; }
        if (sum == G) break;
        __builtin_amdgcn_s_sleep(1);
        if ((++sp & 255u) == 0u) { if (xb_ld(&bar[XB_TMO])) break; if (sp > XB_SPIN_CAP) { atomicAdd(&bar[XB_TMO], 1u); break; } }
    }
    nloc = mine > 0u ? mine : 1u; nx = cnt > 0u ? cnt : 1u;
}
__device__ __forceinline__ void xcd_barrier(const XcdBarrier& b) {
    asm volatile("s_waitcnt vmcnt(0)" ::: "memory");
    __syncthreads();
    if (threadIdx.x == 0) {
        unsigned* bar = b.bar;
        __builtin_amdgcn_s_waitcnt(0);
        unsigned nloc = b.st[0], nx = b.st[1];
        if (nloc == 0u) { xcd_barrier_complete(bar, b.x, nloc, nx); b.st[0] = nloc; b.st[1] = nx; }
        const unsigned old = xb_add(&bar[XB_XSUB(b.x)], 1u);
        const unsigned gen = old / nloc;
        if (old + 1u == (gen + 1u) * nloc) {
            __builtin_amdgcn_fence(__ATOMIC_RELEASE, "agent");
            asm volatile("s_waitcnt vmcnt(0)" ::: "memory");
            const unsigned og = xb_add(&bar[XB_TOP], 1u);
            const unsigned tg = og / nx;
            if (og + 1u == (tg + 1u) * nx) xb_add(&bar[XB_TOPGEN], 1u);
            else XB_SPIN(xb_ld(&bar[XB_TOPGEN]) == tg, bar);
            __builtin_amdgcn_fence(__ATOMIC_ACQUIRE, "agent");
            xb_add(&bar[XB_XGEN(b.x)], 1u);
            asm volatile("s_waitcnt vmcnt(0)" ::: "memory");
        } else {
            XB_SPIN(xb_ld(&bar[XB_XGEN(b.x)]) == gen, bar);
            __builtin_amdgcn_fence(__ATOMIC_ACQUIRE, "agent");
            asm volatile("s_waitcnt vmcnt(0)" ::: "memory");
        }
    }
    __syncthreads();
}

struct Args { const float* in[34]; float* out; unsigned char* ws; float inv32[8]; float inv64[16]; float lam_init[2]; int ph_lo, ph_hi; };
struct Frame {
    LAS unsigned char* lds;
    const float* const* in;
    float* out; unsigned char* ws; unsigned char* ar;
    int tid, lane, wave, blk;
};
enum InIdx { I_X = 0, I_C, I_CTX, I_CCTX, I_WMOD, I_BMOD, I_N1G, I_N2G, I_WIN, I_BGATE, I_DAQG, I_DAKG, I_LQ1, I_LK1, I_LQ2, I_LK2, I_DASUBG, I_GAQG, I_GAKG, I_GMVG, I_GMWS, I_GMBS,
             I_CONVW, I_ALOG, I_DTB, I_GDOUTG, I_WBR, I_WO, I_WR, I_BR, I_WUP, I_BUP, I_WDN, I_BDN };
__device__ __forceinline__ bf16_t* ptile(const Frame& F, int t) { return (bf16_t*)(F.ar + A_P + (size_t)t * PT_BYTES); }
__device__ __forceinline__ const float* modv(const Frame& F, int l, int mi, int which) { return (const float*)(F.ws + WS_MOD) + ((size_t)(l * 17 + mi) * 6144 + which * 1024); }
namespace pg8 {
typedef int v4i_t __attribute__((ext_vector_type(4)));
typedef int v8i_t __attribute__((ext_vector_type(8)));
constexpr int BM = 256, BK = 64, HALF = 128, HTB = HALF * BK * 2, STAGE_BYTES = 8 * HTB, NXCD = 8, WGM = 8;
__host__ __device__ __forceinline__ int lds_byte(int r, int c) { const int st = (r >> 4) * 2 + (c >> 5), rr = r & 15, cc = c & 31, ob = rr * 64 + cc * 2; return st * 1024 + (ob ^ (((ob >> 9) & 1) << 5)); }
__host__ __device__ __forceinline__ void stage_rc(int b, int& R, int& C) { const int st = b / 1024, sb = b % 1024, swz = sb ^ (((sb >> 9) & 1) << 5); R = (st >> 1) * 16 + swz / 64; C = (st & 1) * 32 + (swz % 64) / 2; }
__host__ __device__ __forceinline__ int perm32(int rho) { const int n = rho >> 4, i = rho & 15; return 8 * (i >> 2) + 4 * n + (i & 3); }

struct Unit { int pm, pn, z; };

template <bool F8_>
struct DenseOrderT {
    static constexpr bool GATHER = false, FP8 = F8_;
    __device__ __forceinline__ int scale_w() const { return 0x7a7a7a7a; }
    __device__ __forceinline__ int scale_x() const { return 0x7f7f7f7f; }
    int pn_off = 0;
    __device__ __forceinline__ int arow(const Unit&, int) const { return 0; }
    __device__ __forceinline__ int araw(const Unit&, int) const { return 0; }
    int nM, nN, nwg, G, c; bool skipctx; const char* A; const char* Bt; size_t tstep; int nctx = 0;
    __device__ void init(int nM_, int nN_, int G_, int c_, bool skip, const void* A_, const void* Bt_, int K) { nM = nM_; nN = nN_; nwg = nM * nN; G = G_; c = c_; skipctx = skip; A = (const char*)A_; Bt = (const char*)Bt_; tstep = (size_t)BM * K * (F8_ ? 1 : 2); }
    __device__ bool next(int i, Unit& u) const {
        const long L = (long)i * G + c; if (L >= nwg + nctx) return false;
        if (L >= nwg) { const int idx = (int)L - nwg, q = idx / 7, t = idx - q * 7;
            u.pm = q * 17; u.pn = (t == 0) ? 1 : (t == 1) ? 2 : (t == 2) ? 4 : (t == 3) ? 7 : (t == 4) ? 8 : (t == 5) ? 9 : 11; u.z = 0; return true; }
        int wgid = (int)L; { const int q = nwg / NXCD, r = nwg % NXCD, xcd = wgid % NXCD, off = wgid / NXCD; wgid = (xcd < r ? xcd * (q + 1) : r * (q + 1) + (xcd - r) * q) + off; }
        const int nig = WGM * nN, gid = wgid / nig, fm = gid * WGM, gsz = (nM - fm) < WGM ? (nM - fm) : WGM;
        int pm = fm + ((wgid % nig) % gsz); u.pn = (wgid % nig) / gsz + pn_off; u.z = 0;
        if (skipctx) pm = (pm >> 4) * 17 + 1 + (pm & 15);
        u.pm = pm; return true;
    }
    __device__ __forceinline__ const char* abase(const Unit& u) const { return A + (size_t)u.pm * tstep; }
    __device__ __forceinline__ const char* bbase(const Unit& u) const { return Bt + (size_t)(u.pn - pn_off) * tstep; }
};
typedef DenseOrderT<false> DenseOrder;

template <class Epi, class Sched, bool ALIGN = true>
__device__ __forceinline__ void gemm_phase(LAS unsigned char* lds, const int tid, const int K, const Sched& S, const Epi& E) {
    const int wid = __builtin_amdgcn_readfirstlane(tid >> 6), lane = tid & 63, wr = wid >> 2, wc = wid & 3, fr = lane & 15, fq = lane >> 4;
    constexpr bool F8 = Sched::FP8;
    const int RB = F8 ? K : 2 * K;
    const int nt = RB / 128;
    unsigned voffA[2], voffB[2];
#pragma unroll
    for (int i = 0; i < 2; ++i) { int R, C; stage_rc(tid * 16 + i * 8192, R, C); const int Rb = (R & ~31) + perm32(R & 31);
        voffA[i] = (unsigned)(R * RB + C * 2); voffB[i] = (unsigned)(Rb * RB + C * 2); }
    const size_t kstep = (size_t)(BK * 2);
    const size_t hstep = (size_t)HALF * RB;
    int Rst[2], Cst[2];
#pragma unroll
    for (int i = 0; i < 2; ++i) stage_rc(tid * 16 + i * 8192, Rst[i], Cst[i]);
    unsigned gA[2][2], ngA[2][2];
    const unsigned ldsw = (unsigned)wid * 1024u;
    const int aoff = lds_byte(wr * 64 + fr, fq * 8), boff = lds_byte(wc * 32 + fr, fq * 8);
#define PG8_SA(b, h) (((b) * 2 + (h)) * HTB)
#define PG8_SB(b, h) ((4 + (b) * 2 + (h)) * HTB)
#define PG8_STAGE(bufoff, gbase, voff) do { _Pragma("unroll") for (int _i = 0; _i < 2; ++_i) \
        __builtin_amdgcn_global_load_lds((const unsigned*)((const char*)(gbase) + (voff)[_i]), (LAS unsigned*)(lds + (bufoff) + ldsw + _i * 8192), 16, 0, 0); } while (0)
#define PG8_GLOAD(dst, u_) do { if constexpr (Sched::GATHER) { _Pragma("unroll") for (int _h = 0; _h < 2; ++_h) _Pragma("unroll") for (int _i = 0; _i < 2; ++_i) \
        dst[_h][_i] = (unsigned)S.arow((u_), _h * HALF + Rst[_i]) * (unsigned)RB + (unsigned)(Cst[_i] * 2); } } while (0)
#define PG8_STAGE_A(bufoff, gbase, h_, nx_) do { if constexpr (Sched::GATHER) { _Pragma("unroll") for (int _i = 0; _i < 2; ++_i) \
        __builtin_amdgcn_global_load_lds((const unsigned*)((const char*)(gbase) + ((nx_) ? ngA[h_][_i] : gA[h_][_i])), (LAS unsigned*)(lds + (bufoff) + ldsw + _i * 8192), 16, 0, 0); } \
        else PG8_STAGE(bufoff, (gbase) + (h_) * hstep, voffA); } while (0)
#define PG8_LD32(p_) __builtin_shufflevector(*(const LAS v4i_t*)(p_), *(const LAS v4i_t*)((p_) + 1024), 0, 1, 2, 3, 4, 5, 6, 7)
#define PG8_LDA(dst, b, h) do { if constexpr (F8) { _Pragma("unroll") for (int m = 0; m < 4; ++m) dst##8[m] = PG8_LD32(lds + PG8_SA(b, h) + aoff + m * 2048); } \
        else { _Pragma("unroll") for (int m = 0; m < 4; ++m) _Pragma("unroll") for (int k = 0; k < 2; ++k) dst[m][k] = *(const LAS bf16x8*)(lds + PG8_SA(b, h) + aoff + m * 2048 + k * 1024); } } while (0)
#define PG8_LDB(dst, b, h) do { if constexpr (F8) { _Pragma("unroll") for (int n = 0; n < 2; ++n) dst##8[n] = PG8_LD32(lds + PG8_SB(b, h) + boff + n * 2048); } \
        else { _Pragma("unroll") for (int n = 0; n < 2; ++n) _Pragma("unroll") for (int k = 0; k < 2; ++k) dst[n][k] = *(const LAS bf16x8*)(lds + PG8_SB(b, h) + boff + n * 2048 + k * 1024); } } while (0)
#define PG8_MMA(ai, bj, At, Bt) do { __builtin_amdgcn_s_setprio(1); _Pragma("unroll") for (int m = 0; m < 4; ++m) _Pragma("unroll") for (int n = 0; n < 2; ++n) { \
        if constexpr (F8) asm volatile("v_mfma_scale_f32_16x16x128_f8f6f4 %0, %1, %2, %0, %3, %4 op_sel_hi:[0,0,0]" : "+v"(acc[ai][bj][m][n]) : "v"(Bt##8[n]), "v"(At##8[m]), "v"(sclw), "v"(sclx)); \
        else { _Pragma("unroll") for (int k = 0; k < 2; ++k) acc[ai][bj][m][n] = __builtin_amdgcn_mfma_f32_16x16x32_bf16(Bt[n][k], At[m][k], acc[ai][bj][m][n], 0, 0, 0); } } \
        __builtin_amdgcn_s_setprio(0); } while (0)
#define PG8_WAIT_V(n) asm volatile("s_waitcnt vmcnt(" #n ")" ::: "memory")
#define PG8_WAIT_L(n) asm volatile("s_waitcnt lgkmcnt(" #n ")" ::: "memory")
#define PG8_BAR __builtin_amdgcn_s_barrier()
#define PG8_SCHED __builtin_amdgcn_sched_barrier(0)
    Unit cur, nxt; int ui = 0;
    if (!S.next(0, cur)) return;
    f32x4 acc[2][2][4][2];
#pragma unroll
    for (int a = 0; a < 2; ++a)
#pragma unroll
        for (int b = 0; b < 2; ++b)
#pragma unroll
            for (int m = 0; m < 4; ++m)
#pragma unroll
                for (int n = 0; n < 2; ++n) acc[a][b][m][n] = (f32x4){0.f, 0.f, 0.f, 0.f};
    bf16x8 At[4][2], B0[2][2], B1[2][2];
    v8i_t At8[4], B08[2], B18[2];
    const int sclw = S.scale_w(), sclx = S.scale_x();
    const char* cA = S.abase(cur); const char* cB = S.bbase(cur);
    PG8_GLOAD(gA, cur);
    if constexpr (Sched::GATHER) { _Pragma("unroll") for (int _h = 0; _h < 2; ++_h) _Pragma("unroll") for (int _i = 0; _i < 2; ++_i) ngA[_h][_i] = gA[_h][_i]; asm volatile("s_waitcnt vmcnt(0)" ::: "memory"); }
    PG8_STAGE(PG8_SB(0, 0), cB, voffB); PG8_STAGE(PG8_SB(0, 1), cB + hstep, voffB); PG8_STAGE_A(PG8_SA(0, 0), cA, 0, false); PG8_STAGE_A(PG8_SA(0, 1), cA, 1, false);
    if (wr == 1) PG8_BAR;
    PG8_WAIT_V(2); PG8_BAR;
    PG8_STAGE(PG8_SB(1, 0), cB + kstep, voffB); PG8_STAGE_A(PG8_SA(1, 0), cA + kstep, 0, false); PG8_STAGE(PG8_SB(1, 1), cB + hstep + kstep, voffB);
    PG8_WAIT_V(6); PG8_BAR;
    for (;;) {
        const bool has_next = S.next(ui + 1, nxt);
        const char* nA = has_next ? S.abase(nxt) : cA; const char* nB = has_next ? S.bbase(nxt) : cB;
        int rawn[2][2];
        if constexpr (Sched::GATHER) { if (has_next) { _Pragma("unroll") for (int _h = 0; _h < 2; ++_h) _Pragma("unroll") for (int _i = 0; _i < 2; ++_i) rawn[_h][_i] = S.araw(nxt, _h * HALF + Rst[_i]); } }
#pragma unroll 1
        for (int t = 0; t < nt; t += 2) {
            const bool last = (t == nt - 2);
            const char* a1 = cA + (size_t)(t + 1) * kstep;
            const char* a2 = last ? nA : cA + (size_t)(t + 2) * kstep; const char* b2 = last ? nB : cB + (size_t)(t + 2) * kstep;
            const char* a3 = a2 + kstep; const char* b3 = b2 + kstep;
            if constexpr (Sched::GATHER) { if (last && has_next) { _Pragma("unroll") for (int _h = 0; _h < 2; ++_h) _Pragma("unroll") for (int _i = 0; _i < 2; ++_i)
                ngA[_h][_i] = (unsigned)(rawn[_h][_i] < 0 ? 0 : rawn[_h][_i] >> 2) * (unsigned)RB + (unsigned)(Cst[_i] * 2); } }
            PG8_LDB(B0, 0, 0); PG8_LDB(B1, 0, 1); PG8_SCHED; PG8_LDA(At, 0, 0); PG8_STAGE_A(PG8_SA(1, 1), a1, 1, false);
            PG8_WAIT_V(8); PG8_WAIT_L(0); PG8_BAR; PG8_MMA(0, 0, At, B0); PG8_MMA(0, 1, At, B1); PG8_BAR; PG8_SCHED;
            PG8_LDA(At, 0, 1); PG8_STAGE(PG8_SB(0, 0), b2, voffB); PG8_STAGE(PG8_SB(0, 1), b2 + hstep, voffB); PG8_STAGE_A(PG8_SA(0, 0), a2, 0, last);
            PG8_WAIT_V(8); PG8_WAIT_L(0); PG8_BAR; PG8_MMA(1, 0, At, B0); PG8_MMA(1, 1, At, B1); PG8_BAR; PG8_SCHED;
            PG8_LDB(B0, 1, 0); PG8_LDB(B1, 1, 1); PG8_SCHED; PG8_LDA(At, 1, 0); PG8_STAGE_A(PG8_SA(0, 1), a2, 1, last);
            PG8_WAIT_V(8); PG8_WAIT_L(0); PG8_BAR; PG8_MMA(0, 0, At, B0); PG8_MMA(0, 1, At, B1); PG8_BAR; PG8_SCHED;
            PG8_LDA(At, 1, 1); PG8_STAGE(PG8_SB(1, 0), b3, voffB); PG8_STAGE(PG8_SB(1, 1), b3 + hstep, voffB); PG8_STAGE_A(PG8_SA(1, 0), a3, 0, last);
            PG8_WAIT_V(8); PG8_WAIT_L(0); PG8_BAR; PG8_MMA(1, 0, At, B0); PG8_MMA(1, 1, At, B1); PG8_BAR; PG8_SCHED;
        }
        if (ALIGN) { if (wr == 0) PG8_BAR; }
        bool keep = false;
        if constexpr (F8) asm volatile("s_nop 15\n\ts_nop 15" ::: "memory");
        { int tz = tid; asm volatile("" : "+v"(tz)); const int wid2 = __builtin_amdgcn_readfirstlane(tz >> 6), lane2 = tz & 63;
          if constexpr (Epi::CHAIN) keep = E(acc, cur, wid2 >> 2, wid2 & 3, lane2 & 15, lane2 >> 4); else { E(acc, cur, wid2 >> 2, wid2 & 3, lane2 & 15, lane2 >> 4); if constexpr (Epi::TWICE) { asm volatile("" ::: "memory"); E(acc, cur, wid2 >> 2, wid2 & 3, lane2 & 15, lane2 >> 4); } } }
        if (!has_next) break;
        if (!keep)
#pragma unroll
        for (int a = 0; a < 2; ++a)
#pragma unroll
            for (int b = 0; b < 2; ++b)
#pragma unroll
                for (int m = 0; m < 4; ++m)
#pragma unroll
                    for (int n = 0; n < 2; ++n) acc[a][b][m][n] = (f32x4){0.f, 0.f, 0.f, 0.f};
        cur = nxt; cA = nA; cB = nB; ++ui;
        if constexpr (Sched::GATHER) { _Pragma("unroll") for (int _h = 0; _h < 2; ++_h) _Pragma("unroll") for (int _i = 0; _i < 2; ++_i) gA[_h][_i] = ngA[_h][_i]; }
        if (ALIGN) { if (wr == 1) PG8_BAR; }
    }
    PG8_WAIT_V(0);
    if (!ALIGN) { if (wr == 0) PG8_BAR; }
    PG8_BAR;
#undef PG8_SA
#undef PG8_SB
#undef PG8_STAGE
#undef PG8_STAGE_A
#undef PG8_GLOAD
#undef PG8_LDA
#undef PG8_LDB
#undef PG8_MMA
#undef PG8_LD32
#undef PG8_WAIT_V
#undef PG8_WAIT_L
#undef PG8_BAR
#undef PG8_SCHED
}
}
using pg8::Unit;
typedef f32x4 AccT[2][2][4][2];

__device__ __forceinline__ u32x4 pack8(const f32x4 v0, const f32x4 v1) { u32x4 w; w.x = cvt_pk(v0[0], v0[1]); w.y = cvt_pk(v0[2], v0[3]); w.z = cvt_pk(v1[0], v1[1]); w.w = cvt_pk(v1[2], v1[3]); return w; }
constexpr float YSCL = 16.f;
__device__ __forceinline__ u32x2 pack8f8(const f32x4 v0, const f32x4 v1) { int w0 = 0, w1 = 0;
    w0 = __builtin_amdgcn_cvt_pk_fp8_f32(v0[0], v0[1], w0, false); w0 = __builtin_amdgcn_cvt_pk_fp8_f32(v0[2], v0[3], w0, true);
    w1 = __builtin_amdgcn_cvt_pk_fp8_f32(v1[0], v1[1], w1, false); w1 = __builtin_amdgcn_cvt_pk_fp8_f32(v1[2], v1[3], w1, true); return (u32x2){(unsigned)w0, (unsigned)w1}; }
__device__ __forceinline__ void unpack8f8(const u32x2 w, f32x4& v0, f32x4& v1) {
    const f32x2 a = __builtin_amdgcn_cvt_pk_f32_fp8((int)w.x, false), b = __builtin_amdgcn_cvt_pk_f32_fp8((int)w.x, true), c = __builtin_amdgcn_cvt_pk_f32_fp8((int)w.y, false), d = __builtin_amdgcn_cvt_pk_f32_fp8((int)w.y, true);
    v0 = (f32x4){a[0], a[1], b[0], b[1]}; v1 = (f32x4){c[0], c[1], d[0], d[1]}; }
__device__ __forceinline__ void unpack8(const u32x4 w, f32x4& v0, f32x4& v1) { v0 = (f32x4){bf_lo(w.x), bf_hi(w.x), bf_lo(w.y), bf_hi(w.y)}; v1 = (f32x4){bf_lo(w.z), bf_hi(w.z), bf_lo(w.w), bf_hi(w.w)}; }

struct EpiTiles {
    static constexpr bool CHAIN = false, TWICE = (PROBE_REP & 1024) != 0;
    bf16_t* P; const float* bgate;
    __device__ __forceinline__ void operator()(const AccT& acc, const Unit& u, int wr, int wc, int fr, int fq) const {
        bf16_t* base = P + (size_t)u.pn * ((size_t)NR * 256) + (size_t)(u.pm * 256 + wr * 64 + fr) * 256 + wc * 32 + 8 * fq;
        if (u.pn < T_GATE) {
#pragma unroll
            for (int ai = 0; ai < 2; ++ai)
#pragma unroll
                for (int m = 0; m < 4; ++m)
#pragma unroll
                    for (int bj = 0; bj < 2; ++bj)
                        *(u32x4*)(base + (size_t)(ai * 128 + m * 16) * 256 + bj * 128) = pack8(acc[ai][bj][m][0], acc[ai][bj][m][1]);
        } else {
            unsigned char* gb = (unsigned char*)(P + (size_t)u.pn * ((size_t)NR * 256)) + (size_t)u.pm * 65536 + (((wr * 4 + wc) * 64 + fq * 16 + fr) * 16);
            const float* bg = bgate + ((u.pn - T_GATE) >> 2) * 1024 + ((u.pn - T_GATE) & 3) * 256 + wc * 32 + 8 * fq;
#pragma unroll
            for (int bj = 0; bj < 2; ++bj) {
                const f32x4 b0 = *(const f32x4*)(bg + bj * 128) * -LOG2E, b1 = *(const f32x4*)(bg + bj * 128 + 4) * -LOG2E;
#define GATE255(a_, b_) __builtin_amdgcn_rcpf(__builtin_fmaf(__builtin_amdgcn_exp2f(__builtin_fmaf((a_), -LOG2E, (b_))), 1.f / 255.f, 1.f / 255.f))
#pragma unroll
                for (int ai = 0; ai < 2; ++ai)
#pragma unroll
                    for (int mp = 0; mp < 2; ++mp) {
                        u32x4 o = (u32x4){0u, 0u, 0u, 0u};
#pragma unroll
                        for (int j = 0; j < 4; ++j) {
                            o.x = __builtin_amdgcn_cvt_pk_u8_f32(GATE255(acc[ai][bj][2 * mp][0][j], b0[j]), j, o.x); o.y = __builtin_amdgcn_cvt_pk_u8_f32(GATE255(acc[ai][bj][2 * mp][1][j], b1[j]), j, o.y);
                            o.z = __builtin_amdgcn_cvt_pk_u8_f32(GATE255(acc[ai][bj][2 * mp + 1][0][j], b0[j]), j, o.z); o.w = __builtin_amdgcn_cvt_pk_u8_f32(GATE255(acc[ai][bj][2 * mp + 1][1][j], b1[j]), j, o.w); }
#undef GATE255
                        o.x |= 0x01010101u; o.y |= 0x01010101u; o.z |= 0x01010101u; o.w |= 0x01010101u;
                        *(u32x4*)(gb + ((bj * 2 + ai) * 2 + mp) * 8192) = o;
                    }
            }
        }
    }
};

struct MergeOrder {
    static constexpr bool GATHER = false, FP8 = false;
    __device__ __forceinline__ int scale_w() const { return 0; }
    __device__ __forceinline__ int scale_x() const { return 0; }
    __device__ __forceinline__ int arow(const Unit&, int) const { return 0; }
    __device__ __forceinline__ int araw(const Unit&, int) const { return 0; }
    int G, c, ntile; bool skipctx; const char* P; const char* Wbr;
    __device__ bool next(int i, Unit& u) const {
        const int T = (i >> 2) * G + c; if (T >= ntile) return false;
        int pm = T >> 2; u.pn = T & 3; u.z = i & 3;
        if (skipctx) pm = (pm >> 4) * 17 + 1 + (pm & 15);
        u.pm = pm; return true;
    }
    __device__ __forceinline__ const char* abase(const Unit& u) const { const int tz = (u.z == 0) ? T_AQ : (u.z == 1) ? T_GQ : (u.z == 2) ? T_MU : T_DG; return P + (size_t)tz * PT_BYTES + (size_t)u.pm * (256 * 256 * 2); }
    __device__ __forceinline__ const char* bbase(const Unit& u) const { return Wbr + (size_t)u.z * (1024 * 256 * 2) + (size_t)u.pn * (256 * 256 * 2); }
};
struct EpiMerge {
    static constexpr bool CHAIN = true, TWICE = false;
    const bf16_t* P; bf16_t* merged;
    __device__ __forceinline__ bool operator()(AccT& acc, const Unit& u, int wr, int wc, int fr, int fq) const {
        const int row0 = u.pm * 256 + wr * 64 + fr, colt = wc * 32 + 8 * fq;
        const unsigned char* g0p = (const unsigned char*)(P + (size_t)(T_GATE + 4 * u.z + u.pn) * ((size_t)NR * 256)) + (size_t)u.pm * 65536 + (((wr * 4 + wc) * 64 + fq * 16 + fr) * 16);
        if (u.z < 3) {
            const unsigned char* g1p = g0p + (size_t)4 * PT_BYTES;
            u32x4 ga[2][2], gb[2][2];
#pragma unroll
            for (int q = 0; q < 2; ++q)
#pragma unroll
                for (int h = 0; h < 2; ++h) { ga[q][h] = *(const u32x4*)(g0p + (2 * q + h) * 8192); gb[q][h] = *(const u32x4*)(g1p + (2 * q + h) * 8192); }
#pragma unroll
            for (int q = 0; q < 4; ++q) {
                const int bj = q >> 1, ai = q & 1;
#pragma unroll
                for (int m = 0; m < 4; ++m) {
                    const u32x4 A = ga[q & 1][m >> 1], B = gb[q & 1][m >> 1];
                    const unsigned a0 = (m & 1) ? A.z : A.x, a1 = (m & 1) ? A.w : A.y, b0 = (m & 1) ? B.z : B.x, b1 = (m & 1) ? B.w : B.y;
#pragma unroll
                    for (int j = 0; j < 4; ++j) {
                        acc[ai][bj][m][0][j] *= (float)((a0 >> (8 * j)) & 0xffu) * __builtin_amdgcn_rcpf((float)((b0 >> (8 * j)) & 0xffu));
                        acc[ai][bj][m][1][j] *= (float)((a1 >> (8 * j)) & 0xffu) * __builtin_amdgcn_rcpf((float)((b1 >> (8 * j)) & 0xffu));
                    }
                }
                if (q < 2) {
#pragma unroll
                    for (int h = 0; h < 2; ++h) { ga[q & 1][h] = *(const u32x4*)(g0p + (2 * (q + 2) + h) * 8192); gb[q & 1][h] = *(const u32x4*)(g1p + (2 * (q + 2) + h) * 8192); }
                }
            }
            return true;
        }
        u32x4 ga[8];
#pragma unroll
        for (int i = 0; i < 8; ++i) ga[i] = *(const u32x4*)(g0p + i * 8192);
        bf16_t* mp = merged + (size_t)row0 * 1024 + u.pn * 256 + colt;
#pragma unroll
        for (int bj = 0; bj < 2; ++bj)
#pragma unroll
            for (int ai = 0; ai < 2; ++ai)
#pragma unroll
                for (int m = 0; m < 4; ++m) {
                    const int i = (bj * 2 + ai) * 2 + (m >> 1);
                    const unsigned a0 = (m & 1) ? ga[i].z : ga[i].x, a1 = (m & 1) ? ga[i].w : ga[i].y;
                    f32x4 o0, o1;
#pragma unroll
                    for (int j = 0; j < 4; ++j) { o0[j] = acc[ai][bj][m][0][j] * ((float)((a0 >> (8 * j)) & 0xffu) * (1.f / 255.f)); o1[j] = acc[ai][bj][m][1][j] * ((float)((a1 >> (8 * j)) & 0xffu) * (1.f / 255.f)); }
                    *(u32x4*)(mp + (size_t)(ai * 128 + m * 16) * 1024 + bj * 128) = pack8(o0, o1);
                }
        return false;
    }
};

struct EpiWo {
    static constexpr bool CHAIN = false, TWICE = false;
    const float* xin_lat; const float* xin_ctx; bf16_t* xb; const float* mod_l;
    int which;
    __device__ __forceinline__ void operator()(const AccT& acc, const Unit& u, int wr, int wc, int fr, int fq) const {
        const int b = u.pm / 17, j = u.pm - b * 17; const bool isctx = (j == 0);
        const float* gv = mod_l + (size_t)(isctx ? 16 : b) * 6144 + which * 1024 + u.pn * 256 + wc * 32 + 8 * fq;
        const int r0 = wr * 64 + fr; const int c0 = u.pn * 256 + wc * 32 + 8 * fq;
        bf16_t* xo = xb + (size_t)u.pm * 256 * 1024;
        if (xin_lat != nullptr) {
            const float* xin = isctx ? xin_ctx + (size_t)b * 256 * 1024 : xin_lat + ((size_t)b * 4096 + (size_t)(j - 1) * 256) * 1024;
#pragma unroll
            for (int bj = 0; bj < 2; ++bj) {
                const f32x4 g0 = *(const f32x4*)(gv + bj * 128), g1 = *(const f32x4*)(gv + bj * 128 + 4);
#pragma unroll
                for (int ai = 0; ai < 2; ++ai)
#pragma unroll
                    for (int m = 0; m < 4; ++m) {
                        const size_t off = (size_t)(r0 + ai * 128 + m * 16) * 1024 + c0 + bj * 128;
                        const f32x4 x0 = *(const f32x4*)(xin + off), x1 = *(const f32x4*)(xin + off + 4);
                        *(u32x4*)(xo + off) = pack8(x0 + g0 * acc[ai][bj][m][0], x1 + g1 * acc[ai][bj][m][1]);
                    }
            }
        } else {
#pragma unroll
            for (int bj = 0; bj < 2; ++bj) {
                const f32x4 g0 = *(const f32x4*)(gv + bj * 128), g1 = *(const f32x4*)(gv + bj * 128 + 4);
#pragma unroll
                for (int ai = 0; ai < 2; ++ai)
#pragma unroll
                    for (int m = 0; m < 4; ++m) {
                        const size_t off = (size_t)(r0 + ai * 128 + m * 16) * 1024 + c0 + bj * 128;
                        f32x4 x0, x1; unpack8(*(const u32x4*)(xo + off), x0, x1);
                        *(u32x4*)(xo + off) = pack8(x0 + g0 * acc[ai][bj][m][0], x1 + g1 * acc[ai][bj][m][1]);
                    }
            }
        }
    }
};

template <int NPN, bool GATH>
struct MoeOrder {
    static constexpr bool GATHER = GATH, FP8 = true;
    __device__ __forceinline__ int scale_w() const { return 0x7a7a7a7a; }
    __device__ __forceinline__ int scale_x() const { return 0x7f7f7f7f; }
    int G, c, nunits; const LAS int* texp; const char* A; const char* W; size_t wstride; const int* rowmap;
    __device__ __forceinline__ int arow(const Unit& u, int r) const { const int rm = rowmap[u.pm * 256 + r]; return rm < 0 ? 0 : rm >> 2; }
    __device__ __forceinline__ int araw(const Unit& u, int r) const { return rowmap[u.pm * 256 + r]; }
    __device__ bool next(int i, Unit& u) const {
        constexpr int RT = 32 / NPN;
        const int xcd = c & 7, idx = c >> 3, rt = idx / NPN;
        const int pm = (i * RT + rt) * 8 + xcd; if (pm * NPN >= nunits) return false;
        u.pm = pm; u.pn = idx % NPN; u.z = texp[pm]; return true;
    }
    __device__ __forceinline__ const char* abase(const Unit& u) const { return GATH ? A : A + (size_t)u.pm * (256 * 1024); }
    __device__ __forceinline__ const char* bbase(const Unit& u) const { return W + (size_t)u.z * wstride + (size_t)u.pn * (256 * 1024); }
};
struct EpiUp {
    static constexpr bool CHAIN = false, TWICE = false;
    const float* bup; unsigned char* act;
    __device__ __forceinline__ void operator()(const AccT& acc, const Unit& u, int wr, int wc, int fr, int fq) const {
        const int colt = u.pn * 128 + wc * 32 + 8 * fq;
        const float* bb = bup + (size_t)u.z * 2048 + colt;
        const f32x4 bg0 = *(const f32x4*)(bb), bg1 = *(const f32x4*)(bb + 4), bl0 = *(const f32x4*)(bb + 1024) + 1.f, bl1 = *(const f32x4*)(bb + 1028) + 1.f;
        unsigned char* base = act + (size_t)(u.pm * 256 + wr * 64 + fr) * 1024 + colt;
#pragma unroll
        for (int ai = 0; ai < 2; ++ai)
#pragma unroll
            for (int m = 0; m < 4; ++m) {
                f32x4 o0, o1;
#pragma unroll
                for (int j = 0; j < 4; ++j) {
                    float g = fminf(acc[ai][0][m][0][j] + bg0[j], 7.f), li = fminf(fmaxf(acc[ai][1][m][0][j] + bl0[j], -6.f), 8.f);
                    o0[j] = g * sigmoidf_(1.702f * g) * li;
                    g = fminf(acc[ai][0][m][1][j] + bg1[j], 7.f); li = fminf(fmaxf(acc[ai][1][m][1][j] + bl1[j], -6.f), 8.f);
                    o1[j] = g * sigmoidf_(1.702f * g) * li;
                }
                int w0 = 0, w1 = 0;
                w0 = __builtin_amdgcn_cvt_pk_fp8_f32(o0[0], o0[1], w0, false); w0 = __builtin_amdgcn_cvt_pk_fp8_f32(o0[2], o0[3], w0, true);
                w1 = __builtin_amdgcn_cvt_pk_fp8_f32(o1[0], o1[1], w1, false); w1 = __builtin_amdgcn_cvt_pk_fp8_f32(o1[2], o1[3], w1, true);
                *(u32x2*)(base + (size_t)(ai * 128 + m * 16) * 1024) = (u32x2){(unsigned)w0, (unsigned)w1};
            }
    }
};
struct EpiDown {
    static constexpr bool CHAIN = false, TWICE = false;
    const float* bdn; const float* gslot; unsigned char* ybuf;
    __device__ __forceinline__ void operator()(const AccT& acc, const Unit& u, int wr, int wc, int fr, int fq) const {
        const int colt = u.pn * 256 + wc * 32 + 8 * fq;
        const float* bb = bdn + (size_t)u.z * 1024 + colt;
        const f32x4 b00 = *(const f32x4*)(bb), b01 = *(const f32x4*)(bb + 4), b10 = *(const f32x4*)(bb + 128), b11 = *(const f32x4*)(bb + 132);
        const int row0 = u.pm * 256 + wr * 64 + fr;
        float gtv[2][4];
#pragma unroll
        for (int ai = 0; ai < 2; ++ai)
#pragma unroll
            for (int m = 0; m < 4; ++m) gtv[ai][m] = gslot[row0 + ai * 128 + m * 16];
#pragma unroll
        for (int ai = 0; ai < 2; ++ai)
#pragma unroll
            for (int m = 0; m < 4; ++m) {
                const float gt = gtv[ai][m] * YSCL;
                unsigned char* yp = ybuf + (size_t)(row0 + ai * 128 + m * 16) * 1024 + colt;
                *(u32x2*)(yp) = pack8f8((acc[ai][0][m][0] + b00) * gt, (acc[ai][0][m][1] + b01) * gt);
                *(u32x2*)(yp + 128) = pack8f8((acc[ai][1][m][0] + b10) * gt, (acc[ai][1][m][1] + b11) * gt);
            }
    }
};
__device__ __forceinline__ void xpose_tile(const float* __restrict__ src, int ld, int valid, bf16_t* __restrict__ dst, int Kd, LAS float* scr, int lane) {
    const int c4 = (lane & 15) * 4, kr = lane >> 4;
    f32x4 v[16];
#pragma unroll
    for (int i = 0; i < 16; ++i) v[i] = (c4 < valid) ? *(const f32x4*)(src + (size_t)(i * 4 + kr) * ld + c4) : (f32x4){0.f, 0.f, 0.f, 0.f};
#pragma unroll
    for (int i = 0; i < 16; ++i) { LAS float* s = scr + (i * 4 + kr) * 65 + c4; s[0] = v[i][0]; s[1] = v[i][1]; s[2] = v[i][2]; s[3] = v[i][3]; }
    LDS_WAIT(); asm volatile("" ::: "memory");
    const int c = lane & 7;
#pragma unroll
    for (int j = 0; j < 8; ++j) { const int n = (lane >> 3) + 8 * j; const LAS float* s = scr + (8 * c) * 65 + n;
        u32x4 o; o.x = cvt_pk(s[0 * 65], s[1 * 65]); o.y = cvt_pk(s[2 * 65], s[3 * 65]); o.z = cvt_pk(s[4 * 65], s[5 * 65]); o.w = cvt_pk(s[6 * 65], s[7 * 65]);
        *(u32x4*)(dst + (size_t)n * Kd + 8 * c) = o; }
    LDS_WAIT(); asm volatile("" ::: "memory");
}

__device__ __forceinline__ void xpose_tile8(const float* __restrict__ src, int ld, unsigned char* __restrict__ dst, int Kd, LAS float* scr, int lane) {
    const int c4 = (lane & 15) * 4, kr = lane >> 4;
    f32x4 v[16];
#pragma unroll
    for (int i = 0; i < 16; ++i) v[i] = *(const f32x4*)(src + (size_t)(i * 4 + kr) * ld + c4);
#pragma unroll
    for (int i = 0; i < 16; ++i) { LAS float* s = scr + (i * 4 + kr) * 65 + c4; s[0] = v[i][0]; s[1] = v[i][1]; s[2] = v[i][2]; s[3] = v[i][3]; }
    LDS_WAIT(); asm volatile("" ::: "memory");
    const int c = lane & 7;
#pragma unroll
    for (int j = 0; j < 8; ++j) { const int n = (lane >> 3) + 8 * j; const LAS float* s = scr + (8 * c) * 65 + n;
        int w0 = 0, w1 = 0;
        w0 = __builtin_amdgcn_cvt_pk_fp8_f32(s[0 * 65] * 32.f, s[1 * 65] * 32.f, w0, false); w0 = __builtin_amdgcn_cvt_pk_fp8_f32(s[2 * 65] * 32.f, s[3 * 65] * 32.f, w0, true);
        w1 = __builtin_amdgcn_cvt_pk_fp8_f32(s[4 * 65] * 32.f, s[5 * 65] * 32.f, w1, false); w1 = __builtin_amdgcn_cvt_pk_fp8_f32(s[6 * 65] * 32.f, s[7 * 65] * 32.f, w1, true);
        *(u32x2*)(dst + (size_t)n * Kd + 8 * c) = (u32x2){(unsigned)w0, (unsigned)w1}; }
    LDS_WAIT(); asm volatile("" ::: "memory");
}

__device__ __forceinline__ void p_prologue(const Frame& F, const Args& a) {
    LAS float* scr = (LAS float*)(F.lds + F.wave * 16640);
    const int gw = F.blk * 8 + F.wave, NGW = GRID * 8;
    constexpr int N_IN = 16 * 112, N_BR = 4 * 4 * 16, N_O = 256, N_UP = 32 * 16 * 32, N_DN = 32 * 16 * 16, N_L = N_IN + N_BR + N_O + N_UP + N_DN;
    for (int it = gw; it < 2 * N_L; it += NGW) {
        const int l = it / N_L; int r = it - l * N_L;
        if (r < N_IN) {
            const int kt = r / 112, ntile = r - kt * 112, n0 = ntile * 64;
            int src0, valid;
            if (n0 < 2816) { src0 = n0; valid = 64; } else if (n0 == 2816) { src0 = 2816; valid = 16; } else if (n0 < 3072) { src0 = 0; valid = 0; } else { src0 = n0 - 240; valid = 64; }
            if (n0 < 3072) xpose_tile(F.in[I_WIN] + (size_t)l * 1024 * 6928 + (size_t)(kt * 64) * 6928 + src0, 6928, valid,
                       (bf16_t*)(F.ws + WS_WIN) + (size_t)l * 7168 * 1024 + (size_t)n0 * 1024 + kt * 64, 1024, scr, F.lane);
            else xpose_tile8(F.in[I_WIN] + (size_t)l * 1024 * 6928 + (size_t)(kt * 64) * 6928 + src0, 6928,
                       (unsigned char*)(F.ws + WS_WG8) + (size_t)l * 4096 * 1024 + (size_t)(n0 - 3072) * 1024 + kt * 64, 1024, scr, F.lane);
            continue; }
        r -= N_IN;
        if (r < N_BR) {
            const int n = r >> 6, rr = r & 63, kt = rr >> 4, ntile = rr & 15;
            xpose_tile(F.in[I_WBR] + ((size_t)(l * 4 + n) * 256 + kt * 64) * 1024 + ntile * 64, 1024, 64,
                       (bf16_t*)(F.ws + WS_WBR) + (size_t)(l * 4 + n) * 1024 * 256 + (size_t)(ntile * 64) * 256 + kt * 64, 256, scr, F.lane);
            continue; }
        r -= N_BR;
        if (r < N_O) {
            const int kt = r >> 4, ntile = r & 15;
            xpose_tile(F.in[I_WO] + ((size_t)l * 1024 + kt * 64) * 1024 + ntile * 64, 1024, 64,
                       (bf16_t*)(F.ws + WS_WO) + (size_t)l * 1024 * 1024 + (size_t)(ntile * 64) * 1024 + kt * 64, 1024, scr, F.lane);
            continue; }
        r -= N_O;
        if (r < N_UP) {
            const int e = r >> 9, rr = r & 511, kt = rr >> 5, ntile = rr & 31, n0 = ntile * 64;
            const int j = n0 >> 8, w = n0 & 255, src0 = (w < 128) ? (128 * j + w) : (1024 + 128 * j + (w - 128));
            xpose_tile8(F.in[I_WUP] + ((size_t)(l * 32 + e) * 1024 + kt * 64) * 2048 + src0, 2048,
                        (unsigned char*)(F.ws + WS_WUP) + (size_t)(l * 32 + e) * 2048 * 1024 + (size_t)n0 * 1024 + kt * 64, 1024, scr, F.lane);
            continue; }
        r -= N_UP;
        {
            const int e = r >> 8, rr = r & 255, kt = rr >> 4, ntile = rr & 15;
            xpose_tile8(F.in[I_WDN] + ((size_t)(l * 32 + e) * 1024 + kt * 64) * 1024 + ntile * 64, 1024,
                        (unsigned char*)(F.ws + WS_WDN) + (size_t)(l * 32 + e) * 1024 * 1024 + (size_t)(ntile * 64) * 1024 + kt * 64, 1024, scr, F.lane);
        }
    }
    { const int gt = F.blk * 512 + F.tid, NT = GRID * 512; const float* s = F.in[I_GMWS]; bf16_t* d = (bf16_t*)(F.ws + WS_GMWS);
      for (int i = gt; i < 2 * 4 * 128 * 128 / 4; i += NT) { const f32x4 v = *(const f32x4*)(s + (size_t)i * 4); u32x2 o; o.x = cvt_pk(v[0], v[1]); o.y = cvt_pk(v[2], v[3]); *(u32x2*)(d + (size_t)i * 4) = o; } }
    { const int gt = F.blk * 512 + F.tid;
      if (gt < 1536) {
          const int sel = gt >= 512, idx = sel ? gt - 512 : gt, Q = sel ? 16 : 8, pos = idx / Q, i = idx - pos * Q;
          const float inv = sel ? a.inv64[i] : a.inv32[i];
          const float af = (float)pos * inv;
          double x = (double)af; const double twopi = 6.283185307179586476925287;
          x -= twopi * rint(x / twopi);
          const double x2 = x * x;
          double sn = 1.0, cs = 1.0;
#pragma unroll
          for (int k = 13; k >= 1; --k) { sn = 1.0 - sn * x2 / (double)((2 * k) * (2 * k + 1)); cs = 1.0 - cs * x2 / (double)((2 * k - 1) * (2 * k)); }
          sn *= x;
          f32x2* T = (f32x2*)(F.ws + WS_ROPE);
          T[gt] = (f32x2){(float)cs, (float)sn};
      } }
    __syncthreads();
    {
        LAS float* s = (LAS float*)F.lds;
        LAS float* red = s + 17 * 1024;
        for (int idx = F.tid; idx < 17 * 1024; idx += 512) { const int i = idx >> 10, k = idx & 1023; const float c = (i < 16) ? F.in[I_C][i * 1024 + k] : F.in[I_CCTX][k]; s[idx] = siluf_(c); }
        __syncthreads();
        float* mod = (float*)(F.ws + WS_MOD);
        for (int item = F.blk; item < 96; item += GRID) {
            const int l = item / 48, j0 = (item - l * 48) * 128, jj = F.tid & 127, kp = F.tid >> 7;
            float acc[17];
#pragma unroll
            for (int i = 0; i < 17; ++i) acc[i] = 0.f;
            const float* w = F.in[I_WMOD] + (size_t)l * 1024 * 6144 + (size_t)(kp * 256) * 6144 + j0 + jj;
            const LAS float* sk = s + kp * 256;
#pragma unroll 4
            for (int k = 0; k < 256; ++k) { const float wv = w[(size_t)k * 6144];
#pragma unroll
                for (int i = 0; i < 17; ++i) acc[i] += sk[i * 1024 + k] * wv; }
#pragma unroll
            for (int i = 0; i < 17; ++i) red[(kp * 17 + i) * 128 + jj] = acc[i];
            __syncthreads();
            for (int idx = F.tid; idx < 17 * 128; idx += 512) { const int i = idx >> 7, j = idx & 127;
                mod[(size_t)(l * 17 + i) * 6144 + j0 + j] = red[(0 * 17 + i) * 128 + j] + red[(1 * 17 + i) * 128 + j] + red[(2 * 17 + i) * 128 + j] + red[(3 * 17 + i) * 128 + j] + F.in[I_BMOD][l * 6144 + j0 + j]; }
            __syncthreads();
        }
    }
}
template <int MODE>
__device__ __forceinline__ void p_rowpass(const Frame& F, int l) {
    const int gw = F.blk * 8 + F.wave, NGW = GRID * 8;
    const unsigned char* ybuf = F.ar + A_YBUF; const unsigned* seli = (const unsigned*)(F.ws + WS_SELI);
    bf16_t* H = (bf16_t*)(F.ar + A_H); unsigned char* H8 = F.ar + A_H8;
    bf16_t* XB = (bf16_t*)(F.ws + WS_XB);
    constexpr int NQ = 2;
    const int lc = F.lane * 8;
    u32x4 slv[NQ];
    if (MODE >= 1) {
#pragma unroll
        for (int q = 0; q < NQ; ++q) slv[q] = *(const u32x4*)(seli + (size_t)(gw * NQ + q) * 4);
    }
    for (int R0 = gw * NQ; R0 < NR; R0 += NGW * NQ) {
        f32x4 v[NQ][4]; u32x4 xw[NQ][2]; u32x2 yv[NQ][2][4]; int mir[NQ]; bool act[NQ];
        u32x4 sln[NQ];
        if (MODE >= 1) { const int Rn = (R0 + NGW * NQ < NR) ? R0 + NGW * NQ : R0;
#pragma unroll
            for (int q = 0; q < NQ; ++q) sln[q] = *(const u32x4*)(seli + (size_t)(Rn + q) * 4); }
#pragma unroll
        for (int q = 0; q < NQ; ++q) {
            const int R = R0 + q;
            const int b = R / TPB, p = R - b * TPB; const bool isctx = p < CTXL; mir[q] = isctx ? 16 : b;
            act[q] = !(MODE == 2 && isctx);
            if (MODE == 0) {
                const float* xin = isctx ? F.in[I_CTX] + ((size_t)b * 256 + p) * 1024 : F.in[I_X] + ((size_t)b * 4096 + (p - 256)) * 1024;
#pragma unroll
                for (int c = 0; c < 2; ++c) { v[q][2 * c] = *(const f32x4*)(xin + lc + 512 * c); v[q][2 * c + 1] = *(const f32x4*)(xin + lc + 512 * c + 4); }
            } else if (act[q]) {
#pragma unroll
                for (int c = 0; c < 2; ++c) xw[q][c] = *(const u32x4*)(XB + (size_t)R * 1024 + lc + 512 * c);
                const u32x4 sl = slv[q];
#pragma unroll
                for (int c = 0; c < 2; ++c) {
                    yv[q][c][0] = *(const u32x2*)(ybuf + (size_t)sl.x * 1024 + lc + 512 * c); yv[q][c][1] = *(const u32x2*)(ybuf + (size_t)sl.y * 1024 + lc + 512 * c);
                    yv[q][c][2] = *(const u32x2*)(ybuf + (size_t)sl.z * 1024 + lc + 512 * c); yv[q][c][3] = *(const u32x2*)(ybuf + (size_t)sl.w * 1024 + lc + 512 * c); }
            }
        }
#pragma unroll
        for (int q = 0; q < NQ; ++q) {
            if (!act[q]) continue;
            const int R = R0 + q;
            if (MODE >= 1) {
                const float* g2 = modv(F, l - 1, mir[q], 5);
#pragma unroll
                for (int c = 0; c < 2; ++c) {
                    f32x4 s0 = (f32x4){0.f, 0.f, 0.f, 0.f}, s1 = s0;
#pragma unroll
                    for (int k = 0; k < 4; ++k) { f32x4 a0, a1; unpack8f8(yv[q][c][k], a0, a1); s0 += a0; s1 += a1; }
                    f32x4 x0, x1; unpack8(xw[q][c], x0, x1);
                    v[q][2 * c] = x0 + (*(const f32x4*)(g2 + lc + 512 * c) * (1.f / YSCL)) * s0; v[q][2 * c + 1] = x1 + (*(const f32x4*)(g2 + lc + 512 * c + 4) * (1.f / YSCL)) * s1;
                    if (MODE == 1) *(u32x4*)(XB + (size_t)R * 1024 + lc + 512 * c) = pack8(v[q][2 * c], v[q][2 * c + 1]);
                    else { const int b = R / TPB, p = R - b * TPB; float* xo = F.out + ((size_t)b * 4096 + (p - 256)) * 1024 + lc + 512 * c;
                        *(f32x4*)xo = v[q][2 * c]; *(f32x4*)(xo + 4) = v[q][2 * c + 1]; }
                }
            }
            if (MODE <= 1) {
                float ss = 0.f;
#pragma unroll
                for (int j = 0; j < 4; ++j) ss += (v[q][j][0] * v[q][j][0] + v[q][j][1] * v[q][j][1]) + (v[q][j][2] * v[q][j][2] + v[q][j][3] * v[q][j][3]);
                const float rstd = rsqrtf(wave_sum(ss) * (1.f / 1024.f) + EPS);
                const float* gn = F.in[I_N1G] + l * 1024; const float* sh = modv(F, l, mir[q], 0); const float* sc = modv(F, l, mir[q], 1);
#pragma unroll
                for (int c = 0; c < 2; ++c) { const int cc = lc + 512 * c;
                    const f32x4 h0 = v[q][2 * c] * rstd * *(const f32x4*)(gn + cc) * (*(const f32x4*)(sc + cc) + 1.f) + *(const f32x4*)(sh + cc);
                    const f32x4 h1 = v[q][2 * c + 1] * rstd * *(const f32x4*)(gn + cc + 4) * (*(const f32x4*)(sc + cc + 4) + 1.f) + *(const f32x4*)(sh + cc + 4);
                    *(u32x4*)(H + (size_t)R * 1024 + cc) = pack8(h0, h1);
                    int w0 = 0, w1 = 0; w0 = __builtin_amdgcn_cvt_pk_fp8_f32(h0[0], h0[1], w0, false); w0 = __builtin_amdgcn_cvt_pk_fp8_f32(h0[2], h0[3], w0, true);
                    w1 = __builtin_amdgcn_cvt_pk_fp8_f32(h1[0], h1[1], w1, false); w1 = __builtin_amdgcn_cvt_pk_fp8_f32(h1[2], h1[3], w1, true);
                    *(u32x2*)(H8 + (size_t)R * 1024 + cc) = (u32x2){(unsigned)w0, (unsigned)w1}; }
            }
        }
        if (MODE >= 1) {
#pragma unroll
            for (int q = 0; q < NQ; ++q) slv[q] = sln[q]; }
    }
}

__device__ __forceinline__ void p_final(const Frame& F) {
    const int gw = F.blk * 8 + F.wave, NGW = GRID * 8;
    const unsigned char* ybuf = F.ar + A_YBUF; const unsigned* seli = (const unsigned*)(F.ws + WS_SELI);
    const bf16_t* XB = (const bf16_t*)(F.ws + WS_XB);
    constexpr int NQ = 2;
    const int lc = F.lane * 4;
    u32x4 slv[NQ];
#pragma unroll
    for (int q = 0; q < NQ; ++q) { const int i = gw * NQ + q, R = (i >> 12) * TPB + CTXL + (i & 4095); slv[q] = *(const u32x4*)(seli + (size_t)R * 4); }
    for (int i0 = gw * NQ; i0 < NB * SEQ; i0 += NGW * NQ) {
        u32x2 xw[NQ][4]; unsigned yv[NQ][4][4]; u32x4 sln[NQ];
        { const int in = (i0 + NGW * NQ < NB * SEQ) ? i0 + NGW * NQ : i0;
#pragma unroll
          for (int q = 0; q < NQ; ++q) { const int i = in + q, R = (i >> 12) * TPB + CTXL + (i & 4095); sln[q] = *(const u32x4*)(seli + (size_t)R * 4); } }
#pragma unroll
        for (int q = 0; q < NQ; ++q) {
            const int i = i0 + q, R = (i >> 12) * TPB + CTXL + (i & 4095);
#pragma unroll
            for (int j = 0; j < 4; ++j) xw[q][j] = *(const u32x2*)(XB + (size_t)R * 1024 + lc + 256 * j);
            const u32x4 sl = slv[q];
#pragma unroll
            for (int j = 0; j < 4; ++j) {
                yv[q][j][0] = *(const unsigned*)(ybuf + (size_t)sl.x * 1024 + lc + 256 * j); yv[q][j][1] = *(const unsigned*)(ybuf + (size_t)sl.y * 1024 + lc + 256 * j);
                yv[q][j][2] = *(const unsigned*)(ybuf + (size_t)sl.z * 1024 + lc + 256 * j); yv[q][j][3] = *(const unsigned*)(ybuf + (size_t)sl.w * 1024 + lc + 256 * j); }
        }
#pragma unroll
        for (int q = 0; q < NQ; ++q) {
            const int i = i0 + q, b = i >> 12;
            const float* g2 = modv(F, 1, b, 5);
            float* xo = F.out + (size_t)i * 1024;
#pragma unroll
            for (int j = 0; j < 4; ++j) {
                f32x4 s = (f32x4){0.f, 0.f, 0.f, 0.f};
#pragma unroll
                for (int k = 0; k < 4; ++k) { const f32x2 a = __builtin_amdgcn_cvt_pk_f32_fp8((int)yv[q][j][k], false), c = __builtin_amdgcn_cvt_pk_f32_fp8((int)yv[q][j][k], true); s += (f32x4){a[0], a[1], c[0], c[1]}; }
                const f32x4 x = (f32x4){bf_lo(xw[q][j].x), bf_hi(xw[q][j].x), bf_lo(xw[q][j].y), bf_hi(xw[q][j].y)};
                *(f32x4*)(xo + lc + 256 * j) = x + (*(const f32x4*)(g2 + lc + 256 * j) * (1.f / YSCL)) * s;
            }
        }
#pragma unroll
        for (int q = 0; q < NQ; ++q) slv[q] = sln[q];
    }
}

template <int HD>
__device__ __forceinline__ void qk_norm_rope(bf16_t* p, const float* gain, float post, int pos, const f32x2* rt, bf16_t* po = nullptr) {
    if (!po) po = p;
    float x[HD];
#pragma unroll
    for (int i = 0; i < HD / 8; ++i) { const u32x4 w = *(const u32x4*)(p + 8 * i); x[8 * i] = bf_lo(w.x); x[8 * i + 1] = bf_hi(w.x); x[8 * i + 2] = bf_lo(w.y); x[8 * i + 3] = bf_hi(w.y);
        x[8 * i + 4] = bf_lo(w.z); x[8 * i + 5] = bf_hi(w.z); x[8 * i + 6] = bf_lo(w.w); x[8 * i + 7] = bf_hi(w.w); }
    float ss = 0.f;
#pragma unroll
    for (int i = 0; i < HD; ++i) ss += x[i] * x[i];
    const float r = rsqrtf(ss * (1.f / HD) + EPS);
#pragma unroll
    for (int i = 0; i < HD; ++i) x[i] = x[i] * r * gain[i];
    if (pos >= 0) {
        constexpr int Q = HD / 4; const int row = pos >> 6, col = pos & 63;
#pragma unroll
        for (int i = 0; i < Q; ++i) {
            const f32x2 cr = rt[row * Q + i], cc = rt[col * Q + i];
            const float a = x[i], b = x[i + Q]; x[i] = a * cr[0] - b * cr[1]; x[i + Q] = b * cr[0] + a * cr[1];
            const float c = x[2 * Q + i], d = x[3 * Q + i]; x[2 * Q + i] = c * cc[0] - d * cc[1]; x[3 * Q + i] = d * cc[0] + c * cc[1];
        }
    }
#pragma unroll
    for (int i = 0; i < HD / 8; ++i) { u32x4 w; w.x = cvt_pk(x[8 * i] * post, x[8 * i + 1] * post); w.y = cvt_pk(x[8 * i + 2] * post, x[8 * i + 3] * post);
        w.z = cvt_pk(x[8 * i + 4] * post, x[8 * i + 5] * post); w.w = cvt_pk(x[8 * i + 6] * post, x[8 * i + 7] * post); *(u32x4*)(po + 8 * i) = w; }
}

template <bool gdn_only = false, bool dry = false>
__device__ __forceinline__ void p_prep(const Frame& F, int l) {
    bf16_t* dummy = (bf16_t*)(F.ar + A_CH);
    const int gt = F.blk * 512 + F.tid, NT = GRID * 512;
    const f32x2* rope = (const f32x2*)(F.ws + WS_ROPE);
    if (!gdn_only) for (int idx = gt; idx < NR * 8; idx += NT) {
        const int R = idx >> 3, grp = idx & 7, p = R % TPB; const int pos = (p < CTXL) ? -1 : p - CTXL;
        qk_norm_rope<32>(ptile(F, T_AK) + (size_t)R * 256 + grp * 32, F.in[I_DAKG] + l * 32, 1.f, pos, rope, dry ? dummy + (size_t)R * 256 + grp * 32 : nullptr);
    }
    if (!gdn_only) for (int idx = gt; idx < NR * 2; idx += NT) {
        const int R = idx >> 1, grp = idx & 1, p = R % TPB; const int pos = (p < CTXL) ? -1 : p - CTXL;
        qk_norm_rope<64>(ptile(F, T_GKV) + (size_t)R * 256 + grp * 64, F.in[I_GAKG] + l * 64, 1.f, pos, rope + 512, dry ? dummy + (size_t)R * 256 + grp * 64 : nullptr);
    }
    if (dry) return;
    const int gw = F.blk * 8 + F.wave, NGW = GRID * 8;
    bf16_t* Gq = (bf16_t*)(F.ar + A_H); bf16_t* Gk = Gq + (size_t)NR * 256; bf16_t* Gv = Gk + (size_t)NR * 256;
    float* GB = (float*)(F.ws + WS_GB);
    const float* cw = F.in[I_CONVW] + (size_t)l * 5 * 768;
    const int c = F.lane * 4;
    f32x4 cwv[5][3];
#pragma unroll
    for (int j = 0; j < 5; ++j)
#pragma unroll
        for (int part = 0; part < 3; ++part) cwv[j][part] = *(const f32x4*)(cw + j * 768 + part * 256 + c);
    const f32x4 vg = *(const f32x4*)(F.in[I_GMVG] + l * 256 + c);
    for (int G4 = gw; G4 < NR / 4; G4 += NGW) {
        const int R0 = G4 * 4, p0 = R0 % TPB, Rb = R0 - p0;
        const int lo = (p0 < CTXL) ? 0 : CTXL, hi = (p0 < CTXL) ? CTXL : TPB;
        u32x2 win[8][3];
#pragma unroll
        for (int w = 0; w < 8; ++w) { const int pp = p0 - 2 + w; const int pc = pp < lo ? lo : (pp >= hi ? hi - 1 : pp);
#pragma unroll
            for (int part = 0; part < 3; ++part) win[w][part] = *(const u32x2*)(ptile(F, T_DQ + part) + (size_t)(Rb + pc) * 256 + c); }
        u32x2 vw[4];
        if (!gdn_only) {
#pragma unroll
            for (int r = 0; r < 4; ++r) vw[r] = *(const u32x2*)(ptile(F, T_MV) + (size_t)(R0 + r) * 256 + c);
        }
        float ab; { const int rr = F.lane >> 4, cc = F.lane & 15; ab = bf2f(ptile(F, T_DAB)[(size_t)(R0 + rr) * 256 + cc]); }
#pragma unroll
        for (int w = 0; w < 8; ++w) { const int pp = p0 - 2 + w; if (pp < lo || pp >= hi) {
#pragma unroll
            for (int part = 0; part < 3; ++part) win[w][part] = (u32x2){0u, 0u}; } }
        if (!gdn_only) {
#pragma unroll
            for (int r = 0; r < 4; ++r) {
                const float v0 = gelu_erf(bf_lo(vw[r].x)), v1 = gelu_erf(bf_hi(vw[r].x)), v2 = gelu_erf(bf_lo(vw[r].y)), v3 = gelu_erf(bf_hi(vw[r].y));
                const float rs = rsqrtf(wave_sum((v0 * v0 + v1 * v1) + (v2 * v2 + v3 * v3)) * (1.f / 256.f) + EPS);
                u32x2 o; o.x = cvt_pk(v0 * rs * vg[0], v1 * rs * vg[1]); o.y = cvt_pk(v2 * rs * vg[2], v3 * rs * vg[3]); *(u32x2*)(ptile(F, T_MV) + (size_t)(R0 + r) * 256 + c) = o;
            }
        }
#pragma unroll
        for (int r = 0; r < 4; ++r) {
            float y[3][4];
#pragma unroll
            for (int part = 0; part < 3; ++part) {
                f32x4 a = (f32x4){0.f, 0.f, 0.f, 0.f};
#pragma unroll
                for (int j = 0; j < 5; ++j) { const u32x2 w = win[r + j][part]; a += (f32x4){bf_lo(w.x), bf_hi(w.x), bf_lo(w.y), bf_hi(w.y)} * cwv[j][part]; }
#pragma unroll
                for (int i = 0; i < 4; ++i) y[part][i] = siluf_(a[i]);
            }
            float sq = (y[0][0] * y[0][0] + y[0][1] * y[0][1]) + (y[0][2] * y[0][2] + y[0][3] * y[0][3]);
            float sk = (y[1][0] * y[1][0] + y[1][1] * y[1][1]) + (y[1][2] * y[1][2] + y[1][3] * y[1][3]);
            sq = sum16(sq); sk = sum16(sk);
            const float rq = rsqrtf(sq + EPS) * 0.125f, rk = rsqrtf(sk + EPS);
            const size_t off = (size_t)(R0 + r) * 256 + c;
            u32x2 o; o.x = cvt_pk(y[0][0] * rq, y[0][1] * rq); o.y = cvt_pk(y[0][2] * rq, y[0][3] * rq); *(u32x2*)(Gq + off) = o;
            o.x = cvt_pk(y[1][0] * rk, y[1][1] * rk); o.y = cvt_pk(y[1][2] * rk, y[1][3] * rk); *(u32x2*)(Gk + off) = o;
            o.x = cvt_pk(y[2][0], y[2][1]); o.y = cvt_pk(y[2][2], y[2][3]); *(u32x2*)(Gv + off) = o;
        }
        {
            const int rr = F.lane >> 4, cc = F.lane & 15;
            float r;
            if (cc < 8) { const float xx = ab + F.in[I_DTB][l * 8 + cc]; const float ex = __expf(fminf(xx, 20.f)); const float sp = (xx > 20.f) ? xx : ((xx < -4.f) ? ex * (1.f - ex * (0.5f - ex * (1.f / 3.f))) : __logf(1.f + ex)); r = -__expf(F.in[I_ALOG][l * 8 + cc]) * sp; }
            else r = sigmoidf_(ab);
            GB[(size_t)(R0 + rr) * 16 + cc] = r;
        }
    }
}
__device__ __forceinline__ s16x4 tr_read(const LAS unsigned char* p) { return __builtin_bit_cast(s16x4, __builtin_amdgcn_ds_read_tr16_b64_v4i16((LAS v4i16_t*)p)); }
__device__ __forceinline__ bf16x8 cat8(const s16x4 lo, const s16x4 hi) { return (bf16x8){lo[0], lo[1], lo[2], lo[3], hi[0], hi[1], hi[2], hi[3]}; }
#define MFMA32(a, b, c) __builtin_amdgcn_mfma_f32_32x32x16_bf16((a), (b), (c), 0, 0, 0)
#define MFMA16(a, b, c) __builtin_amdgcn_mfma_f32_16x16x32_bf16((a), (b), (c), 0, 0, 0)
constexpr int KP = 144, VP = 192;
constexpr int ATT_KT = 64;
constexpr int ATT_K_OFF = 0, ATT_V_OFF = ATT_KT * KP;

template <int HD>
__device__ __forceinline__ void q_prep(bf16x8 (&qf)[HD / 16], const bf16_t* qrow, const float* gain, float post, int pos, const f32x2* rt, int h2) {
    constexpr int NKS = HD / 16, Q = HD / 4;
    float x[NKS][8];
#pragma unroll
    for (int ks = 0; ks < NKS; ++ks) { const u32x4 w = *(const u32x4*)(qrow + 16 * ks + 8 * h2);
        x[ks][0] = bf_lo(w.x); x[ks][1] = bf_hi(w.x); x[ks][2] = bf_lo(w.y); x[ks][3] = bf_hi(w.y); x[ks][4] = bf_lo(w.z); x[ks][5] = bf_hi(w.z); x[ks][6] = bf_lo(w.w); x[ks][7] = bf_hi(w.w); }
    float ss = 0.f;
#pragma unroll
    for (int ks = 0; ks < NKS; ++ks)
#pragma unroll
        for (int j = 0; j < 8; ++j) ss += x[ks][j] * x[ks][j];
    const float rr = rsqrtf(add_xor32(ss) * (1.f / HD) + EPS);
#pragma unroll
    for (int ks = 0; ks < NKS; ++ks) { const f32x4 g0 = *(const f32x4*)(gain + 16 * ks + 8 * h2), g1 = *(const f32x4*)(gain + 16 * ks + 8 * h2 + 4);
#pragma unroll
        for (int j = 0; j < 4; ++j) { x[ks][j] *= rr * g0[j]; x[ks][4 + j] *= rr * g1[j]; } }
    if (pos >= 0) {
        const int row = pos >> 6, col = pos & 63;
        if (HD == 64) {
#pragma unroll
            for (int j = 0; j < 8; ++j) {
                const f32x2 cr = rt[row * Q + 8 * h2 + j], cc = rt[col * Q + 8 * h2 + j];
                const float a = x[0][j], b = x[1][j]; x[0][j] = a * cr[0] - b * cr[1]; x[1][j] = b * cr[0] + a * cr[1];
                const float c = x[NKS - 2][j], d = x[NKS - 1][j]; x[NKS - 2][j] = c * cc[0] - d * cc[1]; x[NKS - 1][j] = d * cc[0] + c * cc[1];
            }
        } else {
#pragma unroll
            for (int j = 0; j < 8; ++j) {
                const f32x2 cr = rt[row * Q + j], cc = rt[col * Q + j];
                const auto s0 = __builtin_amdgcn_permlane32_swap(__float_as_uint(x[0][j]), __float_as_uint(x[0][j]), false, false);
                const auto s1 = __builtin_amdgcn_permlane32_swap(__float_as_uint(x[1][j]), __float_as_uint(x[1][j]), false, false);
                const float pa = __uint_as_float(h2 ? s0[0] : s0[1]), pc = __uint_as_float(h2 ? s1[0] : s1[1]);
                x[0][j] = h2 ? (x[0][j] * cr[0] + pa * cr[1]) : (x[0][j] * cr[0] - pa * cr[1]);
                x[1][j] = h2 ? (x[1][j] * cc[0] + pc * cc[1]) : (x[1][j] * cc[0] - pc * cc[1]);
            }
        }
    }
#pragma unroll
    for (int ks = 0; ks < NKS; ++ks) { u32x4 w; w.x = cvt_pk(x[ks][0] * post, x[ks][1] * post); w.y = cvt_pk(x[ks][2] * post, x[ks][3] * post); w.z = cvt_pk(x[ks][4] * post, x[ks][5] * post); w.w = cvt_pk(x[ks][6] * post, x[ks][7] * post);
        qf[ks] = __builtin_bit_cast(bf16x8, w); }
}

template <int HD, int NMAP, bool DIFF>
__device__ __forceinline__ void attn_unit(const Frame& F, const bf16_t* Qb, int qcol, const bf16_t* Kb, int kcol, const bf16_t* Vb, int vcol, bf16_t* Ob, int ocol,
                                          int b, int qt, float lam, float fin_scale, const float* subg, const float* qgain, float qpost, const f32x2* qrt) {
    const int lane = F.lane, r = lane & 31, h2 = lane >> 5, x = lane & 15, g1 = (lane >> 4) & 1;
    const size_t R0 = (size_t)b * TPB + (size_t)qt * 256 + F.wave * 32;
    const int nkt = (qt == 0) ? 256 / ATT_KT : 4352 / ATT_KT;
    constexpr int NKS = HD / 16;
    bf16x8 qf[NMAP][NKS];
    { const int qpos = (qt == 0) ? -1 : (qt - 1) * 256 + F.wave * 32 + r;
#pragma unroll
      for (int m = 0; m < NMAP; ++m) q_prep<HD>(qf[m], Qb + (R0 + r) * 256 + qcol + m * HD, qgain, qpost, qpos, qrt, h2); }
    f32x16 O[NMAP][2]; float lsum[NMAP];
#pragma unroll
    for (int m = 0; m < NMAP; ++m) { lsum[m] = 0.f;
#pragma unroll
        for (int d = 0; d < 2; ++d)
#pragma unroll
            for (int i = 0; i < 16; ++i) O[m][d][i] = 0.f; }
    constexpr int ATT_BUF = ATT_KT * KP + ATT_KT * VP;
    constexpr int NST = ATT_KT / 64;
    const int skey = F.tid >> 3, sseg = F.tid & 7;
    const bf16_t* kg = Kb + ((size_t)b * TPB + skey) * 256 + kcol + sseg * 8;
    const bf16_t* vg = Vb + ((size_t)b * TPB + skey) * 256 + vcol + sseg * 8;
    u32x4 kreg[NST], vreg[NST];
#pragma unroll
    for (int i = 0; i < NST; ++i) { kreg[i] = *(const u32x4*)(kg + (size_t)(64 * i) * 256); vreg[i] = *(const u32x4*)(vg + (size_t)(64 * i) * 256); }
    __syncthreads();
#pragma unroll
    for (int i = 0; i < NST; ++i) { *(LAS u32x4*)(F.lds + ATT_K_OFF + (skey + 64 * i) * KP + sseg * 16) = kreg[i]; *(LAS u32x4*)(F.lds + ATT_V_OFF + (skey + 64 * i) * VP + sseg * 16) = vreg[i]; }
    __syncthreads();
    for (int kt = 0; kt < nkt; ++kt) {
        LAS unsigned char* Ks = F.lds + (kt & 1) * ATT_BUF + ATT_K_OFF; LAS unsigned char* Vs = F.lds + (kt & 1) * ATT_BUF + ATT_V_OFF;
        if (kt + 1 < nkt) {
#pragma unroll
            for (int i = 0; i < NST; ++i) { kreg[i] = *(const u32x4*)(kg + (size_t)((kt + 1) * ATT_KT + 64 * i) * 256); vreg[i] = *(const u32x4*)(vg + (size_t)((kt + 1) * ATT_KT + 64 * i) * 256); } }
#pragma unroll
        for (int grp = 0; grp < ATT_KT / 32; ++grp) {
            f32x16 S[2];
            bf16x8 kfr[2][NKS];
#pragma unroll
            for (int t = 0; t < 2; ++t) {
                const int kb = (NMAP == 2) ? grp : t, m = (NMAP == 2) ? t : 0;
#pragma unroll
                for (int ks = 0; ks < NKS; ++ks) kfr[t][ks] = *(const LAS bf16x8*)(Ks + (kb * 32 + r) * KP + ((DIFF ? m * HD : 0) + 16 * ks + 8 * h2) * 2);
            }
#pragma unroll
            for (int t = 0; t < 2; ++t)
#pragma unroll
                for (int ks = 0; ks < NKS; ++ks) { asm volatile("" : "+v"(kfr[t][ks])); }
#pragma unroll
            for (int t = 0; t < 2; ++t) {
                const int m = (NMAP == 2) ? t : 0;
                const f32x16 half16 = {0.5f, 0.5f, 0.5f, 0.5f, 0.5f, 0.5f, 0.5f, 0.5f, 0.5f, 0.5f, 0.5f, 0.5f, 0.5f, 0.5f, 0.5f, 0.5f};
                S[t] = MFMA32(kfr[t][0], qf[m][0], half16);
#pragma unroll
                for (int ks = 1; ks < NKS; ++ks) S[t] = MFMA32(kfr[t][ks], qf[m][ks], S[t]);
            }
            bf16x8 vf[(NMAP == 2) ? 1 : 2][2][2];
#pragma unroll
            for (int t = 0; t < ((NMAP == 2) ? 1 : 2); ++t) {
                const int kb = (NMAP == 2) ? grp : t;
#pragma unroll
                for (int d = 0; d < 2; ++d)
#pragma unroll
                    for (int s2 = 0; s2 < 2; ++s2) {
                        const LAS unsigned char* vp = Vs + (kb * 32 + 16 * s2 + 4 * h2 + (x >> 2)) * VP + (32 * d + 16 * g1 + 4 * (x & 3)) * 2;
                        vf[t][d][s2] = cat8(tr_read(vp), tr_read(vp + 8 * VP));
                    }
            }
#pragma unroll
            for (int t = 0; t < 2; ++t) {
                const int m = (NMAP == 2) ? t : 0, vt = (NMAP == 2) ? 0 : t;
                bf16x8 pb[2];
#pragma unroll
                for (int s2 = 0; s2 < 2; ++s2) {
                    unsigned w[4];
#pragma unroll
                    for (int j = 0; j < 4; ++j) {
                        w[j] = __builtin_bit_cast(unsigned, __builtin_amdgcn_cvt_pknorm_i16(S[t][8 * s2 + 2 * j], S[t][8 * s2 + 2 * j + 1]));
                        lsum[m] = __builtin_amdgcn_fdot2_f32_bf16(__builtin_bit_cast(bf16x2_t, w[j]), __builtin_bit_cast(bf16x2_t, 0x3f803f80u), lsum[m], false); }
                    pb[s2] = __builtin_bit_cast(bf16x8, (u32x4){w[0], w[1], w[2], w[3]});
                }
#pragma unroll
                for (int d = 0; d < 2; ++d)
#pragma unroll
                    for (int s2 = 0; s2 < 2; ++s2) O[m][d] = MFMA32(vf[vt][d][s2], pb[s2], O[m][d]);
            }
        }
        if (kt + 1 < nkt) { LAS unsigned char* nb = F.lds + ((kt + 1) & 1) * ATT_BUF;
#pragma unroll
            for (int i = 0; i < NST; ++i) { *(LAS u32x4*)(nb + ATT_K_OFF + (skey + 64 * i) * KP + sseg * 16) = kreg[i]; *(LAS u32x4*)(nb + ATT_V_OFF + (skey + 64 * i) * VP + sseg * 16) = vreg[i]; } }
        __syncthreads();
    }
    float inv[NMAP];
#pragma unroll
    for (int m = 0; m < NMAP; ++m) inv[m] = 1.f / add_xor32(lsum[m]);
    bf16_t* op = Ob + (R0 + r) * 256 + ocol;
    if (DIFF) {
        float ss = 0.f;
#pragma unroll
        for (int d = 0; d < 2; ++d)
#pragma unroll
            for (int i = 0; i < 16; ++i) { const float v = O[0][d][i] * inv[0] - lam * (O[NMAP - 1][d][i] * inv[NMAP - 1]); O[0][d][i] = v; ss += v * v; }
        ss = add_xor32(ss);
        const float rr = rsqrtf(ss * (1.f / 64.f) + EPS) * fin_scale;
#pragma unroll
        for (int d = 0; d < 2; ++d)
#pragma unroll
            for (int g4 = 0; g4 < 4; ++g4) { const int dv0 = 32 * d + 8 * g4 + 4 * h2; const f32x4 sg = *(const f32x4*)(subg + dv0);
                u32x2 o; o.x = cvt_pk(O[0][d][4 * g4] * rr * sg[0], O[0][d][4 * g4 + 1] * rr * sg[1]); o.y = cvt_pk(O[0][d][4 * g4 + 2] * rr * sg[2], O[0][d][4 * g4 + 3] * rr * sg[3]);
                *(u32x2*)(op + dv0) = o; }
    } else {
#pragma unroll
        for (int m = 0; m < NMAP; ++m)
#pragma unroll
            for (int d = 0; d < 2; ++d)
#pragma unroll
                for (int g4 = 0; g4 < 4; ++g4) { const int dv0 = 32 * d + 8 * g4 + 4 * h2;
                    u32x2 o; o.x = cvt_pk(O[m][d][4 * g4] * inv[m], O[m][d][4 * g4 + 1] * inv[m]); o.y = cvt_pk(O[m][d][4 * g4 + 2] * inv[m], O[m][d][4 * g4 + 3] * inv[m]);
                    *(u32x2*)(op + m * HD + dv0) = o; }
    }
}

__device__ __forceinline__ void gmlp_unit(const Frame& F, int l, int b, int chunk, int g, bf16_t* dry = nullptr) {
    const int lane = F.lane, r = lane & 31, h2 = lane >> 5, x = lane & 15, g1 = (lane >> 4) & 1;
    const size_t R0 = (size_t)b * TPB + (size_t)chunk * 128;
    LAS unsigned char* Vs = F.lds;
    const bf16_t* vsrc = ptile(F, T_MV) + R0 * 256 + g * 64;
    __syncthreads();
#pragma unroll
    for (int i = 0; i < 2; ++i) { const int pc = F.tid + i * 512, q = pc >> 3, seg = pc & 7; *(LAS u32x4*)(Vs + q * VP + seg * 16) = *(const u32x4*)(vsrc + (size_t)q * 256 + seg * 8); }
    __syncthreads();
    const int cb = F.wave & 1, pb = F.wave >> 1;
    const bf16_t* ws = (const bf16_t*)(F.ws + WS_GMWS) + ((size_t)(l * 4 + g) * 128 + pb * 32 + r) * 128 + 8 * h2;
    f32x16 acc;
#pragma unroll
    for (int i = 0; i < 16; ++i) acc[i] = 0.f;
#pragma unroll
    for (int ks = 0; ks < 8; ++ks) {
        const LAS unsigned char* vp = Vs + (16 * ks + 8 * h2 + (x >> 2)) * VP + (32 * cb + 16 * g1 + 4 * (x & 3)) * 2;
        const bf16x8 af = cat8(tr_read(vp), tr_read(vp + 4 * VP));
        const bf16x8 bfr = *(const bf16x8*)(ws + 16 * ks);
        acc = MFMA32(af, bfr, acc);
    }
    const int pp = pb * 32 + r; const float bs = F.in[I_GMBS][(l * 4 + g) * 128 + pp];
    bf16_t* up = ptile(F, T_MU) + (R0 + pp) * 256 + g * 64 + cb * 32;
#pragma unroll
    for (int g4 = 0; g4 < 4; ++g4) { const int c0 = 8 * g4 + 4 * h2; const u32x2 uw = *(const u32x2*)(up + c0);
        u32x2 o; o.x = cvt_pk(gelu_erf(bf_lo(uw.x)) * (acc[4 * g4] + bs), gelu_erf(bf_hi(uw.x)) * (acc[4 * g4 + 1] + bs)); o.y = cvt_pk(gelu_erf(bf_lo(uw.y)) * (acc[4 * g4 + 2] + bs), gelu_erf(bf_hi(uw.y)) * (acc[4 * g4 + 3] + bs));
        *(u32x2*)((dry ? dry + (R0 + pp) * 256 + g * 64 + cb * 32 : up) + c0) = o; }
}
__device__ __forceinline__ int chunk_p(int dir, int n, int i) { const int f = 64 * n + i; return dir == 0 ? f : (n < 4 ? 255 - f : 4351 + 256 - f); }
__device__ __forceinline__ int crow16(int i, int h2) { return (i & 3) + 8 * (i >> 2) + 4 * h2; }
__device__ __forceinline__ int img_idx(int row, int k) { const int kk = k & 31; return (((row >> 4) * 2 + (k >> 5)) * 64 + ((kk >> 2) & 3) * 16 + (row & 15)) * 8 + 4 * (kk >> 4) + (kk & 3); }
constexpr int CH_NW = 0, CH_QD = 8192, CH_QK = 16384, CH_KDT = 24576, CH_U = 32768;

constexpr int CHS_BYTES = 33792;
__device__ __forceinline__ void gdn_chunk_phase(const Frame& F) {
    const int slot = F.wave >> 1, ws2 = F.wave & 1;
    LAS float* Am = (LAS float*)(F.lds + slot * CHS_BYTES); LAS float* gcv = Am + 4096; LAS float* btv = gcv + 64; LAS float* egv = btv + 64; LAS float* dkv = egv + 64;
    LAS bf16_t* kvt = (LAS bf16_t*)(F.lds + slot * CHS_BYTES + 17408);
    const bf16_t* Gq = (const bf16_t*)(F.ar + A_H); const bf16_t* Gk = Gq + (size_t)NR * 256; const bf16_t* Gv = Gk + (size_t)NR * 256;
    const float* GB = (const float*)(F.ws + WS_GB);
    float* CHG = (float*)(F.ws + WS_CHG);
    for (int it0 = F.blk * 4; it0 < 8704; it0 += GRID * 4) {
        int tq = F.tid; asm volatile("" : "+v"(tq));
        const int t2 = tq & 127, lane = tq & 63, r = lane & 31, h2 = lane >> 5;
        const int item = it0 + slot; const int n = item % 68, h = (item / 68) & 3, b = (item / 272) & 15, dir = item / 4352;
        unsigned char* chp = F.ar + A_CH + (size_t)item * CH_ITEM;
        const size_t Rb = (size_t)b * TPB;
        __syncthreads();
        u32x4 stg[8];
#pragma unroll
        for (int j = 0; j < 8; ++j) { const int pc = t2 + 128 * j, i = pc >> 4, seg = pc & 15;
            stg[j] = *(const u32x4*)(((seg < 8) ? Gk : Gv) + (Rb + chunk_p(dir, n, i)) * 256 + 64 * h + (seg & 7) * 8); }
        bf16x8 qfr[2][4];
#pragma unroll
        for (int tI = 0; tI < 2; ++tI)
#pragma unroll
            for (int ks = 0; ks < 4; ++ks) qfr[tI][ks] = *(const bf16x8*)(Gq + (Rb + chunk_p(dir, n, 32 * tI + r)) * 256 + 64 * h + 8 * h2 + 16 * ks);
#pragma unroll
        for (int j = 0; j < 8; ++j) { const int pc = t2 + 128 * j, i = pc >> 4, seg = pc & 15; *(LAS u32x4*)(kvt + i * 128 + seg * 8) = stg[j]; }
        if (ws2 == 0) {
            const size_t R = Rb + chunk_p(dir, n, lane);
            float g = GB[R * 16 + dir * 4 + h]; const float bt = GB[R * 16 + 8 + dir * 4 + h];
#pragma unroll
            for (int o = 1; o < 64; o <<= 1) { const float t = __int_as_float(__builtin_amdgcn_ds_bpermute(((lane - o) & 63) << 2, __float_as_int(g))); if (lane >= o) g += t; }
            const float gl = __int_as_float(__builtin_amdgcn_readlane(__float_as_int(g), 63));
            gcv[lane] = g; btv[lane] = bt; egv[lane] = __expf(g); dkv[lane] = __expf(gl - g);
            if (lane == 0) CHG[item] = __expf(gl);
        }
        __syncthreads();
        u32x2 qpa[4], qpb[4];
#pragma unroll
        for (int t = 0; t < 4; ++t) { const int pidx = t2 + 128 * t, lp = pidx & 63, q4 = lp >> 4, row = lp & 15, rs = pidx >> 6, rb = rs >> 1, s2 = rs & 1;
            const bf16_t* qp = Gq + (Rb + chunk_p(dir, n, 16 * rb + row)) * 256 + 64 * h + 32 * s2 + 4 * q4;
            qpa[t] = *(const u32x2*)qp; qpb[t] = *(const u32x2*)(qp + 16); }
        if (ws2 == 0) {
#pragma unroll
            for (int tI = 0; tI < 2; ++tI)
#pragma unroll
                for (int tJ = 0; tJ <= tI; ++tJ) {
                    f32x16 acc;
#pragma unroll
                    for (int i = 0; i < 16; ++i) acc[i] = 0.f;
#pragma unroll
                    for (int ks = 0; ks < 4; ++ks) {
                        const bf16x8 af = *(const LAS bf16x8*)(kvt + (32 * tI + r) * 128 + 16 * ks + 8 * h2);
                        const bf16x8 bf = *(const LAS bf16x8*)(kvt + (32 * tJ + r) * 128 + 16 * ks + 8 * h2);
                        acc = MFMA32(af, bf, acc);
                    }
                    const int j = 32 * tJ + r; const float gj = gcv[j];
                    LAS float* ab = Am + (4 * h2) * 64 + j; const LAS float* gb = gcv + 4 * h2; const int dj = 4 * h2 - j;
#pragma unroll
                    for (int i = 0; i < 16; ++i) { const int io = 32 * tI + (i & 3) + 8 * (i >> 2);
                        const float val = gb[64 + io] * acc[i] * __expf(fminf(gb[io] - gj, 0.f));
                        ab[io * 64] = (io + dj > 0) ? val : 0.f; }
                }
        } else {
#pragma unroll
            for (int tJ = 0; tJ < 2; ++tJ)
#pragma unroll
                for (int tI = 0; tI < 2; ++tI) {
                    f32x16 acc;
#pragma unroll
                    for (int i = 0; i < 16; ++i) acc[i] = 0.f;
                    if (tJ <= tI) {
#pragma unroll
                        for (int ks = 0; ks < 4; ++ks) {
                            const bf16x8 af = *(const LAS bf16x8*)(kvt + (32 * tJ + r) * 128 + 16 * ks + 8 * h2);
                            acc = MFMA32(af, qfr[tI][ks], acc);
                        }
                    }
                    const int i = 32 * tI + r; const float gi = gcv[i];
                    const LAS float* gb = gcv + 4 * h2; const int di = i - 4 * h2;
                    unsigned char* qkp = chp + CH_QK + 2 * img_idx(i, 4 * h2);
#pragma unroll
                    for (int g4 = 0; g4 < 4; ++g4) {
                        float v[4];
#pragma unroll
                        for (int e = 0; e < 4; ++e) { const int jo = 32 * tJ + 8 * g4 + e; const float val = acc[4 * g4 + e] * __expf(fminf(gi - gb[jo], 0.f)); v[e] = (di >= jo) ? val : 0.f; }
                        u32x2 o; o.x = cvt_pk(v[0], v[1]); o.y = cvt_pk(v[2], v[3]);
                        *(u32x2*)(qkp + (tJ * 64 + ((2 * g4) & 3) * 16) * 16 + 8 * (g4 >> 1)) = o;
                    }
                }
        }
        __syncthreads();
        {
#pragma unroll
            for (int t = 0; t < 4; ++t) {
                const int pidx = t2 + 128 * t, lp = pidx & 63, q4 = lp >> 4, row = lp & 15, rs = pidx >> 6, rb = rs >> 1, s2 = rs & 1;
                const int i = 16 * rb + row, kdA = 32 * s2 + 4 * q4;
                const u32x2 qa = qpa[t], qb = qpb[t];
                const float eg = egv[i];
                u32x4 o; o.x = cvt_pk(bf_lo(qa.x) * eg, bf_hi(qa.x) * eg); o.y = cvt_pk(bf_lo(qa.y) * eg, bf_hi(qa.y) * eg); o.z = cvt_pk(bf_lo(qb.x) * eg, bf_hi(qb.x) * eg); o.w = cvt_pk(bf_lo(qb.y) * eg, bf_hi(qb.y) * eg);
                *(u32x4*)(chp + CH_QD + pidx * 16) = o;
                const int kd = i, cA = kdA;
                float kv[8];
#pragma unroll
                for (int e = 0; e < 8; ++e) { const int cc = cA + 16 * (e >> 2) + (e & 3); kv[e] = bf2f(kvt[cc * 128 + kd]) * dkv[cc]; }
                o.x = cvt_pk(kv[0], kv[1]); o.y = cvt_pk(kv[2], kv[3]); o.z = cvt_pk(kv[4], kv[5]); o.w = cvt_pk(kv[6], kv[7]);
                *(u32x4*)(chp + CH_KDT + pidx * 16) = o;
            }
        }
        {
            const int c = t2; const bool isw = c < 64;
            float X[64];
#pragma unroll
            for (int i = 0; i < 64; ++i) { const float val = bf2f(kvt[i * 128 + c]); X[i] = val * btv[i] * (isw ? egv[i] : 1.f); }
            __syncthreads();
            f32x4 ra[2][16];
#pragma unroll
            for (int q = 0; q < 1; ++q) ra[1][q] = *(const LAS f32x4*)(Am + 1 * 64 + 4 * q);
#pragma unroll
            for (int i = 1; i < 64; ++i) {
                if (i + 1 < 64) {
#pragma unroll
                    for (int q = 0; q < (i + 4) / 4; ++q) ra[(i + 1) & 1][q] = *(const LAS f32x4*)(Am + (i + 1) * 64 + 4 * q);
                }
#pragma unroll
                for (int q = 0; q < (i + 3) / 4; ++q) asm volatile("" : "+v"(ra[i & 1][q]));
                float s0 = X[i], s1 = 0.f;
#pragma unroll
                for (int j = 0; j < i; ++j) { if (j & 1) s1 -= ra[i & 1][j >> 2][j & 3] * X[j]; else s0 -= ra[i & 1][j >> 2][j & 3] * X[j]; }
                X[i] = s0 + s1;
            }
#pragma unroll
            for (int i = 0; i < 64; ++i) kvt[i * 128 + c] = f2bf(X[i]);
        }
        __syncthreads();
        {
#pragma unroll
            for (int t = 0; t < 4; ++t) {
                const int pidx = t2 + 128 * t, lp = pidx & 63, q4 = lp >> 4, row = lp & 15, rs = pidx >> 6, rb = rs >> 1, s2 = rs & 1;
                const int i = 16 * rb + row, kdA = 32 * s2 + 4 * q4;
                const u32x2 wa = *(const LAS u32x2*)(kvt + i * 128 + kdA), wb = *(const LAS u32x2*)(kvt + i * 128 + kdA + 16);
                u32x4 o; o.x = wa.x ^ 0x80008000u; o.y = wa.y ^ 0x80008000u; o.z = wb.x ^ 0x80008000u; o.w = wb.y ^ 0x80008000u;
                *(u32x4*)(chp + CH_NW + pidx * 16) = o;
            }
#pragma unroll
            for (int t = 0; t < 2; ++t) {
                const int pidx = t2 + 128 * t, sl = pidx >> 6, lp = pidx & 63, q4 = lp >> 4, vcol = 64 + 16 * sl + (lp & 15);
                unsigned w[8];
#pragma unroll
                for (int e = 0; e < 8; ++e) { const int i0 = 16 * (e >> 1) + 4 * q4 + 2 * (e & 1); w[e] = (unsigned)kvt[i0 * 128 + vcol] | ((unsigned)kvt[(i0 + 1) * 128 + vcol] << 16); }
                *(u32x4*)(chp + CH_U + pidx * 32) = (u32x4){w[0], w[1], w[2], w[3]}; *(u32x4*)(chp + CH_U + pidx * 32 + 16) = (u32x4){w[4], w[5], w[6], w[7]};
            }
        }
    }
}

__device__ __forceinline__ void gdn_scan_phase(const Frame& F, int l) {
    constexpr bool do_finish = true;
    const int lane = F.lane, q = lane >> 4, dir = F.wave >> 2, sl = F.wave & 3;
    const float* CHG = (const float*)(F.ws + WS_CHG);
    bf16_t* Ob0 = ptile(F, T_DQ); bf16_t* Ob1 = ptile(F, T_DK);
    for (int bh = F.blk; bh < 64; bh += GRID) {
        const int b = bh >> 2, h = bh & 3;
        const int item0d0 = ((0 * 16 + b) * 4 + h) * 68, item0d1 = ((1 * 16 + b) * 4 + h) * 68;
        const int item0 = dir ? item0d1 : item0d0;
        f32x4 S[4];
#pragma unroll
        for (int kb = 0; kb < 4; ++kb) S[kb] = (f32x4){0.f, 0.f, 0.f, 0.f};
        __syncthreads();
#define GDN_ISSUE(n_) do { _Pragma("unroll") for (int i_ = 0; i_ < 8; ++i_) { const int pc_ = F.wave * 8 + i_, d_ = pc_ >> 5, off_ = (pc_ & 31) * 1024; \
                const unsigned char* src_ = F.ar + A_CH + (size_t)((d_ ? item0d1 : item0d0) + (n_)) * CH_ITEM + off_ + lane * 16; \
                __builtin_amdgcn_global_load_lds((const unsigned*)src_, (LAS unsigned*)(F.lds + ((n_) & 1) * 65536 + d_ * 32768 + off_), 16, 0, 0); } } while (0)
        GDN_ISSUE(0);
        bf16_t* Ob = dir ? Ob1 : Ob0;
        for (int n = 0; n < 68; ++n) {
            const unsigned char* chp = F.ar + A_CH + (size_t)(item0 + n) * CH_ITEM;
            const u32x4 u0 = *(const u32x4*)(chp + CH_U + (sl * 64 + lane) * 32), u1 = *(const u32x4*)(chp + CH_U + (sl * 64 + lane) * 32 + 16);
            const float gl = CHG[item0 + n];
            VM_WAIT();
            __syncthreads();
            if (n + 1 < 68) GDN_ISSUE(n + 1);
            const LAS unsigned char* base = F.lds + (n & 1) * 65536 + dir * 32768 + lane * 16;
#define FRAG(mat, rb, s) (*(const LAS bf16x8*)(base + (mat) + ((rb) * 2 + (s)) * 1024))
            bf16x8 bS[2], bV[2];
#pragma unroll
            for (int s = 0; s < 2; ++s) { u32x4 w; w.x = cvt_pk(S[2 * s][0], S[2 * s][1]); w.y = cvt_pk(S[2 * s][2], S[2 * s][3]); w.z = cvt_pk(S[2 * s + 1][0], S[2 * s + 1][1]); w.w = cvt_pk(S[2 * s + 1][2], S[2 * s + 1][3]); bS[s] = __builtin_bit_cast(bf16x8, w); }
            f32x4 vn[4];
            vn[0] = (f32x4){bf_lo(u0.x), bf_hi(u0.x), bf_lo(u0.y), bf_hi(u0.y)}; vn[1] = (f32x4){bf_lo(u0.z), bf_hi(u0.z), bf_lo(u0.w), bf_hi(u0.w)};
            vn[2] = (f32x4){bf_lo(u1.x), bf_hi(u1.x), bf_lo(u1.y), bf_hi(u1.y)}; vn[3] = (f32x4){bf_lo(u1.z), bf_hi(u1.z), bf_lo(u1.w), bf_hi(u1.w)};
#pragma unroll
            for (int rb = 0; rb < 4; ++rb)
#pragma unroll
                for (int s = 0; s < 2; ++s) vn[rb] = MFMA16(FRAG(CH_NW, rb, s), bS[s], vn[rb]);
#pragma unroll
            for (int s = 0; s < 2; ++s) { u32x4 w; w.x = cvt_pk(vn[2 * s][0], vn[2 * s][1]); w.y = cvt_pk(vn[2 * s][2], vn[2 * s][3]); w.z = cvt_pk(vn[2 * s + 1][0], vn[2 * s + 1][1]); w.w = cvt_pk(vn[2 * s + 1][2], vn[2 * s + 1][3]); bV[s] = __builtin_bit_cast(bf16x8, w); }
            f32x4 o[4];
#pragma unroll
            for (int rb = 0; rb < 4; ++rb) { o[rb] = (f32x4){0.f, 0.f, 0.f, 0.f};
#pragma unroll
                for (int s = 0; s < 2; ++s) { o[rb] = MFMA16(FRAG(CH_QD, rb, s), bS[s], o[rb]); o[rb] = MFMA16(FRAG(CH_QK, rb, s), bV[s], o[rb]); } }
#pragma unroll
            for (int kb = 0; kb < 4; ++kb) { S[kb] = S[kb] * gl;
#pragma unroll
                for (int s = 0; s < 2; ++s) S[kb] = MFMA16(FRAG(CH_KDT, kb, s), bV[s], S[kb]); }
#undef FRAG
#pragma unroll
            for (int rb = 0; rb < 4; ++rb)
#pragma unroll
                for (int e = 0; e < 4; ++e) { const int i = 16 * rb + 4 * q + e;
                    Ob[((size_t)b * TPB + chunk_p(dir, n, i)) * 256 + 64 * h + 16 * sl + (lane & 15)] = f2bf(o[rb][e]); }
        }
        VM_WAIT();
        __syncthreads();
        if (do_finish) {
            const int sub = F.tid >> 4, c = (F.tid & 15) * 4;
            const f32x4 og = *(const f32x4*)(F.in[I_GDOUTG] + l * 64 + c);
            for (int p0 = sub; p0 < TPB; p0 += 128) {
                u32x2 a0[4], a1[4], gw[4];
#pragma unroll
                for (int t = 0; t < 4; ++t) { const size_t off = ((size_t)b * TPB + p0 + 32 * t) * 256 + 64 * h + c;
                    a0[t] = *(const u32x2*)(Ob0 + off); a1[t] = *(const u32x2*)(Ob1 + off); gw[t] = *(const u32x2*)(ptile(F, T_DG) + off); }
#pragma unroll
                for (int t = 0; t < 4; ++t) { const size_t off = ((size_t)b * TPB + p0 + 32 * t) * 256 + 64 * h + c;
                    const float o0 = bf_lo(a0[t].x) + bf_lo(a1[t].x), o1 = bf_hi(a0[t].x) + bf_hi(a1[t].x), o2 = bf_lo(a0[t].y) + bf_lo(a1[t].y), o3 = bf_hi(a0[t].y) + bf_hi(a1[t].y);
                    const float ss = sum16((o0 * o0 + o1 * o1) + (o2 * o2 + o3 * o3));
                    const float rr = rsqrtf(ss * (1.f / 64.f) + EPS);
                    u32x2 w; w.x = cvt_pk(o0 * rr * og[0] * siluf_(bf_lo(gw[t].x)), o1 * rr * og[1] * siluf_(bf_hi(gw[t].x))); w.y = cvt_pk(o2 * rr * og[2] * siluf_(bf_lo(gw[t].y)), o3 * rr * og[3] * siluf_(bf_hi(gw[t].y)));
                    *(u32x2*)(ptile(F, T_DG) + off) = w; }
            }
        }
    }
}
constexpr int WRP = 1032;
constexpr int RT_WLO_OFF = 32 * WRP * 2;
constexpr int RT_REC_OFF = 2 * RT_WLO_OFF;
constexpr int RT_CNT_OFF = RT_REC_OFF + 288 * 4 * 4;
static_assert(RT_CNT_OFF + 256 <= MISC_OFF, "router LDS");

__device__ __forceinline__ void p_route1(const Frame& F, int l, int cl) {
    LAS bf16_t* whi = (LAS bf16_t*)F.lds; LAS bf16_t* wlo = (LAS bf16_t*)(F.lds + RT_WLO_OFF);
    LAS int* rec = (LAS int*)(F.lds + RT_REC_OFF); LAS int* lcnt = (LAS int*)(F.lds + RT_CNT_OFF); LAS int* lbase = lcnt + 32;
    __syncthreads();
    { const float* wr = F.in[I_WR] + (size_t)l * 1024 * 32;
      f32x4 t[16];
#pragma unroll
      for (int i = 0; i < 16; ++i) t[i] = *(const f32x4*)(wr + (size_t)(F.tid + 512 * i) * 4);
#pragma unroll
      for (int i = 0; i < 16; ++i) { const int i4 = F.tid + 512 * i, k = i4 >> 3, e0 = (i4 & 7) * 4;
#pragma unroll
          for (int j = 0; j < 4; ++j) { const bf16_t h = f2bf(t[i][j]); whi[(e0 + j) * WRP + k] = h; wlo[(e0 + j) * WRP + k] = f2bf(t[i][j] - bf2f(h)); } } }
    if (F.tid < 32) lcnt[F.tid] = 0;
    __syncthreads();
    const int g0 = (l == 0) ? (F.blk * 2176) >> 8 : F.blk * 8, g1 = (l == 0) ? ((F.blk + 1) * 2176) >> 8 : F.blk * 8 + 8, ngrp = g1 - g0;
    bf16_t* H2 = (bf16_t*)(F.ar + A_H2); unsigned char* H2f8 = F.ar + A_H2F8;
    const bf16_t* XB = (const bf16_t*)(F.ws + WS_XB);
    int* rowmap = (int*)(F.ws + WS_ROWMAP); float* selg = (float*)(F.ws + WS_SELG);
    for (int i = F.blk * 512 + F.tid; i < MAXROWS; i += GRID * 512) rowmap[i] = -1;
    const int lane = F.lane;
    const float* gn = F.in[I_N2G] + l * 1024;
    for (int rl0 = F.wave * 4; rl0 < ngrp * 32; rl0 += 32) {
        u32x4 xv[4][2]; float ss[4]; int Rr[4], mir[4];
#pragma unroll
        for (int q = 0; q < 4; ++q) {
            const int gr = g0 * 32 + rl0 + q;
            const int R = (l == 0) ? gr : (gr >> 12) * TPB + CTXL + (gr & 4095);
            const int b = R / TPB, p = R - b * TPB; const bool isctx = p < CTXL; Rr[q] = R; mir[q] = isctx ? 16 : b;
#pragma unroll
            for (int c = 0; c < 2; ++c) xv[q][c] = *(const u32x4*)(XB + (size_t)R * 1024 + lane * 8 + 512 * c);
        }
#pragma unroll
        for (int q = 0; q < 4; ++q) { ss[q] = 0.f;
#pragma unroll
            for (int c = 0; c < 2; ++c) { f32x4 a0, a1; unpack8(xv[q][c], a0, a1); ss[q] += ((a0[0] * a0[0] + a0[1] * a0[1]) + (a0[2] * a0[2] + a0[3] * a0[3])) + ((a1[0] * a1[0] + a1[1] * a1[1]) + (a1[2] * a1[2] + a1[3] * a1[3])); } }
#pragma unroll
        for (int q = 0; q < 4; ++q) {
            const float rstd = rsqrtf(wave_sum(ss[q]) * (1.f / 1024.f) + EPS);
            const float* sh = modv(F, l, mir[q], 3); const float* sc = modv(F, l, mir[q], 4); const int R = Rr[q];
#pragma unroll
            for (int c = 0; c < 2; ++c) { const int cc = lane * 8 + 512 * c;
                f32x4 a0, a1; unpack8(xv[q][c], a0, a1);
                const f32x4 h0 = a0 * rstd * *(const f32x4*)(gn + cc) * (*(const f32x4*)(sc + cc) + 1.f) + *(const f32x4*)(sh + cc);
                const f32x4 h1 = a1 * rstd * *(const f32x4*)(gn + cc + 4) * (*(const f32x4*)(sc + cc + 4) + 1.f) + *(const f32x4*)(sh + cc + 4);
                *(u32x4*)(H2 + (size_t)R * 1024 + cc) = pack8(h0, h1);
                int w0 = 0, w1 = 0; w0 = __builtin_amdgcn_cvt_pk_fp8_f32(h0[0], h0[1], w0, false); w0 = __builtin_amdgcn_cvt_pk_fp8_f32(h0[2], h0[3], w0, true);
                w1 = __builtin_amdgcn_cvt_pk_fp8_f32(h1[0], h1[1], w1, false); w1 = __builtin_amdgcn_cvt_pk_fp8_f32(h1[2], h1[3], w1, true);
                *(u32x2*)(H2f8 + (size_t)R * 1024 + cc) = (u32x2){(unsigned)w0, (unsigned)w1}; }
        }
    }
    VM_WAIT();
    __syncthreads();
    const int r = lane & 31, h2 = lane >> 5;
    for (int grp = F.wave; grp < ngrp; grp += 8) {
        const int gr = (g0 + grp) * 32 + r;
        const int R = (l == 0) ? gr : (gr >> 12) * TPB + CTXL + (gr & 4095);
        const bf16_t* bh = H2 + (size_t)R * 1024 + 8 * h2;
        const LAS bf16_t* ah = whi + r * WRP + 8 * h2; const LAS bf16_t* al = wlo + r * WRP + 8 * h2;
        f32x16 acc;
#pragma unroll
        for (int i = 0; i < 16; ++i) acc[i] = 0.f;
        bf16x8 xh[2][8];
#pragma unroll
        for (int j = 0; j < 8; ++j) { xh[0][j] = *(const bf16x8*)(bh + 16 * j); }
#pragma unroll
        for (int kc = 0; kc < 8; ++kc) {
            if (kc + 1 < 8) {
#pragma unroll
                for (int j = 0; j < 8; ++j) { xh[(kc + 1) & 1][j] = *(const bf16x8*)(bh + 16 * (8 * (kc + 1) + j)); }
            }
#pragma unroll
            for (int j = 0; j < 8; ++j) { asm volatile("" : "+v"(xh[kc & 1][j])); }
#pragma unroll
            for (int j = 0; j < 8; ++j) { const int ks = 8 * kc + j;
                const bf16x8 wh = *(const LAS bf16x8*)(ah + 16 * ks), wl = *(const LAS bf16x8*)(al + 16 * ks);
                acc = MFMA32(wh, xh[kc & 1][j], acc); acc = MFMA32(wl, xh[kc & 1][j], acc); }
        }
        float lg[32];
#pragma unroll
        for (int i = 0; i < 16; ++i) { const auto rr = __builtin_amdgcn_permlane32_swap(__float_as_uint(acc[i]), __float_as_uint(acc[i]), false, false);
            const int e = (i & 3) + 8 * (i >> 2); lg[e] = __uint_as_float(rr[0]) + F.in[I_BR][l * 32 + e]; lg[e + 4] = __uint_as_float(rr[1]) + F.in[I_BR][l * 32 + e + 4]; }
        if (lane < 32) {
            const int rl = grp * 32 + r;
            unsigned used = 0u; int se[4]; float sv[4];
#pragma unroll
            for (int k = 0; k < 4; ++k) {
                float best = -INFINITY; int bi = 0;
#pragma unroll
                for (int e = 0; e < 32; ++e) { const bool ok = !((used >> e) & 1u) && lg[e] > best; best = ok ? lg[e] : best; bi = ok ? e : bi; }
                used |= 1u << bi; se[k] = bi; sv[k] = best;
            }
            const float e1 = __expf(sv[1] - sv[0]), e2 = __expf(sv[2] - sv[0]), e3 = __expf(sv[3] - sv[0]); const float den = 1.f / (1.f + e1 + e2 + e3);
            *(f32x4*)(selg + (size_t)R * 4) = (f32x4){den, e1 * den, e2 * den, e3 * den};
#pragma unroll
            for (int k = 0; k < 4; ++k) { const int pos = __hip_atomic_fetch_add(lcnt + se[k], 1, __ATOMIC_RELAXED, __HIP_MEMORY_SCOPE_WORKGROUP); rec[rl * 4 + k] = (pos << 5) | se[k]; }
        }
    }
    __syncthreads();
    if (F.tid < 32) lbase[F.tid] = (int)atomicAdd((unsigned*)(F.ws + WS_CTL) + CW_GCNT + cl * 32 + F.tid, (unsigned)lcnt[F.tid]);
    __syncthreads();
    int* seli = (int*)(F.ws + WS_SELI);
    for (int idx = F.tid; idx < ngrp * 32 * 4; idx += 512) {
        const int rl = idx >> 2, k = idx & 3;
        const int gr = g0 * 32 + rl;
        const int R = (l == 0) ? gr : (gr >> 12) * TPB + CTXL + (gr & 4095);
        const int e = rec[idx] & 31, pos = rec[idx] >> 5;
        seli[(size_t)R * 4 + k] = ((lbase[e] + pos) << 5) | e;
    }
}

__device__ __forceinline__ int moe_tables(const Frame& F, int l) {
    LAS int* off = (LAS int*)(F.lds + MISC_OFF + 64); LAS int* texp = (LAS int*)(F.lds + MISC_OFF + 256);
    __syncthreads();
    if (F.tid == 0) { const unsigned* gc = (const unsigned*)(F.ws + WS_CTL) + CW_GCNT + l * 32; int o = 0;
        for (int e = 0; e < 32; ++e) { off[e] = o; o += (int)((__hip_atomic_load(gc + e, __ATOMIC_RELAXED, __HIP_MEMORY_SCOPE_AGENT) + 255u) & ~255u); } off[32] = o; }
    __syncthreads();
    const int nt = off[32] >> 8;
    for (int pm = F.tid; pm < nt; pm += 512) { int e = 0;
#pragma unroll
        for (int k = 1; k < 32; ++k) e += (off[k] <= pm * 256) ? 1 : 0;
        texp[pm] = e; }
    __syncthreads();
    return nt;
}

__device__ __forceinline__ void p_route2(const Frame& F, int l) {
    (void)moe_tables(F, l);
    const LAS int* off = (const LAS int*)(F.lds + MISC_OFF + 64);
    int* seli = (int*)(F.ws + WS_SELI); const float* selg = (const float*)(F.ws + WS_SELG);
    int* rowmap = (int*)(F.ws + WS_ROWMAP); float* gslot = (float*)(F.ws + WS_GSLOT);
    for (int idx = F.blk * 512 + F.tid; idx < NR * 4; idx += GRID * 512) {
        const int R = idx >> 2;
        if (l == 1 && (R % TPB) < CTXL) continue;
        const int s = seli[idx]; const int e = s & 31, dst = off[e] + (s >> 5);
        rowmap[dst] = idx; gslot[dst] = selg[idx]; seli[idx] = dst;
    }
}
constexpr int NPH = 24;

__global__ void __launch_bounds__(512, 2) mega(Args args) {
    extern __shared__ __attribute__((aligned(16))) unsigned char lds_raw[];
    Frame F;
    F.lds = (LAS unsigned char*)lds_raw;
    F.in = args.in; F.out = args.out; F.ws = args.ws; F.ar = args.ws + WS_ARENA;
    F.tid = threadIdx.x; F.lane = F.tid & 63; F.wave = __builtin_amdgcn_readfirstlane(F.tid >> 6); F.blk = blockIdx.x;
    if (F.tid < 64) ((LAS unsigned*)(F.lds + MISC_OFF))[F.tid] = 0u;
    __syncthreads();
    const int lo = args.ph_lo, hi = args.ph_hi;
    XcdBarrier bar; bar.bar = (unsigned*)(F.ws + WS_CTL) + CW_BAR; bar.x = 0; bar.st = (volatile LAS unsigned*)(F.lds + MISC_OFF);
    if (hi - lo > 1) bar = xcd_barrier_post((unsigned*)(F.ws + WS_CTL) + CW_BAR, (volatile LAS unsigned*)(F.lds + MISC_OFF));
#ifndef PH_MASK
#define PH_MASK 0x1fff
#endif
#define KON(kind) (((PH_MASK) >> (kind)) & 1)
#define IN(k) (lo <= (k) && (k) < hi)
#define SEAM(k) do { if (IN(k) && IN((k) + 1)) xcd_barrier(bar); } while (0)
#define FRESH(FF) Frame FF = F; { int ln_; asm volatile("v_mbcnt_lo_u32_b32 %0, -1, 0\n\tv_mbcnt_hi_u32_b32 %0, -1, %0" : "=v"(ln_)); int wv_ = F.wave, bk_ = F.blk; asm volatile("" : "+s"(wv_), "+s"(bk_)); FF.lane = ln_; FF.wave = wv_; FF.blk = bk_; FF.tid = wv_ * 64 + ln_; }

    if (KON(0) && IN(0)) { FRESH(FF); p_prologue(FF, args); }
    SEAM(0);
    for (int l = 0; l < 2; ++l) {
        const int pb = 1 + 11 * l;
        if (KON(1) && IN(pb + 0)) { FRESH(FF); if (l == 0) p_rowpass<0>(FF, 0); else p_rowpass<1>(FF, 1); }
        SEAM(pb + 0);
        if (KON(2) && IN(pb + 1)) { FRESH(FF);
            EpiTiles E{ptile(FF, 0), FF.in[I_BGATE] + l * 4096};
            {
                pg8::DenseOrder S;
                if (l == 0) S.init(NRT, T_GATE, GRID, FF.blk, false, FF.ar + A_H, (const bf16_t*)(FF.ws + WS_WIN) + (size_t)l * 7168 * 1024, 1024);
                else { S.init(256, T_GATE, GRID, FF.blk, true, FF.ar + A_H, (const bf16_t*)(FF.ws + WS_WIN) + (size_t)l * 7168 * 1024, 1024); S.nctx = 16 * 7; }
#if PROBE_REP & 512
                if ((FF.blk >> 3) & 1) { __builtin_amdgcn_s_sleep(127); __builtin_amdgcn_s_sleep(127); __builtin_amdgcn_s_sleep(127); }
#endif
                pg8::gemm_phase<EpiTiles, pg8::DenseOrder>(FF.lds, FF.tid, 1024, S, E);
#if PROBE_REP & 1
                pg8::gemm_phase<EpiTiles, pg8::DenseOrder>(FF.lds, FF.tid, 1024, S, E);
#endif
            }
        }
        SEAM(pb + 1);
        if (KON(3) && IN(pb + 2)) { FRESH(FF);
#if PROBE_REP & 64
            p_prep<false, true>(FF, l);
#endif
#if PROBE_REP & 128
            p_prep<true, false>(FF, l);
#endif
            p_prep(FF, l); }
        SEAM(pb + 2);
        if (KON(4) && IN(pb + 3)) { FRESH(FF);
#if PROBE_REP & 32
            for (int u = FF.blk; u < 16 * 34 * 4; u += GRID) { const int g = u & 3, bc = u >> 2, b = bc / 34, chunk = bc - b * 34; gmlp_unit(FF, l, b, chunk, g, (bf16_t*)(FF.ar + A_H + 3 * PT_BYTES)); }
#endif
            for (int u = FF.blk; u < 16 * 34 * 4; u += GRID) { const int g = u & 3, bc = u >> 2, b = bc / 34, chunk = bc - b * 34; gmlp_unit(FF, l, b, chunk, g); }
            gdn_chunk_phase(FF);
#if PROBE_REP & 16
            gdn_chunk_phase(FF);
#endif
        }
        SEAM(pb + 3);
        if (KON(5) && IN(pb + 4)) { FRESH(FF);
            gdn_scan_phase(FF, l);
            float lam; { float d1 = 0.f, d2 = 0.f; for (int i = 0; i < 32; ++i) { d1 += FF.in[I_LQ1][l * 32 + i] * FF.in[I_LK1][l * 32 + i]; d2 += FF.in[I_LQ2][l * 32 + i] * FF.in[I_LK2][l * 32 + i]; } lam = expf(d1) - expf(d2) + args.lam_init[l]; }
            const int nq = (l == 0) ? 17 : 16, nda = 64 * nq, nga = 32 * nq;
            volatile LAS int* qslot = (volatile LAS int*)(FF.lds + MISC_OFF + 32);
            unsigned* qctr = (unsigned*)(FF.ws + WS_CTL) + CW_QUEUE + 64 * l;
            bf16_t* oda = ptile(FF, T_AQ); bf16_t* oga = ptile(FF, T_GQ);
            for (;;) {
                __syncthreads();
                if (FF.tid == 0) *qslot = (int)__hip_atomic_fetch_add(qctr, 1u, __ATOMIC_RELAXED, __HIP_MEMORY_SCOPE_AGENT);
                __syncthreads();
                int u = *qslot;
                if (u >= nda + nga) break;
                if (u < nda) {
                    const int qi = u / 64, bh = u - qi * 64, b = bh >> 2, h = bh & 3, qt = (qi < 16) ? qi + 1 : 0;
                    attn_unit<32, 2, true>(FF, ptile(FF, T_AQ), 64 * h, ptile(FF, T_AK), 64 * h, ptile(FF, T_AV), 64 * h, oda, 64 * h, b, qt, lam, 1.f - args.lam_init[l], FF.in[I_DASUBG] + l * 64, FF.in[I_DAQG] + l * 32, 0.17677669529663687f * LOG2E * QSC, (const f32x2*)(FF.ws + WS_ROPE));
                } else {
                    u -= nda; const int qi = u / 32, bk = u - qi * 32, b = bk >> 1, kv = bk & 1, qt = (qi < 16) ? qi + 1 : 0;
                    attn_unit<64, 2, false>(FF, ptile(FF, T_GQ), 128 * kv, ptile(FF, T_GKV), 64 * kv, ptile(FF, T_GKV), 128 + 64 * kv, oga, 128 * kv, b, qt, 0.f, 1.f, nullptr, FF.in[I_GAQG] + l * 64, 0.125f * LOG2E * QSC, (const f32x2*)(FF.ws + WS_ROPE) + 512);
                }
            }
            __syncthreads();
            {
                EpiTiles E{ptile(FF, 0), FF.in[I_BGATE] + l * 4096};
                pg8::DenseOrderT<true> S; S.init((l == 0) ? NRT : 256, 16, GRID, FF.blk, l == 1, FF.ar + A_H8, FF.ws + WS_WG8 + (size_t)l * 4096 * 1024, 1024); S.pn_off = T_GATE;
                pg8::gemm_phase<EpiTiles, pg8::DenseOrderT<true>>(FF.lds, FF.tid, 1024, S, E);
#if PROBE_REP & 2
                pg8::gemm_phase<EpiTiles, pg8::DenseOrderT<true>>(FF.lds, FF.tid, 1024, S, E);
#endif
            }
        }
        SEAM(pb + 4);
        if (KON(6) && IN(pb + 5)) { FRESH(FF);
            MergeOrder S; S.G = GRID; S.c = FF.blk; S.skipctx = (l == 1); S.ntile = (l == 1) ? 1024 : 1088; S.P = (const char*)(FF.ar + A_P); S.Wbr = (const char*)((const bf16_t*)(FF.ws + WS_WBR) + (size_t)l * 4 * 1024 * 256);
            EpiMerge E{ptile(FF, 0), (bf16_t*)(FF.ar + A_MERGED)};
            pg8::gemm_phase<EpiMerge, MergeOrder>(FF.lds, FF.tid, 256, S, E);
        }
        SEAM(pb + 5);
        if (KON(7) && IN(pb + 6)) { FRESH(FF);
            pg8::DenseOrder S; S.init((l == 1) ? 256 : NRT, 4, GRID, FF.blk, l == 1, FF.ar + A_MERGED, (const bf16_t*)(FF.ws + WS_WO) + (size_t)l * 1024 * 1024, 1024);
            EpiWo E{(l == 0) ? FF.in[I_X] : nullptr, FF.in[I_CTX], (bf16_t*)(FF.ws + WS_XB), (const float*)(FF.ws + WS_MOD) + (size_t)l * 17 * 6144, 2};
            pg8::gemm_phase<EpiWo, pg8::DenseOrder>(FF.lds, FF.tid, 1024, S, E);
        }
        SEAM(pb + 6);
#if PROBE_REP & 256
        if (KON(8) && IN(pb + 7)) { FRESH(FF); p_route1(FF, l, l + 2); }
#endif
        if (KON(8) && IN(pb + 7)) { FRESH(FF); p_route1(FF, l, l); }
        SEAM(pb + 7);
        if (KON(9) && IN(pb + 8)) { FRESH(FF); p_route2(FF, l); }
        SEAM(pb + 8);
        if (KON(10) && IN(pb + 9)) { FRESH(FF);
            const int nt = moe_tables(FF, l);
            MoeOrder<8, true> S; S.G = GRID; S.c = FF.blk; S.nunits = nt * 8; S.texp = (const LAS int*)(FF.lds + MISC_OFF + 256); S.A = (const char*)(FF.ar + A_H2F8); S.rowmap = (const int*)(FF.ws + WS_ROWMAP);
            S.W = (const char*)(FF.ws + WS_WUP) + (size_t)l * 32 * 2048 * 1024; S.wstride = (size_t)2048 * 1024;
            EpiUp E{FF.in[I_BUP] + (size_t)l * 32 * 2048, (unsigned char*)(FF.ar + A_ACT)};
            pg8::gemm_phase<EpiUp, MoeOrder<8, true>>(FF.lds, FF.tid, 1024, S, E);
#if PROBE_REP & 4
            pg8::gemm_phase<EpiUp, MoeOrder<8, true>>(FF.lds, FF.tid, 1024, S, E);
#endif
        }
        SEAM(pb + 9);
        if (KON(11) && IN(pb + 10)) { FRESH(FF);
            const int nt = moe_tables(FF, l);
            MoeOrder<4, false> S; S.G = GRID; S.c = FF.blk; S.nunits = nt * 4; S.texp = (const LAS int*)(FF.lds + MISC_OFF + 256); S.A = (const char*)(FF.ar + A_ACT); S.rowmap = nullptr;
            S.W = (const char*)(FF.ws + WS_WDN) + (size_t)l * 32 * 1024 * 1024; S.wstride = (size_t)1024 * 1024;
            EpiDown E{FF.in[I_BDN] + (size_t)l * 32 * 1024, (const float*)(FF.ws + WS_GSLOT), FF.ar + A_YBUF};
            pg8::gemm_phase<EpiDown, MoeOrder<4, false>>(FF.lds, FF.tid, 1024, S, E);
#if PROBE_REP & 8
            pg8::gemm_phase<EpiDown, MoeOrder<4, false>>(FF.lds, FF.tid, 1024, S, E);
#endif
        }
        SEAM(pb + 10);
    }
#if PROBE_REP & 2048
    if (KON(12) && IN(23)) { FRESH(FF); p_final(FF); }
#endif
    if (KON(12) && IN(23)) { FRESH(FF); p_final(FF); }
#undef IN
#undef SEAM
}

extern "C" void kernel_launch(void* const* d_in, const int* in_sizes, int n_in, void* d_out, int out_size, void* d_ws, size_t ws_size, hipStream_t stream) {
    static int grid = 0;
    if (grid == 0) {
        if (n_in != 34 || out_size != NB * SEQ * D || ws_size < WS_NEED) { fprintf(stderr, "kernel_launch: unexpected shapes (n_in %d out %d ws %zu need %zu)\n", n_in, out_size, ws_size, (size_t)WS_NEED); grid = -1; return; }
        int dev = 0, cus = 0;
        if (hipGetDevice(&dev) != hipSuccess || hipDeviceGetAttribute(&cus, hipDeviceAttributeMultiprocessorCount, dev) != hipSuccess) { grid = -1; return; }
        if (hipFuncSetAttribute((const void*)mega, hipFuncAttributeMaxDynamicSharedMemorySize, LDS_BYTES) != hipSuccess) { fprintf(stderr, "kernel_launch: hipFuncSetAttribute failed\n"); grid = -1; return; }
        int per_cu = 0;
        (void)hipOccupancyMaxActiveBlocksPerMultiprocessor(&per_cu, (const void*)mega, 512, LDS_BYTES);
        (void)hipGetLastError();
        if (cus != 256 || per_cu < 1) { fprintf(stderr, "kernel_launch: needs 256 CUs with one resident workgroup each (cus %d, per_cu %d)\n", cus, per_cu); grid = -1; return; }
        grid = GRID;
    }
    if (grid < 0) return;
    (void)hipMemsetAsync((char*)d_ws + WS_CTL, 0, CTL_BYTES, stream);
    Args a;
    memset(&a, 0, sizeof(a));
    for (int i = 0; i < 34; ++i) a.in[i] = (const float*)d_in[i];
    a.out = (float*)d_out; a.ws = (unsigned char*)d_ws;
    for (int i = 0; i < 8; ++i) a.inv32[i] = (float)pow(10000.0, -(double)i / 8.0);
    for (int i = 0; i < 16; ++i) a.inv64[i] = (float)pow(10000.0, -(double)i / 16.0);
    for (int l = 0; l < 2; ++l) a.lam_init[l] = (float)(0.8 - 0.6 * exp(-0.3 * (double)l));
    a.ph_lo = 0; a.ph_hi = NPH;
    hipLaunchKernelGGL(mega, dim3(grid), dim3(512), LDS_BYTES, stream, a);
}
```

```cpp
#include <hip/hip_runtime.h>
#include <stdint.h>
#include <stdio.h>
#include <math.h>
#include <string.h>

#define LAS __attribute__((address_space(3)))
typedef unsigned short bf16_t;
typedef short bf16x8 __attribute__((ext_vector_type(8)));
typedef short s16x4 __attribute__((ext_vector_type(4)));
typedef short v4i16_t __attribute__((ext_vector_type(4)));
typedef float f32x2 __attribute__((ext_vector_type(2)));
typedef float f32x4 __attribute__((ext_vector_type(4)));
typedef float f32x16 __attribute__((ext_vector_type(16)));
typedef unsigned u32x2 __attribute__((ext_vector_type(2)));
typedef unsigned u32x4 __attribute__((ext_vector_type(4)));

constexpr int D = 1024, NB = 16, SEQ = 4096, CTXL = 256, TPB = SEQ + CTXL;
constexpr int NR = NB * TPB;
constexpr int NRT = NR / 256;
constexpr int NPT = 28;
constexpr int NE = 32;
constexpr int GRID = 256;
constexpr int MAXT = 1120, MAXROWS = MAXT * 256;
#ifndef PROBE_REP
#define PROBE_REP 0
#endif
constexpr float EPS = 1e-6f;
constexpr float LOG2E = 1.4426950408889634f;
constexpr float QSC = 128.f / 32767.f;
constexpr int T_AQ = 0, T_AK = 1, T_AV = 2, T_GQ = 3, T_GKV = 4, T_MU = 5, T_MV = 6, T_DQ = 7, T_DK = 8, T_DV = 9, T_DG = 10, T_DAB = 11, T_GATE = 12;

constexpr size_t WS_CTL = 0;
constexpr size_t CTL_BYTES = 65536;
constexpr int CW_BAR = 0;
constexpr int CW_GCNT = 4096;
constexpr int CW_QUEUE = 4352;
constexpr size_t WS_MOD = 65536;
constexpr size_t WS_ROPE = WS_MOD + 2ull * 17 * 6144 * 4;
constexpr size_t WS_WIN = 1048576;
constexpr size_t WS_WBR = WS_WIN + 2ull * 7168 * 1024 * 2;
constexpr size_t WS_WO = WS_WBR + 2ull * 4 * 1024 * 256 * 2;
constexpr size_t WS_WUP = WS_WO + 2ull * 1024 * 1024 * 2;
constexpr size_t WS_WG8 = WS_WUP + 2ull * 32 * 2048 * 1024;
constexpr size_t WS_WDN = WS_WG8 + 2ull * 4096 * 1024;
constexpr size_t WS_GMWS = WS_WDN + 2ull * 32 * 1024 * 1024;
constexpr size_t WS_XB = WS_GMWS + 2ull * 4 * 128 * 128 * 2;
constexpr size_t WS_SELI = WS_XB + (size_t)NR * 1024 * 2;
constexpr size_t WS_SELG = WS_SELI + (size_t)NR * 4 * 4;
constexpr size_t WS_GB = WS_SELG + (size_t)NR * 4 * 4;
constexpr size_t WS_ROWMAP = WS_GB + (size_t)NR * 16 * 4;
constexpr size_t WS_GSLOT = WS_ROWMAP + (size_t)MAXROWS * 4;
constexpr size_t WS_CHG = WS_GSLOT + (size_t)MAXROWS * 4;
constexpr size_t WS_ARENA = (WS_CHG + 8704 * 4 + 4095) & ~(size_t)4095;
constexpr size_t PT_BYTES = (size_t)NR * 256 * 2;
constexpr size_t A_H = 0;
constexpr size_t A_P = (size_t)NR * 1024 * 2;
constexpr size_t A_CH = A_P + NPT * PT_BYTES;
constexpr size_t CH_ITEM = 40960;
constexpr size_t A_END = A_CH + 8704ull * CH_ITEM;
constexpr size_t A_MERGED = A_CH;
constexpr size_t A_H2 = 0;
constexpr size_t A_XS = A_P;
constexpr size_t A_ACT = A_XS + (size_t)MAXROWS * 1024 * 2;
constexpr size_t A_H2F8 = A_XS + (size_t)NR * 1024 * 2;
constexpr size_t A_YBUF = A_XS;
static_assert(A_ACT + (size_t)MAXROWS * 1024 * 2 <= A_END, "arena");
static_assert((size_t)NR * 4 * 1024 * 2 <= (size_t)MAXROWS * 1024 * 2, "ybuf fits xs");
constexpr size_t A_H8 = A_END;
constexpr size_t WS_NEED = WS_ARENA + A_END + (size_t)NR * 1024;

constexpr int RING_BYTES = 131072;
constexpr int MISC_OFF = 140544;
constexpr int LDS_BYTES = 147456;

typedef __bf16 bf16x2_t __attribute__((ext_vector_type(2)));
__device__ __forceinline__ unsigned cvt_pk(float lo, float hi) { const f32x2 v = {lo, hi}; const bf16x2_t b = __builtin_convertvector(v, bf16x2_t); return __builtin_bit_cast(unsigned, b); }
__device__ __forceinline__ float bf_lo(unsigned u) { return __uint_as_float(u << 16); }
__device__ __forceinline__ float bf_hi(unsigned u) { return __uint_as_float(u & 0xffff0000u); }
__device__ __forceinline__ float bf2f(bf16_t h) { return __uint_as_float(((unsigned)h) << 16); }
__device__ __forceinline__ bf16_t f2bf(float f) { return (bf16_t)(cvt_pk(f, 0.f) & 0xffffu); }
template <int O> __device__ __forceinline__ float xor_f(float v) { return __int_as_float(__builtin_amdgcn_ds_swizzle(__float_as_int(v), (O << 10) | 0x1f)); }
__device__ __forceinline__ float add_xor32(float v) { const auto rr = __builtin_amdgcn_permlane32_swap(__float_as_uint(v), __float_as_uint(v), false, false); return __uint_as_float(rr[0]) + __uint_as_float(rr[1]); }
__device__ __forceinline__ float sum16(float v) { v += xor_f<1>(v); v += xor_f<2>(v); v += xor_f<4>(v); v += xor_f<8>(v); return v; }
__device__ __forceinline__ float wave_sum(float v) { v = sum16(v); v += xor_f<16>(v); return add_xor32(v); }
__device__ __forceinline__ float sigmoidf_(float x) { return __builtin_amdgcn_rcpf(1.f + __builtin_amdgcn_exp2f(x * -LOG2E)); }
__device__ __forceinline__ float siluf_(float x) { return x * __builtin_amdgcn_rcpf(1.f + __builtin_amdgcn_exp2f(x * -LOG2E)); }
__device__ __forceinline__ float gelu_erf(float v) {
    const float av = fabsf(v), t = __builtin_amdgcn_rcpf(av * 0.2316418882f + 1.0f);
    float q = t * 0.5307027145f + (-0.7265760135f); q = q * t + 0.7107068705f; q = q * t + (-0.142248368f); q = q * t + 0.127414796f; q = q * t;
    const float e = __builtin_amdgcn_exp2f((v * v) * (-0.72134752044f));
    const float m = v * (q * e);
    return v < 0.f ? m : v - m;
}
#define VM_WAIT() asm volatile("s_waitcnt vmcnt(0)" ::: "memory")
#define LDS_WAIT() asm volatile("s_waitcnt lgkmcnt(0)" ::: "memory")

#define XB_TMO      128
#define XB_XCNT(j)  (256  + 64 * (j))
#define XB_XSUB(j)  (1280 + 64 * (j))
#define XB_XGEN(j)  (2304 + 64 * (j))
#define XB_TOP      3328
#define XB_TOPGEN   3392
#define XCD_BAR_WORDS 3456
#define XB_SPIN_CAP (1u << 18)
__device__ __forceinline__ unsigned xb_ld(unsigned* p)              { return __hip_atomic_load(p, __ATOMIC_RELAXED, __HIP_MEMORY_SCOPE_AGENT); }
__device__ __forceinline__ unsigned xb_add(unsigned* p, unsigned v) { return __hip_atomic_fetch_add(p, v, __ATOMIC_RELAXED, __HIP_MEMORY_SCOPE_AGENT); }
__device__ __forceinline__ unsigned xb_xcc_id() { return (unsigned)__builtin_amdgcn_s_getreg((3 << 11) | 20) & 0xFu; }
#define XB_SPIN(cond, bar) do { unsigned _sp = 0; while (cond) { __builtin_amdgcn_s_sleep(1); \
    if ((++_sp & 255u) == 0u) { if (xb_ld(&(bar)[XB_TMO])) break; if (_sp > XB_SPIN_CAP) { atomicAdd(&(bar)[XB_TMO], 1u); break; } } } } while (0)
struct XcdBarrier { unsigned* bar; unsigned x; volatile LAS unsigned* st; };
__device__ __forceinline__ XcdBarrier xcd_barrier_post(unsigned* bar, volatile LAS unsigned* st) {
    XcdBarrier b; b.bar = bar; b.x = xb_xcc_id(); b.st = st;
    if (threadIdx.x == 0) (void)xb_add(&bar[XB_XCNT(b.x)], 1u);
    return b;
}
__device__ __forceinline__ void xcd_barrier_complete(unsigned* bar, unsigned x, unsigned& nloc, unsigned& nx) {
    const unsigned G = gridDim.x * gridDim.y * gridDim.z;
    unsigned sum, cnt, mine, sp = 0u;
    for (;;) {
        sum = 0u; cnt = 0u; mine = 0u;
#pragma unroll
        for (unsigned j = 0; j < 16; ++j) { const unsigned c = xb_ld(&bar[XB_XCNT(j)]); sum += c; cnt += (c > 0u) ? 1u : 0u; mine = (j == x) ? c : mine; }
        if (sum == G) break;
        __builtin_amdgcn_s_sleep(1);
        if ((++sp & 255u) == 0u) { if (xb_ld(&bar[XB_TMO])) break; if (sp > XB_SPIN_CAP) { atomicAdd(&bar[XB_TMO], 1u); break; } }
    }
    nloc = mine > 0u ? mine : 1u; nx = cnt > 0u ? cnt : 1u;
}
__device__ __forceinline__ void xcd_barrier(const XcdBarrier& b) {
    asm volatile("s_waitcnt vmcnt(0)" ::: "memory");
    __syncthreads();
    if (threadIdx.x == 0) {
        unsigned* bar = b.bar;
        __builtin_amdgcn_s_waitcnt(0);
        unsigned nloc = b.st[0], nx = b.st[1];
        if (nloc == 0u) { xcd_barrier_complete(bar, b.x, nloc, nx); b.st[0] = nloc; b.st[1] = nx; }
        const unsigned old = xb_add(&bar[XB_XSUB(b.x)], 1u);
        const unsigned gen = old / nloc;
        if (old + 1u == (gen + 1u) * nloc) {
            __builtin_amdgcn_fence(__ATOMIC_RELEASE, "agent");
            asm volatile("s_waitcnt vmcnt(0)" ::: "memory");
            const unsigned og = xb_add(&bar[XB_TOP], 1u);
            const unsigned tg = og / nx;
            if (og + 1u == (tg + 1u) * nx) xb_add(&bar[XB_TOPGEN], 1u);
            else XB_SPIN(xb_ld(&bar[XB_TOPGEN]) == tg, bar);
            __builtin_amdgcn_fence(__ATOMIC_ACQUIRE, "agent");
            xb_add(&bar[XB_XGEN(b.x)], 1u);
            asm volatile("s_waitcnt vmcnt(0)" ::: "memory");
        } else {
            XB_SPIN(xb_ld(&bar[XB_XGEN(b.x)]) == gen, bar);
            __builtin_amdgcn_fence(__ATOMIC_ACQUIRE, "agent");
            asm volatile("s_waitcnt vmcnt(0)" ::: "memory");
        }
    }
    __syncthreads();
}

struct Args { const float* in[34]; float* out; unsigned char* ws; float inv32[8]; float inv64[16]; float lam_init[2]; int ph_lo, ph_hi; };
struct Frame {
    LAS unsigned char* lds;
    const float* const* in;
    float* out; unsigned char* ws; unsigned char* ar;
    int tid, lane, wave, blk;
};
enum InIdx { I_X = 0, I_C, I_CTX, I_CCTX, I_WMOD, I_BMOD, I_N1G, I_N2G, I_WIN, I_BGATE, I_DAQG, I_DAKG, I_LQ1, I_LK1, I_LQ2, I_LK2, I_DASUBG, I_GAQG, I_GAKG, I_GMVG, I_GMWS, I_GMBS,
             I_CONVW, I_ALOG, I_DTB, I_GDOUTG, I_WBR, I_WO, I_WR, I_BR, I_WUP, I_BUP, I_WDN, I_BDN };
__device__ __forceinline__ bf16_t* ptile(const Frame& F, int t) { return (bf16_t*)(F.ar + A_P + (size_t)t * PT_BYTES); }
__device__ __forceinline__ const float* modv(const Frame& F, int l, int mi, int which) { return (const float*)(F.ws + WS_MOD) + ((size_t)(l * 17 + mi) * 6144 + which * 1024); }
namespace pg8 {
typedef int v4i_t __attribute__((ext_vector_type(4)));
typedef int v8i_t __attribute__((ext_vector_type(8)));
constexpr int BM = 256, BK = 64, HALF = 128, HTB = HALF * BK * 2, STAGE_BYTES = 8 * HTB, NXCD = 8, WGM = 8;
__host__ __device__ __forceinline__ int lds_byte(int r, int c) { const int st = (r >> 4) * 2 + (c >> 5), rr = r & 15, cc = c & 31, ob = rr * 64 + cc * 2; return st * 1024 + (ob ^ (((ob >> 9) & 1) << 5)); }
__host__ __device__ __forceinline__ void stage_rc(int b, int& R, int& C) { const int st = b / 1024, sb = b % 1024, swz = sb ^ (((sb >> 9) & 1) << 5); R = (st >> 1) * 16 + swz / 64; C = (st & 1) * 32 + (swz % 64) / 2; }
__host__ __device__ __forceinline__ int perm32(int rho) { const int n = rho >> 4, i = rho & 15; return 8 * (i >> 2) + 4 * n + (i & 3); }

struct Unit { int pm, pn, z; };

template <bool F8_>
struct DenseOrderT {
    static constexpr bool GATHER = false, FP8 = F8_;
    __device__ __forceinline__ int scale_w() const { return 0x7a7a7a7a; }
    __device__ __forceinline__ int scale_x() const { return 0x7f7f7f7f; }
    int pn_off = 0;
    __device__ __forceinline__ int arow(const Unit&, int) const { return 0; }
    __device__ __forceinline__ int araw(const Unit&, int) const { return 0; }
    int nM, nN, nwg, G, c; bool skipctx; const char* A; const char* Bt; size_t tstep; int nctx = 0;
    __device__ void init(int nM_, int nN_, int G_, int c_, bool skip, const void* A_, const void* Bt_, int K) { nM = nM_; nN = nN_; nwg = nM * nN; G = G_; c = c_; skipctx = skip; A = (const char*)A_; Bt = (const char*)Bt_; tstep = (size_t)BM * K * (F8_ ? 1 : 2); }
    __device__ bool next(int i, Unit& u) const {
        const long L = (long)i * G + c; if (L >= nwg + nctx) return false;
        if (L >= nwg) { const int idx = (int)L - nwg, q = idx / 7, t = idx - q * 7;
            u.pm = q * 17; u.pn = (t == 0) ? 1 : (t == 1) ? 2 : (t == 2) ? 4 : (t == 3) ? 7 : (t == 4) ? 8 : (t == 5) ? 9 : 11; u.z = 0; return true; }
        int wgid = (int)L; { const int q = nwg / NXCD, r = nwg % NXCD, xcd = wgid % NXCD, off = wgid / NXCD; wgid = (xcd < r ? xcd * (q + 1) : r * (q + 1) + (xcd - r) * q) + off; }
        const int nig = WGM * nN, gid = wgid / nig, fm = gid * WGM, gsz = (nM - fm) < WGM ? (nM - fm) : WGM;
        int pm = fm + ((wgid % nig) % gsz); u.pn = (wgid % nig) / gsz + pn_off; u.z = 0;
        if (skipctx) pm = (pm >> 4) * 17 + 1 + (pm & 15);
        u.pm = pm; return true;
    }
    __device__ __forceinline__ const char* abase(const Unit& u) const { return A + (size_t)u.pm * tstep; }
    __device__ __forceinline__ const char* bbase(const Unit& u) const { return Bt + (size_t)(u.pn - pn_off) * tstep; }
};
typedef DenseOrderT<false> DenseOrder;

template <class Epi, class Sched, bool ALIGN = true>
__device__ __forceinline__ void gemm_phase(LAS unsigned char* lds, const int tid, const int K, const Sched& S, const Epi& E) {
    const int wid = __builtin_amdgcn_readfirstlane(tid >> 6), lane = tid & 63, wr = wid >> 2, wc = wid & 3, fr = lane & 15, fq = lane >> 4;
    constexpr bool F8 = Sched::FP8;
    const int RB = F8 ? K : 2 * K;
    const int nt = RB / 128;
    unsigned voffA[2], voffB[2];
#pragma unroll
    for (int i = 0; i < 2; ++i) { int R, C; stage_rc(tid * 16 + i * 8192, R, C); const int Rb = (R & ~31) + perm32(R & 31);
        voffA[i] = (unsigned)(R * RB + C * 2); voffB[i] = (unsigned)(Rb * RB + C * 2); }
    const size_t kstep = (size_t)(BK * 2);
    const size_t hstep = (size_t)HALF * RB;
    int Rst[2], Cst[2];
#pragma unroll
    for (int i = 0; i < 2; ++i) stage_rc(tid * 16 + i * 8192, Rst[i], Cst[i]);
    unsigned gA[2][2], ngA[2][2];
    const unsigned ldsw = (unsigned)wid * 1024u;
    const int aoff = lds_byte(wr * 64 + fr, fq * 8), boff = lds_byte(wc * 32 + fr, fq * 8);
#define PG8_SA(b, h) (((b) * 2 + (h)) * HTB)
#define PG8_SB(b, h) ((4 + (b) * 2 + (h)) * HTB)
#define PG8_STAGE(bufoff, gbase, voff) do { _Pragma("unroll") for (int _i = 0; _i < 2; ++_i) \
        __builtin_amdgcn_global_load_lds((const unsigned*)((const char*)(gbase) + (voff)[_i]), (LAS unsigned*)(lds + (bufoff) + ldsw + _i * 8192), 16, 0, 0); } while (0)
#define PG8_GLOAD(dst, u_) do { if constexpr (Sched::GATHER) { _Pragma("unroll") for (int _h = 0; _h < 2; ++_h) _Pragma("unroll") for (int _i = 0; _i < 2; ++_i) \
        dst[_h][_i] = (unsigned)S.arow((u_), _h * HALF + Rst[_i]) * (unsigned)RB + (unsigned)(Cst[_i] * 2); } } while (0)
#define PG8_STAGE_A(bufoff, gbase, h_, nx_) do { if constexpr (Sched::GATHER) { _Pragma("unroll") for (int _i = 0; _i < 2; ++_i) \
        __builtin_amdgcn_global_load_lds((const unsigned*)((const char*)(gbase) + ((nx_) ? ngA[h_][_i] : gA[h_][_i])), (LAS unsigned*)(lds + (bufoff) + ldsw + _i * 8192), 16, 0, 0); } \
        else PG8_STAGE(bufoff, (gbase) + (h_) * hstep, voffA); } while (0)
#define PG8_LD32(p_) __builtin_shufflevector(*(const LAS v4i_t*)(p_), *(const LAS v4i_t*)((p_) + 1024), 0, 1, 2, 3, 4, 5, 6, 7)
#define PG8_LDA(dst, b, h) do { if constexpr (F8) { _Pragma("unroll") for (int m = 0; m < 4; ++m) dst##8[m] = PG8_LD32(lds + PG8_SA(b, h) + aoff + m * 2048); } \
        else { _Pragma("unroll") for (int m = 0; m < 4; ++m) _Pragma("unroll") for (int k = 0; k < 2; ++k) dst[m][k] = *(const LAS bf16x8*)(lds + PG8_SA(b, h) + aoff + m * 2048 + k * 1024); } } while (0)
#define PG8_LDB(dst, b, h) do { if constexpr (F8) { _Pragma("unroll") for (int n = 0; n < 2; ++n) dst##8[n] = PG8_LD32(lds + PG8_SB(b, h) + boff + n * 2048); } \
        else { _Pragma("unroll") for (int n = 0; n < 2; ++n) _Pragma("unroll") for (int k = 0; k < 2; ++k) dst[n][k] = *(const LAS bf16x8*)(lds + PG8_SB(b, h) + boff + n * 2048 + k * 1024); } } while (0)
#define PG8_MMA(ai, bj, At, Bt) do { __builtin_amdgcn_s_setprio(1); _Pragma("unroll") for (int m = 0; m < 4; ++m) _Pragma("unroll") for (int n = 0; n < 2; ++n) { \
        if constexpr (F8) asm volatile("v_mfma_scale_f32_16x16x128_f8f6f4 %0, %1, %2, %0, %3, %4 op_sel_hi:[0,0,0]" : "+v"(acc[ai][bj][m][n]) : "v"(Bt##8[n]), "v"(At##8[m]), "v"(sclw), "v"(sclx)); \
        else { _Pragma("unroll") for (int k = 0; k < 2; ++k) acc[ai][bj][m][n] = __builtin_amdgcn_mfma_f32_16x16x32_bf16(Bt[n][k], At[m][k], acc[ai][bj][m][n], 0, 0, 0); } } \
        __builtin_amdgcn_s_setprio(0); } while (0)
#define PG8_WAIT_V(n) asm volatile("s_waitcnt vmcnt(" #n ")" ::: "memory")
#define PG8_WAIT_L(n) asm volatile("s_waitcnt lgkmcnt(" #n ")" ::: "memory")
#define PG8_BAR __builtin_amdgcn_s_barrier()
#define PG8_SCHED __builtin_amdgcn_sched_barrier(0)
    Unit cur, nxt; int ui = 0;
    if (!S.next(0, cur)) return;
    f32x4 acc[2][2][4][2];
#pragma unroll
    for (int a = 0; a < 2; ++a)
#pragma unroll
        for (int b = 0; b < 2; ++b)
#pragma unroll
            for (int m = 0; m < 4; ++m)
#pragma unroll
                for (int n = 0; n < 2; ++n) acc[a][b][m][n] = (f32x4){0.f, 0.f, 0.f, 0.f};
    bf16x8 At[4][2], B0[2][2], B1[2][2];
    v8i_t At8[4], B08[2], B18[2];
    const int sclw = S.scale_w(), sclx = S.scale_x();
    const char* cA = S.abase(cur); const char* cB = S.bbase(cur);
    PG8_GLOAD(gA, cur);
    if constexpr (Sched::GATHER) { _Pragma("unroll") for (int _h = 0; _h < 2; ++_h) _Pragma("unroll") for (int _i = 0; _i < 2; ++_i) ngA[_h][_i] = gA[_h][_i]; asm volatile("s_waitcnt vmcnt(0)" ::: "memory"); }
    PG8_STAGE(PG8_SB(0, 0), cB, voffB); PG8_STAGE(PG8_SB(0, 1), cB + hstep, voffB); PG8_STAGE_A(PG8_SA(0, 0), cA, 0, false); PG8_STAGE_A(PG8_SA(0, 1), cA, 1, false);
    if (wr == 1) PG8_BAR;
    PG8_WAIT_V(2); PG8_BAR;
    PG8_STAGE(PG8_SB(1, 0), cB + kstep, voffB); PG8_STAGE_A(PG8_SA(1, 0), cA + kstep, 0, false); PG8_STAGE(PG8_SB(1, 1), cB + hstep + kstep, voffB);
    PG8_WAIT_V(6); PG8_BAR;
    for (;;) {
        const bool has_next = S.next(ui + 1, nxt);
        const char* nA = has_next ? S.abase(nxt) : cA; const char* nB = has_next ? S.bbase(nxt) : cB;
        int rawn[2][2];
        if constexpr (Sched::GATHER) { if (has_next) { _Pragma("unroll") for (int _h = 0; _h < 2; ++_h) _Pragma("unroll") for (int _i = 0; _i < 2; ++_i) rawn[_h][_i] = S.araw(nxt, _h * HALF + Rst[_i]); } }
#pragma unroll 1
        for (int t = 0; t < nt; t += 2) {
            const bool last = (t == nt - 2);
            const char* a1 = cA + (size_t)(t + 1) * kstep;
            const char* a2 = last ? nA : cA + (size_t)(t + 2) * kstep; const char* b2 = last ? nB : cB + (size_t)(t + 2) * kstep;
            const char* a3 = a2 + kstep; const char* b3 = b2 + kstep;
            if constexpr (Sched::GATHER) { if (last && has_next) { _Pragma("unroll") for (int _h = 0; _h < 2; ++_h) _Pragma("unroll") for (int _i = 0; _i < 2; ++_i)
                ngA[_h][_i] = (unsigned)(rawn[_h][_i] < 0 ? 0 : rawn[_h][_i] >> 2) * (unsigned)RB + (unsigned)(Cst[_i] * 2); } }
            PG8_LDB(B0, 0, 0); PG8_LDB(B1, 0, 1); PG8_SCHED; PG8_LDA(At, 0, 0); PG8_STAGE_A(PG8_SA(1, 1), a1, 1, false);
            PG8_WAIT_V(8); PG8_WAIT_L(0); PG8_BAR; PG8_MMA(0, 0, At, B0); PG8_MMA(0, 1, At, B1); PG8_BAR; PG8_SCHED;
            PG8_LDA(At, 0, 1); PG8_STAGE(PG8_SB(0, 0), b2, voffB); PG8_STAGE(PG8_SB(0, 1), b2 + hstep, voffB); PG8_STAGE_A(PG8_SA(0, 0), a2, 0, last);
            PG8_WAIT_V(8); PG8_WAIT_L(0); PG8_BAR; PG8_MMA(1, 0, At, B0); PG8_MMA(1, 1, At, B1); PG8_BAR; PG8_SCHED;
            PG8_LDB(B0, 1, 0); PG8_LDB(B1, 1, 1); PG8_SCHED; PG8_LDA(At, 1, 0); PG8_STAGE_A(PG8_SA(0, 1), a2, 1, last);
            PG8_WAIT_V(8); PG8_WAIT_L(0); PG8_BAR; PG8_MMA(0, 0, At, B0); PG8_MMA(0, 1, At, B1); PG8_BAR; PG8_SCHED;
            PG8_LDA(At, 1, 1); PG8_STAGE(PG8_SB(1, 0), b3, voffB); PG8_STAGE(PG8_SB(1, 1), b3 + hstep, voffB); PG8_STAGE_A(PG8_SA(1, 0), a3, 0, last);
            PG8_WAIT_V(8); PG8_WAIT_L(0); PG8_BAR; PG8_MMA(1, 0, At, B0); PG8_MMA(1, 1, At, B1); PG8_BAR; PG8_SCHED;
        }
        if (ALIGN) { if (wr == 0) PG8_BAR; }
        bool keep = false;
        if constexpr (F8) asm volatile("s_nop 15\n\ts_nop 15" ::: "memory");
        { int tz = tid; asm volatile("" : "+v"(tz)); const int wid2 = __builtin_amdgcn_readfirstlane(tz >> 6), lane2 = tz & 63;
          if constexpr (Epi::CHAIN) keep = E(acc, cur, wid2 >> 2, wid2 & 3, lane2 & 15, lane2 >> 4); else { E(acc, cur, wid2 >> 2, wid2 & 3, lane2 & 15, lane2 >> 4); if constexpr (Epi::TWICE) { asm volatile("" ::: "memory"); E(acc, cur, wid2 >> 2, wid2 & 3, lane2 & 15, lane2 >> 4); } } }
        if (!has_next) break;
        if (!keep)
#pragma unroll
        for (int a = 0; a < 2; ++a)
#pragma unroll
            for (int b = 0; b < 2; ++b)
#pragma unroll
                for (int m = 0; m < 4; ++m)
#pragma unroll
                    for (int n = 0; n < 2; ++n) acc[a][b][m][n] = (f32x4){0.f, 0.f, 0.f, 0.f};
        cur = nxt; cA = nA; cB = nB; ++ui;
        if constexpr (Sched::GATHER) { _Pragma("unroll") for (int _h = 0; _h < 2; ++_h) _Pragma("unroll") for (int _i = 0; _i < 2; ++_i) gA[_h][_i] = ngA[_h][_i]; }
        if (ALIGN) { if (wr == 1) PG8_BAR; }
    }
    PG8_WAIT_V(0);
    if (!ALIGN) { if (wr == 0) PG8_BAR; }
    PG8_BAR;
#undef PG8_SA
#undef PG8_SB
#undef PG8_STAGE
#undef PG8_STAGE_A
#undef PG8_GLOAD
#undef PG8_LDA
#undef PG8_LDB
#undef PG8_MMA
#undef PG8_LD32
#undef PG8_WAIT_V
#undef PG8_WAIT_L
#undef PG8_BAR
#undef PG8_SCHED
}
}
using pg8::Unit;
typedef f32x4 AccT[2][2][4][2];

__device__ __forceinline__ u32x4 pack8(const f32x4 v0, const f32x4 v1) { u32x4 w; w.x = cvt_pk(v0[0], v0[1]); w.y = cvt_pk(v0[2], v0[3]); w.z = cvt_pk(v1[0], v1[1]); w.w = cvt_pk(v1[2], v1[3]); return w; }
constexpr float YSCL = 16.f;
__device__ __forceinline__ u32x2 pack8f8(const f32x4 v0, const f32x4 v1) { int w0 = 0, w1 = 0;
    w0 = __builtin_amdgcn_cvt_pk_fp8_f32(v0[0], v0[1], w0, false); w0 = __builtin_amdgcn_cvt_pk_fp8_f32(v0[2], v0[3], w0, true);
    w1 = __builtin_amdgcn_cvt_pk_fp8_f32(v1[0], v1[1], w1, false); w1 = __builtin_amdgcn_cvt_pk_fp8_f32(v1[2], v1[3], w1, true); return (u32x2){(unsigned)w0, (unsigned)w1}; }
__device__ __forceinline__ void unpack8f8(const u32x2 w, f32x4& v0, f32x4& v1) {
    const f32x2 a = __builtin_amdgcn_cvt_pk_f32_fp8((int)w.x, false), b = __builtin_amdgcn_cvt_pk_f32_fp8((int)w.x, true), c = __builtin_amdgcn_cvt_pk_f32_fp8((int)w.y, false), d = __builtin_amdgcn_cvt_pk_f32_fp8((int)w.y, true);
    v0 = (f32x4){a[0], a[1], b[0], b[1]}; v1 = (f32x4){c[0], c[1], d[0], d[1]}; }
__device__ __forceinline__ void unpack8(const u32x4 w, f32x4& v0, f32x4& v1) { v0 = (f32x4){bf_lo(w.x), bf_hi(w.x), bf_lo(w.y), bf_hi(w.y)}; v1 = (f32x4){bf_lo(w.z), bf_hi(w.z), bf_lo(w.w), bf_hi(w.w)}; }

struct EpiTiles {
    static constexpr bool CHAIN = false, TWICE = (PROBE_REP & 1024) != 0;
    bf16_t* P; const float* bgate;
    __device__ __forceinline__ void operator()(const AccT& acc, const Unit& u, int wr, int wc, int fr, int fq) const {
        bf16_t* base = P + (size_t)u.pn * ((size_t)NR * 256) + (size_t)(u.pm * 256 + wr * 64 + fr) * 256 + wc * 32 + 8 * fq;
        if (u.pn < T_GATE) {
#pragma unroll
            for (int ai = 0; ai < 2; ++ai)
#pragma unroll
                for (int m = 0; m < 4; ++m)
#pragma unroll
                    for (int bj = 0; bj < 2; ++bj)
                        *(u32x4*)(base + (size_t)(ai * 128 + m * 16) * 256 + bj * 128) = pack8(acc[ai][bj][m][0], acc[ai][bj][m][1]);
        } else {
            unsigned char* gb = (unsigned char*)(P + (size_t)u.pn * ((size_t)NR * 256)) + (size_t)u.pm * 65536 + (((wr * 4 + wc) * 64 + fq * 16 + fr) * 16);
            const float* bg = bgate + ((u.pn - T_GATE) >> 2) * 1024 + ((u.pn - T_GATE) & 3) * 256 + wc * 32 + 8 * fq;
#pragma unroll
            for (int bj = 0; bj < 2; ++bj) {
                const f32x4 b0 = *(const f32x4*)(bg + bj * 128) * -LOG2E, b1 = *(const f32x4*)(bg + bj * 128 + 4) * -LOG2E;
#define GATE255(a_, b_) __builtin_amdgcn_rcpf(__builtin_fmaf(__builtin_amdgcn_exp2f(__builtin_fmaf((a_), -LOG2E, (b_))), 1.f / 255.f, 1.f / 255.f))
#pragma unroll
                for (int ai = 0; ai < 2; ++ai)
#pragma unroll
                    for (int mp = 0; mp < 2; ++mp) {
                        u32x4 o = (u32x4){0u, 0u, 0u, 0u};
#pragma unroll
                        for (int j = 0; j < 4; ++j) {
                            o.x = __builtin_amdgcn_cvt_pk_u8_f32(GATE255(acc[ai][bj][2 * mp][0][j], b0[j]), j, o.x); o.y = __builtin_amdgcn_cvt_pk_u8_f32(GATE255(acc[ai][bj][2 * mp][1][j], b1[j]), j, o.y);
                            o.z = __builtin_amdgcn_cvt_pk_u8_f32(GATE255(acc[ai][bj][2 * mp + 1][0][j], b0[j]), j, o.z); o.w = __builtin_amdgcn_cvt_pk_u8_f32(GATE255(acc[ai][bj][2 * mp + 1][1][j], b1[j]), j, o.w); }
#undef GATE255
                        o.x |= 0x01010101u; o.y |= 0x01010101u; o.z |= 0x01010101u; o.w |= 0x01010101u;
                        *(u32x4*)(gb + ((bj * 2 + ai) * 2 + mp) * 8192) = o;
                    }
            }
        }
    }
};

struct MergeOrder {
    static constexpr bool GATHER = false, FP8 = false;
    __device__ __forceinline__ int scale_w() const { return 0; }
    __device__ __forceinline__ int scale_x() const { return 0; }
    __device__ __forceinline__ int arow(const Unit&, int) const { return 0; }
    __device__ __forceinline__ int araw(const Unit&, int) const { return 0; }
    int G, c, ntile; bool skipctx; const char* P; const char* Wbr;
    __device__ bool next(int i, Unit& u) const {
        const int T = (i >> 2) * G + c; if (T >= ntile) return false;
        int pm = T >> 2; u.pn = T & 3; u.z = i & 3;
        if (skipctx) pm = (pm >> 4) * 17 + 1 + (pm & 15);
        u.pm = pm; return true;
    }
    __device__ __forceinline__ const char* abase(const Unit& u) const { const int tz = (u.z == 0) ? T_AQ : (u.z == 1) ? T_GQ : (u.z == 2) ? T_MU : T_DG; return P + (size_t)tz * PT_BYTES + (size_t)u.pm * (256 * 256 * 2); }
    __device__ __forceinline__ const char* bbase(const Unit& u) const { return Wbr + (size_t)u.z * (1024 * 256 * 2) + (size_t)u.pn * (256 * 256 * 2); }
};
struct EpiMerge {
    static constexpr bool CHAIN = true, TWICE = false;
    const bf16_t* P; bf16_t* merged;
    __device__ __forceinline__ bool operator()(AccT& acc, const Unit& u, int wr, int wc, int fr, int fq) const {
        const int row0 = u.pm * 256 + wr * 64 + fr, colt = wc * 32 + 8 * fq;
        const unsigned char* g0p = (const unsigned char*)(P + (size_t)(T_GATE + 4 * u.z + u.pn) * ((size_t)NR * 256)) + (size_t)u.pm * 65536 + (((wr * 4 + wc) * 64 + fq * 16 + fr) * 16);
        if (u.z < 3) {
            const unsigned char* g1p = g0p + (size_t)4 * PT_BYTES;
            u32x4 ga[2][2], gb[2][2];
#pragma unroll
            for (int q = 0; q < 2; ++q)
#pragma unroll
                for (int h = 0; h < 2; ++h) { ga[q][h] = *(const u32x4*)(g0p + (2 * q + h) * 8192); gb[q][h] = *(const u32x4*)(g1p + (2 * q + h) * 8192); }
#pragma unroll
            for (int q = 0; q < 4; ++q) {
                const int bj = q >> 1, ai = q & 1;
#pragma unroll
                for (int m = 0; m < 4; ++m) {
                    const u32x4 A = ga[q & 1][m >> 1], B = gb[q & 1][m >> 1];
                    const unsigned a0 = (m & 1) ? A.z : A.x, a1 = (m & 1) ? A.w : A.y, b0 = (m & 1) ? B.z : B.x, b1 = (m & 1) ? B.w : B.y;
#pragma unroll
                    for (int j = 0; j < 4; ++j) {
                        acc[ai][bj][m][0][j] *= (float)((a0 >> (8 * j)) & 0xffu) * __builtin_amdgcn_rcpf((float)((b0 >> (8 * j)) & 0xffu));
                        acc[ai][bj][m][1][j] *= (float)((a1 >> (8 * j)) & 0xffu) * __builtin_amdgcn_rcpf((float)((b1 >> (8 * j)) & 0xffu));
                    }
                }
                if (q < 2) {
#pragma unroll
                    for (int h = 0; h < 2; ++h) { ga[q & 1][h] = *(const u32x4*)(g0p + (2 * (q + 2) + h) * 8192); gb[q & 1][h] = *(const u32x4*)(g1p + (2 * (q + 2) + h) * 8192); }
                }
            }
            return true;
        }
        u32x4 ga[8];
#pragma unroll
        for (int i = 0; i < 8; ++i) ga[i] = *(const u32x4*)(g0p + i * 8192);
        bf16_t* mp = merged + (size_t)row0 * 1024 + u.pn * 256 + colt;
#pragma unroll
        for (int bj = 0; bj < 2; ++bj)
#pragma unroll
            for (int ai = 0; ai < 2; ++ai)
#pragma unroll
                for (int m = 0; m < 4; ++m) {
                    const int i = (bj * 2 + ai) * 2 + (m >> 1);
                    const unsigned a0 = (m & 1) ? ga[i].z : ga[i].x, a1 = (m & 1) ? ga[i].w : ga[i].y;
                    f32x4 o0, o1;
#pragma unroll
                    for (int j = 0; j < 4; ++j) { o0[j] = acc[ai][bj][m][0][j] * ((float)((a0 >> (8 * j)) & 0xffu) * (1.f / 255.f)); o1[j] = acc[ai][bj][m][1][j] * ((float)((a1 >> (8 * j)) & 0xffu) * (1.f / 255.f)); }
                    *(u32x4*)(mp + (size_t)(ai * 128 + m * 16) * 1024 + bj * 128) = pack8(o0, o1);
                }
        return false;
    }
};

struct EpiWo {
    static constexpr bool CHAIN = false, TWICE = false;
    const float* xin_lat; const float* xin_ctx; bf16_t* xb; const float* mod_l;
    int which;
    __device__ __forceinline__ void operator()(const AccT& acc, const Unit& u, int wr, int wc, int fr, int fq) const {
        const int b = u.pm / 17, j = u.pm - b * 17; const bool isctx = (j == 0);
        const float* gv = mod_l + (size_t)(isctx ? 16 : b) * 6144 + which * 1024 + u.pn * 256 + wc * 32 + 8 * fq;
        const int r0 = wr * 64 + fr; const int c0 = u.pn * 256 + wc * 32 + 8 * fq;
        bf16_t* xo = xb + (size_t)u.pm * 256 * 1024;
        if (xin_lat != nullptr) {
            const float* xin = isctx ? xin_ctx + (size_t)b * 256 * 1024 : xin_lat + ((size_t)b * 4096 + (size_t)(j - 1) * 256) * 1024;
#pragma unroll
            for (int bj = 0; bj < 2; ++bj) {
                const f32x4 g0 = *(const f32x4*)(gv + bj * 128), g1 = *(const f32x4*)(gv + bj * 128 + 4);
#pragma unroll
                for (int ai = 0; ai < 2; ++ai)
#pragma unroll
                    for (int m = 0; m < 4; ++m) {
                        const size_t off = (size_t)(r0 + ai * 128 + m * 16) * 1024 + c0 + bj * 128;
                        const f32x4 x0 = *(const f32x4*)(xin + off), x1 = *(const f32x4*)(xin + off + 4);
                        *(u32x4*)(xo + off) = pack8(x0 + g0 * acc[ai][bj][m][0], x1 + g1 * acc[ai][bj][m][1]);
                    }
            }
        } else {
#pragma unroll
            for (int bj = 0; bj < 2; ++bj) {
                const f32x4 g0 = *(const f32x4*)(gv + bj * 128), g1 = *(const f32x4*)(gv + bj * 128 + 4);
#pragma unroll
                for (int ai = 0; ai < 2; ++ai)
#pragma unroll
                    for (int m = 0; m < 4; ++m) {
                        const size_t off = (size_t)(r0 + ai * 128 + m * 16) * 1024 + c0 + bj * 128;
                        f32x4 x0, x1; unpack8(*(const u32x4*)(xo + off), x0, x1);
                        *(u32x4*)(xo + off) = pack8(x0 + g0 * acc[ai][bj][m][0], x1 + g1 * acc[ai][bj][m][1]);
                    }
            }
        }
    }
};

template <int NPN, bool GATH>
struct MoeOrder {
    static constexpr bool GATHER = GATH, FP8 = true;
    __device__ __forceinline__ int scale_w() const { return 0x7a7a7a7a; }
    __device__ __forceinline__ int scale_x() const { return 0x7f7f7f7f; }
    int G, c, nunits; const LAS int* texp; const char* A; const char* W; size_t wstride; const int* rowmap;
    __device__ __forceinline__ int arow(const Unit& u, int r) const { const int rm = rowmap[u.pm * 256 + r]; return rm < 0 ? 0 : rm >> 2; }
    __device__ __forceinline__ int araw(const Unit& u, int r) const { return rowmap[u.pm * 256 + r]; }
    __device__ bool next(int i, Unit& u) const {
        constexpr int RT = 32 / NPN;
        const int xcd = c & 7, idx = c >> 3, rt = idx / NPN;
        const int pm = (i * RT + rt) * 8 + xcd; if (pm * NPN >= nunits) return false;
        u.pm = pm; u.pn = idx % NPN; u.z = texp[pm]; return true;
    }
    __device__ __forceinline__ const char* abase(const Unit& u) const { return GATH ? A : A + (size_t)u.pm * (256 * 1024); }
    __device__ __forceinline__ const char* bbase(const Unit& u) const { return W + (size_t)u.z * wstride + (size_t)u.pn * (256 * 1024); }
};
struct EpiUp {
    static constexpr bool CHAIN = false, TWICE = false;
    const float* bup; unsigned char* act;
    __device__ __forceinline__ void operator()(const AccT& acc, const Unit& u, int wr, int wc, int fr, int fq) const {
        const int colt = u.pn * 128 + wc * 32 + 8 * fq;
        const float* bb = bup + (size_t)u.z * 2048 + colt;
        const f32x4 bg0 = *(const f32x4*)(bb), bg1 = *(const f32x4*)(bb + 4), bl0 = *(const f32x4*)(bb + 1024) + 1.f, bl1 = *(const f32x4*)(bb + 1028) + 1.f;
        unsigned char* base = act + (size_t)(u.pm * 256 + wr * 64 + fr) * 1024 + colt;
#pragma unroll
        for (int ai = 0; ai < 2; ++ai)
#pragma unroll
            for (int m = 0; m < 4; ++m) {
                f32x4 o0, o1;
#pragma unroll
                for (int j = 0; j < 4; ++j) {
                    float g = fminf(acc[ai][0][m][0][j] + bg0[j], 7.f), li = fminf(fmaxf(acc[ai][1][m][0][j] + bl0[j], -6.f), 8.f);
                    o0[j] = g * sigmoidf_(1.702f * g) * li;
                    g = fminf(acc[ai][0][m][1][j] + bg1[j], 7.f); li = fminf(fmaxf(acc[ai][1][m][1][j] + bl1[j], -6.f), 8.f);
                    o1[j] = g * sigmoidf_(1.702f * g) * li;
                }
                int w0 = 0, w1 = 0;
                w0 = __builtin_amdgcn_cvt_pk_fp8_f32(o0[0], o0[1], w0, false); w0 = __builtin_amdgcn_cvt_pk_fp8_f32(o0[2], o0[3], w0, true);
                w1 = __builtin_amdgcn_cvt_pk_fp8_f32(o1[0], o1[1], w1, false); w1 = __builtin_amdgcn_cvt_pk_fp8_f32(o1[2], o1[3], w1, true);
                *(u32x2*)(base + (size_t)(ai * 128 + m * 16) * 1024) = (u32x2){(unsigned)w0, (unsigned)w1};
            }
    }
};
struct EpiDown {
    static constexpr bool CHAIN = false, TWICE = false;
    const float* bdn; const float* gslot; unsigned char* ybuf;
    __device__ __forceinline__ void operator()(const AccT& acc, const Unit& u, int wr, int wc, int fr, int fq) const {
        const int colt = u.pn * 256 + wc * 32 + 8 * fq;
        const float* bb = bdn + (size_t)u.z * 1024 + colt;
        const f32x4 b00 = *(const f32x4*)(bb), b01 = *(const f32x4*)(bb + 4), b10 = *(const f32x4*)(bb + 128), b11 = *(const f32x4*)(bb + 132);
        const int row0 = u.pm * 256 + wr * 64 + fr;
        float gtv[2][4];
#pragma unroll
        for (int ai = 0; ai < 2; ++ai)
#pragma unroll
            for (int m = 0; m < 4; ++m) gtv[ai][m] = gslot[row0 + ai * 128 + m * 16];
#pragma unroll
        for (int ai = 0; ai < 2; ++ai)
#pragma unroll
            for (int m = 0; m < 4; ++m) {
                const float gt = gtv[ai][m] * YSCL;
                unsigned char* yp = ybuf + (size_t)(row0 + ai * 128 + m * 16) * 1024 + colt;
                *(u32x2*)(yp) = pack8f8((acc[ai][0][m][0] + b00) * gt, (acc[ai][0][m][1] + b01) * gt);
                *(u32x2*)(yp + 128) = pack8f8((acc[ai][1][m][0] + b10) * gt, (acc[ai][1][m][1] + b11) * gt);
            }
    }
};
__device__ __forceinline__ void xpose_tile(const float* __restrict__ src, int ld, int valid, bf16_t* __restrict__ dst, int Kd, LAS float* scr, int lane) {
    const int c4 = (lane & 15) * 4, kr = lane >> 4;
    f32x4 v[16];
#pragma unroll
    for (int i = 0; i < 16; ++i) v[i] = (c4 < valid) ? *(const f32x4*)(src + (size_t)(i * 4 + kr) * ld + c4) : (f32x4){0.f, 0.f, 0.f, 0.f};
#pragma unroll
    for (int i = 0; i < 16; ++i) { LAS float* s = scr + (i * 4 + kr) * 65 + c4; s[0] = v[i][0]; s[1] = v[i][1]; s[2] = v[i][2]; s[3] = v[i][3]; }
    LDS_WAIT(); asm volatile("" ::: "memory");
    const int c = lane & 7;
#pragma unroll
    for (int j = 0; j < 8; ++j) { const int n = (lane >> 3) + 8 * j; const LAS float* s = scr + (8 * c) * 65 + n;
        u32x4 o; o.x = cvt_pk(s[0 * 65], s[1 * 65]); o.y = cvt_pk(s[2 * 65], s[3 * 65]); o.z = cvt_pk(s[4 * 65], s[5 * 65]); o.w = cvt_pk(s[6 * 65], s[7 * 65]);
        *(u32x4*)(dst + (size_t)n * Kd + 8 * c) = o; }
    LDS_WAIT(); asm volatile("" ::: "memory");
}

__device__ __forceinline__ void xpose_tile8(const float* __restrict__ src, int ld, unsigned char* __restrict__ dst, int Kd, LAS float* scr, int lane) {
    const int c4 = (lane & 15) * 4, kr = lane >> 4;
    f32x4 v[16];
#pragma unroll
    for (int i = 0; i < 16; ++i) v[i] = *(const f32x4*)(src + (size_t)(i * 4 + kr) * ld + c4);
#pragma unroll
    for (int i = 0; i < 16; ++i) { LAS float* s = scr + (i * 4 + kr) * 65 + c4; s[0] = v[i][0]; s[1] = v[i][1]; s[2] = v[i][2]; s[3] = v[i][3]; }
    LDS_WAIT(); asm volatile("" ::: "memory");
    const int c = lane & 7;
#pragma unroll
    for (int j = 0; j < 8; ++j) { const int n = (lane >> 3) + 8 * j; const LAS float* s = scr + (8 * c) * 65 + n;
        int w0 = 0, w1 = 0;
        w0 = __builtin_amdgcn_cvt_pk_fp8_f32(s[0 * 65] * 32.f, s[1 * 65] * 32.f, w0, false); w0 = __builtin_amdgcn_cvt_pk_fp8_f32(s[2 * 65] * 32.f, s[3 * 65] * 32.f, w0, true);
        w1 = __builtin_amdgcn_cvt_pk_fp8_f32(s[4 * 65] * 32.f, s[5 * 65] * 32.f, w1, false); w1 = __builtin_amdgcn_cvt_pk_fp8_f32(s[6 * 65] * 32.f, s[7 * 65] * 32.f, w1, true);
        *(u32x2*)(dst + (size_t)n * Kd + 8 * c) = (u32x2){(unsigned)w0, (unsigned)w1}; }
    LDS_WAIT(); asm volatile("" ::: "memory");
}

__device__ __forceinline__ void p_prologue(const Frame& F, const Args& a) {
    LAS float* scr = (LAS float*)(F.lds + F.wave * 16640);
    const int gw = F.blk * 8 + F.wave, NGW = GRID * 8;
    constexpr int N_IN = 16 * 112, N_BR = 4 * 4 * 16, N_O = 256, N_UP = 32 * 16 * 32, N_DN = 32 * 16 * 16, N_L = N_IN + N_BR + N_O + N_UP + N_DN;
    for (int it = gw; it < 2 * N_L; it += NGW) {
        const int l = it / N_L; int r = it - l * N_L;
        if (r < N_IN) {
            const int kt = r / 112, ntile = r - kt * 112, n0 = ntile * 64;
            int src0, valid;
            if (n0 < 2816) { src0 = n0; valid = 64; } else if (n0 == 2816) { src0 = 2816; valid = 16; } else if (n0 < 3072) { src0 = 0; valid = 0; } else { src0 = n0 - 240; valid = 64; }
            if (n0 < 3072) xpose_tile(F.in[I_WIN] + (size_t)l * 1024 * 6928 + (size_t)(kt * 64) * 6928 + src0, 6928, valid,
                       (bf16_t*)(F.ws + WS_WIN) + (size_t)l * 7168 * 1024 + (size_t)n0 * 1024 + kt * 64, 1024, scr, F.lane);
            else xpose_tile8(F.in[I_WIN] + (size_t)l * 1024 * 6928 + (size_t)(kt * 64) * 6928 + src0, 6928,
                       (unsigned char*)(F.ws + WS_WG8) + (size_t)l * 4096 * 1024 + (size_t)(n0 - 3072) * 1024 + kt * 64, 1024, scr, F.lane);
            continue; }
        r -= N_IN;
        if (r < N_BR) {
            const int n = r >> 6, rr = r & 63, kt = rr >> 4, ntile = rr & 15;
            xpose_tile(F.in[I_WBR] + ((size_t)(l * 4 + n) * 256 + kt * 64) * 1024 + ntile * 64, 1024, 64,
                       (bf16_t*)(F.ws + WS_WBR) + (size_t)(l * 4 + n) * 1024 * 256 + (size_t)(ntile * 64) * 256 + kt * 64, 256, scr, F.lane);
            continue; }
        r -= N_BR;
        if (r < N_O) {
            const int kt = r >> 4, ntile = r & 15;
            xpose_tile(F.in[I_WO] + ((size_t)l * 1024 + kt * 64) * 1024 + ntile * 64, 1024, 64,
                       (bf16_t*)(F.ws + WS_WO) + (size_t)l * 1024 * 1024 + (size_t)(ntile * 64) * 1024 + kt * 64, 1024, scr, F.lane);
            continue; }
        r -= N_O;
        if (r < N_UP) {
            const int e = r >> 9, rr = r & 511, kt = rr >> 5, ntile = rr & 31, n0 = ntile * 64;
            const int j = n0 >> 8, w = n0 & 255, src0 = (w < 128) ? (128 * j + w) : (1024 + 128 * j + (w - 128));
            xpose_tile8(F.in[I_WUP] + ((size_t)(l * 32 + e) * 1024 + kt * 64) * 2048 + src0, 2048,
                        (unsigned char*)(F.ws + WS_WUP) + (size_t)(l * 32 + e) * 2048 * 1024 + (size_t)n0 * 1024 + kt * 64, 1024, scr, F.lane);
            continue; }
        r -= N_UP;
        {
            const int e = r >> 8, rr = r & 255, kt = rr >> 4, ntile = rr & 15;
            xpose_tile8(F.in[I_WDN] + ((size_t)(l * 32 + e) * 1024 + kt * 64) * 1024 + ntile * 64, 1024,
                        (unsigned char*)(F.ws + WS_WDN) + (size_t)(l * 32 + e) * 1024 * 1024 + (size_t)(ntile * 64) * 1024 + kt * 64, 1024, scr, F.lane);
        }
    }
    { const int gt = F.blk * 512 + F.tid, NT = GRID * 512; const float* s = F.in[I_GMWS]; bf16_t* d = (bf16_t*)(F.ws + WS_GMWS);
      for (int i = gt; i < 2 * 4 * 128 * 128 / 4; i += NT) { const f32x4 v = *(const f32x4*)(s + (size_t)i * 4); u32x2 o; o.x = cvt_pk(v[0], v[1]); o.y = cvt_pk(v[2], v[3]); *(u32x2*)(d + (size_t)i * 4) = o; } }
    { const int gt = F.blk * 512 + F.tid;
      if (gt < 1536) {
          const int sel = gt >= 512, idx = sel ? gt - 512 : gt, Q = sel ? 16 : 8, pos = idx / Q, i = idx - pos * Q;
          const float inv = sel ? a.inv64[i] : a.inv32[i];
          const float af = (float)pos * inv;
          double x = (double)af; const double twopi = 6.283185307179586476925287;
          x -= twopi * rint(x / twopi);
          const double x2 = x * x;
          double sn = 1.0, cs = 1.0;
#pragma unroll
          for (int k = 13; k >= 1; --k) { sn = 1.0 - sn * x2 / (double)((2 * k) * (2 * k + 1)); cs = 1.0 - cs * x2 / (double)((2 * k - 1) * (2 * k)); }
          sn *= x;
          f32x2* T = (f32x2*)(F.ws + WS_ROPE);
          T[gt] = (f32x2){(float)cs, (float)sn};
      } }
    __syncthreads();
    {
        LAS float* s = (LAS float*)F.lds;
        LAS float* red = s + 17 * 1024;
        for (int idx = F.tid; idx < 17 * 1024; idx += 512) { const int i = idx >> 10, k = idx & 1023; const float c = (i < 16) ? F.in[I_C][i * 1024 + k] : F.in[I_CCTX][k]; s[idx] = siluf_(c); }
        __syncthreads();
        float* mod = (float*)(F.ws + WS_MOD);
        for (int item = F.blk; item < 96; item += GRID) {
            const int l = item / 48, j0 = (item - l * 48) * 128, jj = F.tid & 127, kp = F.tid >> 7;
            float acc[17];
#pragma unroll
            for (int i = 0; i < 17; ++i) acc[i] = 0.f;
            const float* w = F.in[I_WMOD] + (size_t)l * 1024 * 6144 + (size_t)(kp * 256) * 6144 + j0 + jj;
            const LAS float* sk = s + kp * 256;
#pragma unroll 4
            for (int k = 0; k < 256; ++k) { const float wv = w[(size_t)k * 6144];
#pragma unroll
                for (int i = 0; i < 17; ++i) acc[i] += sk[i * 1024 + k] * wv; }
#pragma unroll
            for (int i = 0; i < 17; ++i) red[(kp * 17 + i) * 128 + jj] = acc[i];
            __syncthreads();
            for (int idx = F.tid; idx < 17 * 128; idx += 512) { const int i = idx >> 7, j = idx & 127;
                mod[(size_t)(l * 17 + i) * 6144 + j0 + j] = red[(0 * 17 + i) * 128 + j] + red[(1 * 17 + i) * 128 + j] + red[(2 * 17 + i) * 128 + j] + red[(3 * 17 + i) * 128 + j] + F.in[I_BMOD][l * 6144 + j0 + j]; }
            __syncthreads();
        }
    }
}
template <int MODE>
__device__ __forceinline__ void p_rowpass(const Frame& F, int l) {
    const int gw = F.blk * 8 + F.wave, NGW = GRID * 8;
    const unsigned char* ybuf = F.ar + A_YBUF; const unsigned* seli = (const unsigned*)(F.ws + WS_SELI);
    bf16_t* H = (bf16_t*)(F.ar + A_H); unsigned char* H8 = F.ar + A_H8;
    bf16_t* XB = (bf16_t*)(F.ws + WS_XB);
    constexpr int NQ = 2;
    const int lc = F.lane * 8;
    u32x4 slv[NQ];
    if (MODE >= 1) {
#pragma unroll
        for (int q = 0; q < NQ; ++q) slv[q] = *(const u32x4*)(seli + (size_t)(gw * NQ + q) * 4);
    }
    for (int R0 = gw * NQ; R0 < NR; R0 += NGW * NQ) {
        f32x4 v[NQ][4]; u32x4 xw[NQ][2]; u32x2 yv[NQ][2][4]; int mir[NQ]; bool act[NQ];
        u32x4 sln[NQ];
        if (MODE >= 1) { const int Rn = (R0 + NGW * NQ < NR) ? R0 + NGW * NQ : R0;
#pragma unroll
            for (int q = 0; q < NQ; ++q) sln[q] = *(const u32x4*)(seli + (size_t)(Rn + q) * 4); }
#pragma unroll
        for (int q = 0; q < NQ; ++q) {
            const int R = R0 + q;
            const int b = R / TPB, p = R - b * TPB; const bool isctx = p < CTXL; mir[q] = isctx ? 16 : b;
            act[q] = !(MODE == 2 && isctx);
            if (MODE == 0) {
                const float* xin = isctx ? F.in[I_CTX] + ((size_t)b * 256 + p) * 1024 : F.in[I_X] + ((size_t)b * 4096 + (p - 256)) * 1024;
#pragma unroll
                for (int c = 0; c < 2; ++c) { v[q][2 * c] = *(const f32x4*)(xin + lc + 512 * c); v[q][2 * c + 1] = *(const f32x4*)(xin + lc + 512 * c + 4); }
            } else if (act[q]) {
#pragma unroll
                for (int c = 0; c < 2; ++c) xw[q][c] = *(const u32x4*)(XB + (size_t)R * 1024 + lc + 512 * c);
                const u32x4 sl = slv[q];
#pragma unroll
                for (int c = 0; c < 2; ++c) {
                    yv[q][c][0] = *(const u32x2*)(ybuf + (size_t)sl.x * 1024 + lc + 512 * c); yv[q][c][1] = *(const u32x2*)(ybuf + (size_t)sl.y * 1024 + lc + 512 * c);
                    yv[q][c][2] = *(const u32x2*)(ybuf + (size_t)sl.z * 1024 + lc + 512 * c); yv[q][c][3] = *(const u32x2*)(ybuf + (size_t)sl.w * 1024 + lc + 512 * c); }
            }
        }
#pragma unroll
        for (int q = 0; q < NQ; ++q) {
            if (!act[q]) continue;
            const int R = R0 + q;
            if (MODE >= 1) {
                const float* g2 = modv(F, l - 1, mir[q], 5);
#pragma unroll
                for (int c = 0; c < 2; ++c) {
                    f32x4 s0 = (f32x4){0.f, 0.f, 0.f, 0.f}, s1 = s0;
#pragma unroll
                    for (int k = 0; k < 4; ++k) { f32x4 a0, a1; unpack8f8(yv[q][c][k], a0, a1); s0 += a0; s1 += a1; }
                    f32x4 x0, x1; unpack8(xw[q][c], x0, x1);
                    v[q][2 * c] = x0 + (*(const f32x4*)(g2 + lc + 512 * c) * (1.f / YSCL)) * s0; v[q][2 * c + 1] = x1 + (*(const f32x4*)(g2 + lc + 512 * c + 4) * (1.f / YSCL)) * s1;
                    if (MODE == 1) *(u32x4*)(XB + (size_t)R * 1024 + lc + 512 * c) = pack8(v[q][2 * c], v[q][2 * c + 1]);
                    else { const int b = R / TPB, p = R - b * TPB; float* xo = F.out + ((size_t)b * 4096 + (p - 256)) * 1024 + lc + 512 * c;
                        *(f32x4*)xo = v[q][2 * c]; *(f32x4*)(xo + 4) = v[q][2 * c + 1]; }
                }
            }
            if (MODE <= 1) {
                float ss = 0.f;
#pragma unroll
                for (int j = 0; j < 4; ++j) ss += (v[q][j][0] * v[q][j][0] + v[q][j][1] * v[q][j][1]) + (v[q][j][2] * v[q][j][2] + v[q][j][3] * v[q][j][3]);
                const float rstd = rsqrtf(wave_sum(ss) * (1.f / 1024.f) + EPS);
                const float* gn = F.in[I_N1G] + l * 1024; const float* sh = modv(F, l, mir[q], 0); const float* sc = modv(F, l, mir[q], 1);
#pragma unroll
                for (int c = 0; c < 2; ++c) { const int cc = lc + 512 * c;
                    const f32x4 h0 = v[q][2 * c] * rstd * *(const f32x4*)(gn + cc) * (*(const f32x4*)(sc + cc) + 1.f) + *(const f32x4*)(sh + cc);
                    const f32x4 h1 = v[q][2 * c + 1] * rstd * *(const f32x4*)(gn + cc + 4) * (*(const f32x4*)(sc + cc + 4) + 1.f) + *(const f32x4*)(sh + cc + 4);
                    *(u32x4*)(H + (size_t)R * 1024 + cc) = pack8(h0, h1);
                    int w0 = 0, w1 = 0; w0 = __builtin_amdgcn_cvt_pk_fp8_f32(h0[0], h0[1], w0, false); w0 = __builtin_amdgcn_cvt_pk_fp8_f32(h0[2], h0[3], w0, true);
                    w1 = __builtin_amdgcn_cvt_pk_fp8_f32(h1[0], h1[1], w1, false); w1 = __builtin_amdgcn_cvt_pk_fp8_f32(h1[2], h1[3], w1, true);
                    *(u32x2*)(H8 + (size_t)R * 1024 + cc) = (u32x2){(unsigned)w0, (unsigned)w1}; }
            }
        }
        if (MODE >= 1) {
#pragma unroll
            for (int q = 0; q < NQ; ++q) slv[q] = sln[q]; }
    }
}

template <int HD>
__device__ __forceinline__ void qk_norm_rope(bf16_t* p, const float* gain, float post, int pos, const f32x2* rt, bf16_t* po = nullptr) {
    if (!po) po = p;
    float x[HD];
#pragma unroll
    for (int i = 0; i < HD / 8; ++i) { const u32x4 w = *(const u32x4*)(p + 8 * i); x[8 * i] = bf_lo(w.x); x[8 * i + 1] = bf_hi(w.x); x[8 * i + 2] = bf_lo(w.y); x[8 * i + 3] = bf_hi(w.y);
        x[8 * i + 4] = bf_lo(w.z); x[8 * i + 5] = bf_hi(w.z); x[8 * i + 6] = bf_lo(w.w); x[8 * i + 7] = bf_hi(w.w); }
    float ss = 0.f;
#pragma unroll
    for (int i = 0; i < HD; ++i) ss += x[i] * x[i];
    const float r = rsqrtf(ss * (1.f / HD) + EPS);
#pragma unroll
    for (int i = 0; i < HD; ++i) x[i] = x[i] * r * gain[i];
    if (pos >= 0) {
        constexpr int Q = HD / 4; const int row = pos >> 6, col = pos & 63;
#pragma unroll
        for (int i = 0; i < Q; ++i) {
            const f32x2 cr = rt[row * Q + i], cc = rt[col * Q + i];
            const float a = x[i], b = x[i + Q]; x[i] = a * cr[0] - b * cr[1]; x[i + Q] = b * cr[0] + a * cr[1];
            const float c = x[2 * Q + i], d = x[3 * Q + i]; x[2 * Q + i] = c * cc[0] - d * cc[1]; x[3 * Q + i] = d * cc[0] + c * cc[1];
        }
    }
#pragma unroll
    for (int i = 0; i < HD / 8; ++i) { u32x4 w; w.x = cvt_pk(x[8 * i] * post, x[8 * i + 1] * post); w.y = cvt_pk(x[8 * i + 2] * post, x[8 * i + 3] * post);
        w.z = cvt_pk(x[8 * i + 4] * post, x[8 * i + 5] * post); w.w = cvt_pk(x[8 * i + 6] * post, x[8 * i + 7] * post); *(u32x4*)(po + 8 * i) = w; }
}

template <bool gdn_only = false, bool dry = false>
__device__ __forceinline__ void p_prep(const Frame& F, int l) {
    bf16_t* dummy = (bf16_t*)(F.ar + A_CH);
    const int gt = F.blk * 512 + F.tid, NT = GRID * 512;
    const f32x2* rope = (const f32x2*)(F.ws + WS_ROPE);
    if (!gdn_only) for (int idx = gt; idx < NR * 8; idx += NT) {
        const int R = idx >> 3, grp = idx & 7, p = R % TPB; const int pos = (p < CTXL) ? -1 : p - CTXL;
        qk_norm_rope<32>(ptile(F, T_AK) + (size_t)R * 256 + grp * 32, F.in[I_DAKG] + l * 32, 1.f, pos, rope, dry ? dummy + (size_t)R * 256 + grp * 32 : nullptr);
    }
    if (!gdn_only) for (int idx = gt; idx < NR * 2; idx += NT) {
        const int R = idx >> 1, grp = idx & 1, p = R % TPB; const int pos = (p < CTXL) ? -1 : p - CTXL;
        qk_norm_rope<64>(ptile(F, T_GKV) + (size_t)R * 256 + grp * 64, F.in[I_GAKG] + l * 64, 1.f, pos, rope + 512, dry ? dummy + (size_t)R * 256 + grp * 64 : nullptr);
    }
    if (dry) return;
    const int gw = F.blk * 8 + F.wave, NGW = GRID * 8;
    bf16_t* Gq = (bf16_t*)(F.ar + A_H); bf16_t* Gk = Gq + (size_t)NR * 256; bf16_t* Gv = Gk + (size_t)NR * 256;
    float* GB = (float*)(F.ws + WS_GB);
    const float* cw = F.in[I_CONVW] + (size_t)l * 5 * 768;
    const int c = F.lane * 4;
    f32x4 cwv[5][3];
#pragma unroll
    for (int j = 0; j < 5; ++j)
#pragma unroll
        for (int part = 0; part < 3; ++part) cwv[j][part] = *(const f32x4*)(cw + j * 768 + part * 256 + c);
    const f32x4 vg = *(const f32x4*)(F.in[I_GMVG] + l * 256 + c);
    for (int G4 = gw; G4 < NR / 4; G4 += NGW) {
        const int R0 = G4 * 4, p0 = R0 % TPB, Rb = R0 - p0;
        const int lo = (p0 < CTXL) ? 0 : CTXL, hi = (p0 < CTXL) ? CTXL : TPB;
        u32x2 win[8][3];
#pragma unroll
        for (int w = 0; w < 8; ++w) { const int pp = p0 - 2 + w; const int pc = pp < lo ? lo : (pp >= hi ? hi - 1 : pp);
#pragma unroll
            for (int part = 0; part < 3; ++part) win[w][part] = *(const u32x2*)(ptile(F, T_DQ + part) + (size_t)(Rb + pc) * 256 + c); }
        u32x2 vw[4];
        if (!gdn_only) {
#pragma unroll
            for (int r = 0; r < 4; ++r) vw[r] = *(const u32x2*)(ptile(F, T_MV) + (size_t)(R0 + r) * 256 + c);
        }
        float ab; { const int rr = F.lane >> 4, cc = F.lane & 15; ab = bf2f(ptile(F, T_DAB)[(size_t)(R0 + rr) * 256 + cc]); }
#pragma unroll
        for (int w = 0; w < 8; ++w) { const int pp = p0 - 2 + w; if (pp < lo || pp >= hi) {
#pragma unroll
            for (int part = 0; part < 3; ++part) win[w][part] = (u32x2){0u, 0u}; } }
        if (!gdn_only) {
#pragma unroll
            for (int r = 0; r < 4; ++r) {
                const float v0 = gelu_erf(bf_lo(vw[r].x)), v1 = gelu_erf(bf_hi(vw[r].x)), v2 = gelu_erf(bf_lo(vw[r].y)), v3 = gelu_erf(bf_hi(vw[r].y));
                const float rs = rsqrtf(wave_sum((v0 * v0 + v1 * v1) + (v2 * v2 + v3 * v3)) * (1.f / 256.f) + EPS);
                u32x2 o; o.x = cvt_pk(v0 * rs * vg[0], v1 * rs * vg[1]); o.y = cvt_pk(v2 * rs * vg[2], v3 * rs * vg[3]); *(u32x2*)(ptile(F, T_MV) + (size_t)(R0 + r) * 256 + c) = o;
            }
        }
#pragma unroll
        for (int r = 0; r < 4; ++r) {
            float y[3][4];
#pragma unroll
            for (int part = 0; part < 3; ++part) {
                f32x4 a = (f32x4){0.f, 0.f, 0.f, 0.f};
#pragma unroll
                for (int j = 0; j < 5; ++j) { const u32x2 w = win[r + j][part]; a += (f32x4){bf_lo(w.x), bf_hi(w.x), bf_lo(w.y), bf_hi(w.y)} * cwv[j][part]; }
#pragma unroll
                for (int i = 0; i < 4; ++i) y[part][i] = siluf_(a[i]);
            }
            float sq = (y[0][0] * y[0][0] + y[0][1] * y[0][1]) + (y[0][2] * y[0][2] + y[0][3] * y[0][3]);
            float sk = (y[1][0] * y[1][0] + y[1][1] * y[1][1]) + (y[1][2] * y[1][2] + y[1][3] * y[1][3]);
            sq = sum16(sq); sk = sum16(sk);
            const float rq = rsqrtf(sq + EPS) * 0.125f, rk = rsqrtf(sk + EPS);
            const size_t off = (size_t)(R0 + r) * 256 + c;
            u32x2 o; o.x = cvt_pk(y[0][0] * rq, y[0][1] * rq); o.y = cvt_pk(y[0][2] * rq, y[0][3] * rq); *(u32x2*)(Gq + off) = o;
            o.x = cvt_pk(y[1][0] * rk, y[1][1] * rk); o.y = cvt_pk(y[1][2] * rk, y[1][3] * rk); *(u32x2*)(Gk + off) = o;
            o.x = cvt_pk(y[2][0], y[2][1]); o.y = cvt_pk(y[2][2], y[2][3]); *(u32x2*)(Gv + off) = o;
        }
        {
            const int rr = F.lane >> 4, cc = F.lane & 15;
            float r;
            if (cc < 8) { const float xx = ab + F.in[I_DTB][l * 8 + cc]; const float ex = __expf(fminf(xx, 20.f)); const float sp = (xx > 20.f) ? xx : ((xx < -4.f) ? ex * (1.f - ex * (0.5f - ex * (1.f / 3.f))) : __logf(1.f + ex)); r = -__expf(F.in[I_ALOG][l * 8 + cc]) * sp; }
            else r = sigmoidf_(ab);
            GB[(size_t)(R0 + rr) * 16 + cc] = r;
        }
    }
}
__device__ __forceinline__ s16x4 tr_read(const LAS unsigned char* p) { return __builtin_bit_cast(s16x4, __builtin_amdgcn_ds_read_tr16_b64_v4i16((LAS v4i16_t*)p)); }
__device__ __forceinline__ bf16x8 cat8(const s16x4 lo, const s16x4 hi) { return (bf16x8){lo[0], lo[1], lo[2], lo[3], hi[0], hi[1], hi[2], hi[3]}; }
#define MFMA32(a, b, c) __builtin_amdgcn_mfma_f32_32x32x16_bf16((a), (b), (c), 0, 0, 0)
#define MFMA16(a, b, c) __builtin_amdgcn_mfma_f32_16x16x32_bf16((a), (b), (c), 0, 0, 0)
constexpr int KP = 144, VP = 192;
constexpr int ATT_KT = 64;
constexpr int ATT_K_OFF = 0, ATT_V_OFF = ATT_KT * KP;

template <int HD>
__device__ __forceinline__ void q_prep(bf16x8 (&qf)[HD / 16], const bf16_t* qrow, const float* gain, float post, int pos, const f32x2* rt, int h2) {
    constexpr int NKS = HD / 16, Q = HD / 4;
    float x[NKS][8];
#pragma unroll
    for (int ks = 0; ks < NKS; ++ks) { const u32x4 w = *(const u32x4*)(qrow + 16 * ks + 8 * h2);
        x[ks][0] = bf_lo(w.x); x[ks][1] = bf_hi(w.x); x[ks][2] = bf_lo(w.y); x[ks][3] = bf_hi(w.y); x[ks][4] = bf_lo(w.z); x[ks][5] = bf_hi(w.z); x[ks][6] = bf_lo(w.w); x[ks][7] = bf_hi(w.w); }
    float ss = 0.f;
#pragma unroll
    for (int ks = 0; ks < NKS; ++ks)
#pragma unroll
        for (int j = 0; j < 8; ++j) ss += x[ks][j] * x[ks][j];
    const float rr = rsqrtf(add_xor32(ss) * (1.f / HD) + EPS);
#pragma unroll
    for (int ks = 0; ks < NKS; ++ks) { const f32x4 g0 = *(const f32x4*)(gain + 16 * ks + 8 * h2), g1 = *(const f32x4*)(gain + 16 * ks + 8 * h2 + 4);
#pragma unroll
        for (int j = 0; j < 4; ++j) { x[ks][j] *= rr * g0[j]; x[ks][4 + j] *= rr * g1[j]; } }
    if (pos >= 0) {
        const int row = pos >> 6, col = pos & 63;
        if (HD == 64) {
#pragma unroll
            for (int j = 0; j < 8; ++j) {
                const f32x2 cr = rt[row * Q + 8 * h2 + j], cc = rt[col * Q + 8 * h2 + j];
                const float a = x[0][j], b = x[1][j]; x[0][j] = a * cr[0] - b * cr[1]; x[1][j] = b * cr[0] + a * cr[1];
                const float c = x[NKS - 2][j], d = x[NKS - 1][j]; x[NKS - 2][j] = c * cc[0] - d * cc[1]; x[NKS - 1][j] = d * cc[0] + c * cc[1];
            }
        } else {
#pragma unroll
            for (int j = 0; j < 8; ++j) {
                const f32x2 cr = rt[row * Q + j], cc = rt[col * Q + j];
                const auto s0 = __builtin_amdgcn_permlane32_swap(__float_as_uint(x[0][j]), __float_as_uint(x[0][j]), false, false);
                const auto s1 = __builtin_amdgcn_permlane32_swap(__float_as_uint(x[1][j]), __float_as_uint(x[1][j]), false, false);
                const float pa = __uint_as_float(h2 ? s0[0] : s0[1]), pc = __uint_as_float(h2 ? s1[0] : s1[1]);
                x[0][j] = h2 ? (x[0][j] * cr[0] + pa * cr[1]) : (x[0][j] * cr[0] - pa * cr[1]);
                x[1][j] = h2 ? (x[1][j] * cc[0] + pc * cc[1]) : (x[1][j] * cc[0] - pc * cc[1]);
            }
        }
    }
#pragma unroll
    for (int ks = 0; ks < NKS; ++ks) { u32x4 w; w.x = cvt_pk(x[ks][0] * post, x[ks][1] * post); w.y = cvt_pk(x[ks][2] * post, x[ks][3] * post); w.z = cvt_pk(x[ks][4] * post, x[ks][5] * post); w.w = cvt_pk(x[ks][6] * post, x[ks][7] * post);
        qf[ks] = __builtin_bit_cast(bf16x8, w); }
}

template <int HD, int NMAP, bool DIFF>
__device__ __forceinline__ void attn_unit(const Frame& F, const bf16_t* Qb, int qcol, const bf16_t* Kb, int kcol, const bf16_t* Vb, int vcol, bf16_t* Ob, int ocol,
                                          int b, int qt, float lam, float fin_scale, const float* subg, const float* qgain, float qpost, const f32x2* qrt) {
    const int lane = F.lane, r = lane & 31, h2 = lane >> 5, x = lane & 15, g1 = (lane >> 4) & 1;
    const size_t R0 = (size_t)b * TPB + (size_t)qt * 256 + F.wave * 32;
    const int nkt = (qt == 0) ? 256 / ATT_KT : 4352 / ATT_KT;
    constexpr int NKS = HD / 16;
    bf16x8 qf[NMAP][NKS];
    { const int qpos = (qt == 0) ? -1 : (qt - 1) * 256 + F.wave * 32 + r;
#pragma unroll
      for (int m = 0; m < NMAP; ++m) q_prep<HD>(qf[m], Qb + (R0 + r) * 256 + qcol + m * HD, qgain, qpost, qpos, qrt, h2); }
    f32x16 O[NMAP][2]; f32x4 lacc[NMAP];
    bf16x8 onesA; { const int mrow = lane & 15, kg = lane >> 4; const unsigned o = ((mrow == 0 && (kg & 1) == 0) || (mrow == 1 && (kg & 1) == 1)) ? 0x3f803f80u : 0u; onesA = __builtin_bit_cast(bf16x8, (u32x4){o, o, o, o}); }
#pragma unroll
    for (int m = 0; m < NMAP; ++m) { lacc[m] = (f32x4){0.f, 0.f, 0.f, 0.f};
#pragma unroll
        for (int d = 0; d < 2; ++d)
#pragma unroll
            for (int i = 0; i < 16; ++i) O[m][d][i] = 0.f; }
    constexpr int ATT_BUF = ATT_KT * KP + ATT_KT * VP;
    constexpr int NST = ATT_KT / 64;
    const int skey = F.tid >> 3, sseg = F.tid & 7;
    const bf16_t* kg = Kb + ((size_t)b * TPB + skey) * 256 + kcol + sseg * 8;
    const bf16_t* vg = Vb + ((size_t)b * TPB + skey) * 256 + vcol + sseg * 8;
    u32x4 kreg[NST], vreg[NST];
#pragma unroll
    for (int i = 0; i < NST; ++i) { kreg[i] = *(const u32x4*)(kg + (size_t)(64 * i) * 256); vreg[i] = *(const u32x4*)(vg + (size_t)(64 * i) * 256); }
    __syncthreads();
#pragma unroll
    for (int i = 0; i < NST; ++i) { *(LAS u32x4*)(F.lds + ATT_K_OFF + (skey + 64 * i) * KP + sseg * 16) = kreg[i]; *(LAS u32x4*)(F.lds + ATT_V_OFF + (skey + 64 * i) * VP + sseg * 16) = vreg[i]; }
    __syncthreads();
    for (int kt = 0; kt < nkt; ++kt) {
        LAS unsigned char* Ks = F.lds + (kt & 1) * ATT_BUF + ATT_K_OFF; LAS unsigned char* Vs = F.lds + (kt & 1) * ATT_BUF + ATT_V_OFF;
        if (kt + 1 < nkt) {
#pragma unroll
            for (int i = 0; i < NST; ++i) { kreg[i] = *(const u32x4*)(kg + (size_t)((kt + 1) * ATT_KT + 64 * i) * 256); vreg[i] = *(const u32x4*)(vg + (size_t)((kt + 1) * ATT_KT + 64 * i) * 256); } }
#pragma unroll
        for (int grp = 0; grp < ATT_KT / 32; ++grp) {
            f32x16 S[2];
            bf16x8 kfr[2][NKS];
#pragma unroll
            for (int t = 0; t < 2; ++t) {
                const int kb = (NMAP == 2) ? grp : t, m = (NMAP == 2) ? t : 0;
#pragma unroll
                for (int ks = 0; ks < NKS; ++ks) kfr[t][ks] = *(const LAS bf16x8*)(Ks + (kb * 32 + r) * KP + ((DIFF ? m * HD : 0) + 16 * ks + 8 * h2) * 2);
            }
#pragma unroll
            for (int t = 0; t < 2; ++t)
#pragma unroll
                for (int ks = 0; ks < NKS; ++ks) { asm volatile("" : "+v"(kfr[t][ks])); }
#pragma unroll
            for (int t = 0; t < 2; ++t) {
                const int m = (NMAP == 2) ? t : 0;
                const f32x16 half16 = {0.5f, 0.5f, 0.5f, 0.5f, 0.5f, 0.5f, 0.5f, 0.5f, 0.5f, 0.5f, 0.5f, 0.5f, 0.5f, 0.5f, 0.5f, 0.5f};
                S[t] = MFMA32(kfr[t][0], qf[m][0], half16);
#pragma unroll
                for (int ks = 1; ks < NKS; ++ks) S[t] = MFMA32(kfr[t][ks], qf[m][ks], S[t]);
            }
            bf16x8 vf[(NMAP == 2) ? 1 : 2][2][2];
#pragma unroll
            for (int t = 0; t < ((NMAP == 2) ? 1 : 2); ++t) {
                const int kb = (NMAP == 2) ? grp : t;
#pragma unroll
                for (int d = 0; d < 2; ++d)
#pragma unroll
                    for (int s2 = 0; s2 < 2; ++s2) {
                        const LAS unsigned char* vp = Vs + (kb * 32 + 16 * s2 + 4 * h2 + (x >> 2)) * VP + (32 * d + 16 * g1 + 4 * (x & 3)) * 2;
                        vf[t][d][s2] = cat8(tr_read(vp), tr_read(vp + 8 * VP));
                    }
            }
#pragma unroll
            for (int t = 0; t < 2; ++t) {
                const int m = (NMAP == 2) ? t : 0, vt = (NMAP == 2) ? 0 : t;
                bf16x8 pb[2];
#pragma unroll
                for (int s2 = 0; s2 < 2; ++s2) {
                    unsigned w[4];
#pragma unroll
                    for (int j = 0; j < 4; ++j) w[j] = __builtin_bit_cast(unsigned, __builtin_amdgcn_cvt_pknorm_i16(S[t][8 * s2 + 2 * j], S[t][8 * s2 + 2 * j + 1]));
                    pb[s2] = __builtin_bit_cast(bf16x8, (u32x4){w[0], w[1], w[2], w[3]});
                    lacc[m] = MFMA16(onesA, pb[s2], lacc[m]);
                }
#pragma unroll
                for (int d = 0; d < 2; ++d)
#pragma unroll
                    for (int s2 = 0; s2 < 2; ++s2) O[m][d] = MFMA32(vf[vt][d][s2], pb[s2], O[m][d]);
            }
        }
        if (kt + 1 < nkt) { LAS unsigned char* nb = F.lds + ((kt + 1) & 1) * ATT_BUF;
#pragma unroll
            for (int i = 0; i < NST; ++i) { *(LAS u32x4*)(nb + ATT_K_OFF + (skey + 64 * i) * KP + sseg * 16) = kreg[i]; *(LAS u32x4*)(nb + ATT_V_OFF + (skey + 64 * i) * VP + sseg * 16) = vreg[i]; } }
        __syncthreads();
    }
    float inv[NMAP];
#pragma unroll
    for (int m = 0; m < NMAP; ++m) {
        const float s0 = __int_as_float(__builtin_amdgcn_ds_bpermute((lane & 15) << 2, __float_as_int(lacc[m][0]))), s1 = __int_as_float(__builtin_amdgcn_ds_bpermute((lane & 15) << 2, __float_as_int(lacc[m][1])));
        inv[m] = 1.f / ((r < 16) ? s0 : s1); }
    bf16_t* op = Ob + (R0 + r) * 256 + ocol;
    if (DIFF) {
        float ss = 0.f;
#pragma unroll
        for (int d = 0; d < 2; ++d)
#pragma unroll
            for (int i = 0; i < 16; ++i) { const float v = O[0][d][i] * inv[0] - lam * (O[NMAP - 1][d][i] * inv[NMAP - 1]); O[0][d][i] = v; ss += v * v; }
        ss = add_xor32(ss);
        const float rr = rsqrtf(ss * (1.f / 64.f) + EPS) * fin_scale;
#pragma unroll
        for (int d = 0; d < 2; ++d)
#pragma unroll
            for (int g4 = 0; g4 < 4; ++g4) { const int dv0 = 32 * d + 8 * g4 + 4 * h2; const f32x4 sg = *(const f32x4*)(subg + dv0);
                u32x2 o; o.x = cvt_pk(O[0][d][4 * g4] * rr * sg[0], O[0][d][4 * g4 + 1] * rr * sg[1]); o.y = cvt_pk(O[0][d][4 * g4 + 2] * rr * sg[2], O[0][d][4 * g4 + 3] * rr * sg[3]);
                *(u32x2*)(op + dv0) = o; }
    } else {
#pragma unroll
        for (int m = 0; m < NMAP; ++m)
#pragma unroll
            for (int d = 0; d < 2; ++d)
#pragma unroll
                for (int g4 = 0; g4 < 4; ++g4) { const int dv0 = 32 * d + 8 * g4 + 4 * h2;
                    u32x2 o; o.x = cvt_pk(O[m][d][4 * g4] * inv[m], O[m][d][4 * g4 + 1] * inv[m]); o.y = cvt_pk(O[m][d][4 * g4 + 2] * inv[m], O[m][d][4 * g4 + 3] * inv[m]);
                    *(u32x2*)(op + m * HD + dv0) = o; }
    }
}

__device__ __forceinline__ void gmlp_unit(const Frame& F, int l, int b, int chunk, int g, bf16_t* dry = nullptr) {
    const int lane = F.lane, r = lane & 31, h2 = lane >> 5, x = lane & 15, g1 = (lane >> 4) & 1;
    const size_t R0 = (size_t)b * TPB + (size_t)chunk * 128;
    LAS unsigned char* Vs = F.lds;
    const bf16_t* vsrc = ptile(F, T_MV) + R0 * 256 + g * 64;
    __syncthreads();
#pragma unroll
    for (int i = 0; i < 2; ++i) { const int pc = F.tid + i * 512, q = pc >> 3, seg = pc & 7; *(LAS u32x4*)(Vs + q * VP + seg * 16) = *(const u32x4*)(vsrc + (size_t)q * 256 + seg * 8); }
    __syncthreads();
    const int cb = F.wave & 1, pb = F.wave >> 1;
    const bf16_t* ws = (const bf16_t*)(F.ws + WS_GMWS) + ((size_t)(l * 4 + g) * 128 + pb * 32 + r) * 128 + 8 * h2;
    f32x16 acc;
#pragma unroll
    for (int i = 0; i < 16; ++i) acc[i] = 0.f;
#pragma unroll
    for (int ks = 0; ks < 8; ++ks) {
        const LAS unsigned char* vp = Vs + (16 * ks + 8 * h2 + (x >> 2)) * VP + (32 * cb + 16 * g1 + 4 * (x & 3)) * 2;
        const bf16x8 af = cat8(tr_read(vp), tr_read(vp + 4 * VP));
        const bf16x8 bfr = *(const bf16x8*)(ws + 16 * ks);
        acc = MFMA32(af, bfr, acc);
    }
    const int pp = pb * 32 + r; const float bs = F.in[I_GMBS][(l * 4 + g) * 128 + pp];
    bf16_t* up = ptile(F, T_MU) + (R0 + pp) * 256 + g * 64 + cb * 32;
#pragma unroll
    for (int g4 = 0; g4 < 4; ++g4) { const int c0 = 8 * g4 + 4 * h2; const u32x2 uw = *(const u32x2*)(up + c0);
        u32x2 o; o.x = cvt_pk(gelu_erf(bf_lo(uw.x)) * (acc[4 * g4] + bs), gelu_erf(bf_hi(uw.x)) * (acc[4 * g4 + 1] + bs)); o.y = cvt_pk(gelu_erf(bf_lo(uw.y)) * (acc[4 * g4 + 2] + bs), gelu_erf(bf_hi(uw.y)) * (acc[4 * g4 + 3] + bs));
        *(u32x2*)((dry ? dry + (R0 + pp) * 256 + g * 64 + cb * 32 : up) + c0) = o; }
}
__device__ __forceinline__ int chunk_p(int dir, int n, int i) { const int f = 64 * n + i; return dir == 0 ? f : (n < 4 ? 255 - f : 4351 + 256 - f); }
__device__ __forceinline__ int crow16(int i, int h2) { return (i & 3) + 8 * (i >> 2) + 4 * h2; }
__device__ __forceinline__ int img_idx(int row, int k) { const int kk = k & 31; return (((row >> 4) * 2 + (k >> 5)) * 64 + ((kk >> 2) & 3) * 16 + (row & 15)) * 8 + 4 * (kk >> 4) + (kk & 3); }
constexpr int CH_NW = 0, CH_QD = 8192, CH_QK = 16384, CH_KDT = 24576, CH_U = 32768;

constexpr int CHS_BYTES = 33792;
__device__ __forceinline__ void gdn_chunk_phase(const Frame& F) {
    const int slot = F.wave >> 1, ws2 = F.wave & 1;
    LAS float* Am = (LAS float*)(F.lds + slot * CHS_BYTES); LAS float* gcv = Am + 4096; LAS float* btv = gcv + 64; LAS float* egv = btv + 64; LAS float* dkv = egv + 64;
    LAS bf16_t* kvt = (LAS bf16_t*)(F.lds + slot * CHS_BYTES + 17408);
    const bf16_t* Gq = (const bf16_t*)(F.ar + A_H); const bf16_t* Gk = Gq + (size_t)NR * 256; const bf16_t* Gv = Gk + (size_t)NR * 256;
    const float* GB = (const float*)(F.ws + WS_GB);
    float* CHG = (float*)(F.ws + WS_CHG);
    for (int it0 = F.blk * 4; it0 < 8704; it0 += GRID * 4) {
        int tq = F.tid; asm volatile("" : "+v"(tq));
        const int t2 = tq & 127, lane = tq & 63, r = lane & 31, h2 = lane >> 5;
        const int item = it0 + slot; const int n = item % 68, h = (item / 68) & 3, b = (item / 272) & 15, dir = item / 4352;
        unsigned char* chp = F.ar + A_CH + (size_t)item * CH_ITEM;
        const size_t Rb = (size_t)b * TPB;
        __syncthreads();
        u32x4 stg[8];
#pragma unroll
        for (int j = 0; j < 8; ++j) { const int pc = t2 + 128 * j, i = pc >> 4, seg = pc & 15;
            stg[j] = *(const u32x4*)(((seg < 8) ? Gk : Gv) + (Rb + chunk_p(dir, n, i)) * 256 + 64 * h + (seg & 7) * 8); }
        bf16x8 qfr[2][4];
#pragma unroll
        for (int tI = 0; tI < 2; ++tI)
#pragma unroll
            for (int ks = 0; ks < 4; ++ks) qfr[tI][ks] = *(const bf16x8*)(Gq + (Rb + chunk_p(dir, n, 32 * tI + r)) * 256 + 64 * h + 8 * h2 + 16 * ks);
#pragma unroll
        for (int j = 0; j < 8; ++j) { const int pc = t2 + 128 * j, i = pc >> 4, seg = pc & 15; *(LAS u32x4*)(kvt + i * 128 + seg * 8) = stg[j]; }
        if (ws2 == 0) {
            const size_t R = Rb + chunk_p(dir, n, lane);
            float g = GB[R * 16 + dir * 4 + h]; const float bt = GB[R * 16 + 8 + dir * 4 + h];
#pragma unroll
            for (int o = 1; o < 64; o <<= 1) { const float t = __int_as_float(__builtin_amdgcn_ds_bpermute(((lane - o) & 63) << 2, __float_as_int(g))); if (lane >= o) g += t; }
            const float gl = __int_as_float(__builtin_amdgcn_readlane(__float_as_int(g), 63));
            gcv[lane] = g; btv[lane] = bt; egv[lane] = __expf(g); dkv[lane] = __expf(gl - g);
            if (lane == 0) CHG[item] = __expf(gl);
        }
        __syncthreads();
        u32x2 qpa[4], qpb[4];
#pragma unroll
        for (int t = 0; t < 4; ++t) { const int pidx = t2 + 128 * t, lp = pidx & 63, q4 = lp >> 4, row = lp & 15, rs = pidx >> 6, rb = rs >> 1, s2 = rs & 1;
            const bf16_t* qp = Gq + (Rb + chunk_p(dir, n, 16 * rb + row)) * 256 + 64 * h + 32 * s2 + 4 * q4;
            qpa[t] = *(const u32x2*)qp; qpb[t] = *(const u32x2*)(qp + 16); }
        if (ws2 == 0) {
#pragma unroll
            for (int tI = 0; tI < 2; ++tI)
#pragma unroll
                for (int tJ = 0; tJ <= tI; ++tJ) {
                    f32x16 acc;
#pragma unroll
                    for (int i = 0; i < 16; ++i) acc[i] = 0.f;
#pragma unroll
                    for (int ks = 0; ks < 4; ++ks) {
                        const bf16x8 af = *(const LAS bf16x8*)(kvt + (32 * tI + r) * 128 + 16 * ks + 8 * h2);
                        const bf16x8 bf = *(const LAS bf16x8*)(kvt + (32 * tJ + r) * 128 + 16 * ks + 8 * h2);
                        acc = MFMA32(af, bf, acc);
                    }
                    const int j = 32 * tJ + r; const float gj = gcv[j];
                    LAS float* ab = Am + (4 * h2) * 64 + j; const LAS float* gb = gcv + 4 * h2; const int dj = 4 * h2 - j;
#pragma unroll
                    for (int i = 0; i < 16; ++i) { const int io = 32 * tI + (i & 3) + 8 * (i >> 2);
                        const float val = gb[64 + io] * acc[i] * __expf(fminf(gb[io] - gj, 0.f));
                        ab[io * 64] = (io + dj > 0) ? val : 0.f; }
                }
        } else {
#pragma unroll
            for (int tJ = 0; tJ < 2; ++tJ)
#pragma unroll
                for (int tI = 0; tI < 2; ++tI) {
                    f32x16 acc;
#pragma unroll
                    for (int i = 0; i < 16; ++i) acc[i] = 0.f;
                    if (tJ <= tI) {
#pragma unroll
                        for (int ks = 0; ks < 4; ++ks) {
                            const bf16x8 af = *(const LAS bf16x8*)(kvt + (32 * tJ + r) * 128 + 16 * ks + 8 * h2);
                            acc = MFMA32(af, qfr[tI][ks], acc);
                        }
                    }
                    const int i = 32 * tI + r; const float gi = gcv[i];
                    const LAS float* gb = gcv + 4 * h2; const int di = i - 4 * h2;
                    unsigned char* qkp = chp + CH_QK + 2 * img_idx(i, 4 * h2);
#pragma unroll
                    for (int g4 = 0; g4 < 4; ++g4) {
                        float v[4];
#pragma unroll
                        for (int e = 0; e < 4; ++e) { const int jo = 32 * tJ + 8 * g4 + e; const float val = acc[4 * g4 + e] * __expf(fminf(gi - gb[jo], 0.f)); v[e] = (di >= jo) ? val : 0.f; }
                        u32x2 o; o.x = cvt_pk(v[0], v[1]); o.y = cvt_pk(v[2], v[3]);
                        *(u32x2*)(qkp + (tJ * 64 + ((2 * g4) & 3) * 16) * 16 + 8 * (g4 >> 1)) = o;
                    }
                }
        }
        __syncthreads();
        {
#pragma unroll
            for (int t = 0; t < 4; ++t) {
                const int pidx = t2 + 128 * t, lp = pidx & 63, q4 = lp >> 4, row = lp & 15, rs = pidx >> 6, rb = rs >> 1, s2 = rs & 1;
                const int i = 16 * rb + row, kdA = 32 * s2 + 4 * q4;
                const u32x2 qa = qpa[t], qb = qpb[t];
                const float eg = egv[i];
                u32x4 o; o.x = cvt_pk(bf_lo(qa.x) * eg, bf_hi(qa.x) * eg); o.y = cvt_pk(bf_lo(qa.y) * eg, bf_hi(qa.y) * eg); o.z = cvt_pk(bf_lo(qb.x) * eg, bf_hi(qb.x) * eg); o.w = cvt_pk(bf_lo(qb.y) * eg, bf_hi(qb.y) * eg);
                *(u32x4*)(chp + CH_QD + pidx * 16) = o;
                const int kd = i, cA = kdA;
                float kv[8];
#pragma unroll
                for (int e = 0; e < 8; ++e) { const int cc = cA + 16 * (e >> 2) + (e & 3); kv[e] = bf2f(kvt[cc * 128 + kd]) * dkv[cc]; }
                o.x = cvt_pk(kv[0], kv[1]); o.y = cvt_pk(kv[2], kv[3]); o.z = cvt_pk(kv[4], kv[5]); o.w = cvt_pk(kv[6], kv[7]);
                *(u32x4*)(chp + CH_KDT + pidx * 16) = o;
            }
        }
        {
            const int c = t2; const bool isw = c < 64;
            float X[64];
#pragma unroll
            for (int i = 0; i < 64; ++i) { const float val = bf2f(kvt[i * 128 + c]); X[i] = val * btv[i] * (isw ? egv[i] : 1.f); }
            __syncthreads();
            f32x4 ra[2][16];
#pragma unroll
            for (int q = 0; q < 1; ++q) ra[1][q] = *(const LAS f32x4*)(Am + 1 * 64 + 4 * q);
#pragma unroll
            for (int i = 1; i < 64; ++i) {
                if (i + 1 < 64) {
#pragma unroll
                    for (int q = 0; q < (i + 4) / 4; ++q) ra[(i + 1) & 1][q] = *(const LAS f32x4*)(Am + (i + 1) * 64 + 4 * q);
                }
#pragma unroll
                for (int q = 0; q < (i + 3) / 4; ++q) asm volatile("" : "+v"(ra[i & 1][q]));
                float s0 = X[i], s1 = 0.f;
#pragma unroll
                for (int j = 0; j < i; ++j) { if (j & 1) s1 -= ra[i & 1][j >> 2][j & 3] * X[j]; else s0 -= ra[i & 1][j >> 2][j & 3] * X[j]; }
                X[i] = s0 + s1;
            }
#pragma unroll
            for (int i = 0; i < 64; ++i) kvt[i * 128 + c] = f2bf(X[i]);
        }
        __syncthreads();
        {
#pragma unroll
            for (int t = 0; t < 4; ++t) {
                const int pidx = t2 + 128 * t, lp = pidx & 63, q4 = lp >> 4, row = lp & 15, rs = pidx >> 6, rb = rs >> 1, s2 = rs & 1;
                const int i = 16 * rb + row, kdA = 32 * s2 + 4 * q4;
                const u32x2 wa = *(const LAS u32x2*)(kvt + i * 128 + kdA), wb = *(const LAS u32x2*)(kvt + i * 128 + kdA + 16);
                u32x4 o; o.x = wa.x ^ 0x80008000u; o.y = wa.y ^ 0x80008000u; o.z = wb.x ^ 0x80008000u; o.w = wb.y ^ 0x80008000u;
                *(u32x4*)(chp + CH_NW + pidx * 16) = o;
            }
#pragma unroll
            for (int t = 0; t < 2; ++t) {
                const int pidx = t2 + 128 * t, sl = pidx >> 6, lp = pidx & 63, q4 = lp >> 4, vcol = 64 + 16 * sl + (lp & 15);
                unsigned w[8];
#pragma unroll
                for (int e = 0; e < 8; ++e) { const int i0 = 16 * (e >> 1) + 4 * q4 + 2 * (e & 1); w[e] = (unsigned)kvt[i0 * 128 + vcol] | ((unsigned)kvt[(i0 + 1) * 128 + vcol] << 16); }
                *(u32x4*)(chp + CH_U + pidx * 32) = (u32x4){w[0], w[1], w[2], w[3]}; *(u32x4*)(chp + CH_U + pidx * 32 + 16) = (u32x4){w[4], w[5], w[6], w[7]};
            }
        }
    }
}

__device__ __forceinline__ void gdn_scan_phase(const Frame& F, int l) {
    constexpr bool do_finish = true;
    const int lane = F.lane, q = lane >> 4, dir = F.wave >> 2, sl = F.wave & 3;
    const float* CHG = (const float*)(F.ws + WS_CHG);
    bf16_t* Ob0 = ptile(F, T_DQ); bf16_t* Ob1 = ptile(F, T_DK);
    for (int bh = F.blk; bh < 64; bh += GRID) {
        const int b = bh >> 2, h = bh & 3;
        const int item0d0 = ((0 * 16 + b) * 4 + h) * 68, item0d1 = ((1 * 16 + b) * 4 + h) * 68;
        const int item0 = dir ? item0d1 : item0d0;
        f32x4 S[4];
#pragma unroll
        for (int kb = 0; kb < 4; ++kb) S[kb] = (f32x4){0.f, 0.f, 0.f, 0.f};
        __syncthreads();
#define GDN_ISSUE(n_) do { _Pragma("unroll") for (int i_ = 0; i_ < 8; ++i_) { const int pc_ = F.wave * 8 + i_, d_ = pc_ >> 5, off_ = (pc_ & 31) * 1024; \
                const unsigned char* src_ = F.ar + A_CH + (size_t)((d_ ? item0d1 : item0d0) + (n_)) * CH_ITEM + off_ + lane * 16; \
                __builtin_amdgcn_global_load_lds((const unsigned*)src_, (LAS unsigned*)(F.lds + ((n_) & 1) * 65536 + d_ * 32768 + off_), 16, 0, 0); } } while (0)
        GDN_ISSUE(0);
        bf16_t* Ob = dir ? Ob1 : Ob0;
        for (int n = 0; n < 68; ++n) {
            const unsigned char* chp = F.ar + A_CH + (size_t)(item0 + n) * CH_ITEM;
            const u32x4 u0 = *(const u32x4*)(chp + CH_U + (sl * 64 + lane) * 32), u1 = *(const u32x4*)(chp + CH_U + (sl * 64 + lane) * 32 + 16);
            const float gl = CHG[item0 + n];
            VM_WAIT();
            __syncthreads();
            if (n + 1 < 68) GDN_ISSUE(n + 1);
            const LAS unsigned char* base = F.lds + (n & 1) * 65536 + dir * 32768 + lane * 16;
#define FRAG(mat, rb, s) (*(const LAS bf16x8*)(base + (mat) + ((rb) * 2 + (s)) * 1024))
            bf16x8 bS[2], bV[2];
#pragma unroll
            for (int s = 0; s < 2; ++s) { u32x4 w; w.x = cvt_pk(S[2 * s][0], S[2 * s][1]); w.y = cvt_pk(S[2 * s][2], S[2 * s][3]); w.z = cvt_pk(S[2 * s + 1][0], S[2 * s + 1][1]); w.w = cvt_pk(S[2 * s + 1][2], S[2 * s + 1][3]); bS[s] = __builtin_bit_cast(bf16x8, w); }
            f32x4 vn[4];
            vn[0] = (f32x4){bf_lo(u0.x), bf_hi(u0.x), bf_lo(u0.y), bf_hi(u0.y)}; vn[1] = (f32x4){bf_lo(u0.z), bf_hi(u0.z), bf_lo(u0.w), bf_hi(u0.w)};
            vn[2] = (f32x4){bf_lo(u1.x), bf_hi(u1.x), bf_lo(u1.y), bf_hi(u1.y)}; vn[3] = (f32x4){bf_lo(u1.z), bf_hi(u1.z), bf_lo(u1.w), bf_hi(u1.w)};
#pragma unroll
            for (int rb = 0; rb < 4; ++rb)
#pragma unroll
                for (int s = 0; s < 2; ++s) vn[rb] = MFMA16(FRAG(CH_NW, rb, s), bS[s], vn[rb]);
#pragma unroll
            for (int s = 0; s < 2; ++s) { u32x4 w; w.x = cvt_pk(vn[2 * s][0], vn[2 * s][1]); w.y = cvt_pk(vn[2 * s][2], vn[2 * s][3]); w.z = cvt_pk(vn[2 * s + 1][0], vn[2 * s + 1][1]); w.w = cvt_pk(vn[2 * s + 1][2], vn[2 * s + 1][3]); bV[s] = __builtin_bit_cast(bf16x8, w); }
            f32x4 o[4];
#pragma unroll
            for (int rb = 0; rb < 4; ++rb) { o[rb] = (f32x4){0.f, 0.f, 0.f, 0.f};
#pragma unroll
                for (int s = 0; s < 2; ++s) { o[rb] = MFMA16(FRAG(CH_QD, rb, s), bS[s], o[rb]); o[rb] = MFMA16(FRAG(CH_QK, rb, s), bV[s], o[rb]); } }
#pragma unroll
            for (int kb = 0; kb < 4; ++kb) { S[kb] = S[kb] * gl;
#pragma unroll
                for (int s = 0; s < 2; ++s) S[kb] = MFMA16(FRAG(CH_KDT, kb, s), bV[s], S[kb]); }
#undef FRAG
#pragma unroll
            for (int rb = 0; rb < 4; ++rb)
#pragma unroll
                for (int e = 0; e < 4; ++e) { const int i = 16 * rb + 4 * q + e;
                    Ob[((size_t)b * TPB + chunk_p(dir, n, i)) * 256 + 64 * h + 16 * sl + (lane & 15)] = f2bf(o[rb][e]); }
        }
        VM_WAIT();
        __syncthreads();
        if (do_finish) {
            const int sub = F.tid >> 4, c = (F.tid & 15) * 4;
            const f32x4 og = *(const f32x4*)(F.in[I_GDOUTG] + l * 64 + c);
            for (int p0 = sub; p0 < TPB; p0 += 128) {
                u32x2 a0[4], a1[4], gw[4];
#pragma unroll
                for (int t = 0; t < 4; ++t) { const size_t off = ((size_t)b * TPB + p0 + 32 * t) * 256 + 64 * h + c;
                    a0[t] = *(const u32x2*)(Ob0 + off); a1[t] = *(const u32x2*)(Ob1 + off); gw[t] = *(const u32x2*)(ptile(F, T_DG) + off); }
#pragma unroll
                for (int t = 0; t < 4; ++t) { const size_t off = ((size_t)b * TPB + p0 + 32 * t) * 256 + 64 * h + c;
                    const float o0 = bf_lo(a0[t].x) + bf_lo(a1[t].x), o1 = bf_hi(a0[t].x) + bf_hi(a1[t].x), o2 = bf_lo(a0[t].y) + bf_lo(a1[t].y), o3 = bf_hi(a0[t].y) + bf_hi(a1[t].y);
                    const float ss = sum16((o0 * o0 + o1 * o1) + (o2 * o2 + o3 * o3));
                    const float rr = rsqrtf(ss * (1.f / 64.f) + EPS);
                    u32x2 w; w.x = cvt_pk(o0 * rr * og[0] * siluf_(bf_lo(gw[t].x)), o1 * rr * og[1] * siluf_(bf_hi(gw[t].x))); w.y = cvt_pk(o2 * rr * og[2] * siluf_(bf_lo(gw[t].y)), o3 * rr * og[3] * siluf_(bf_hi(gw[t].y)));
                    *(u32x2*)(ptile(F, T_DG) + off) = w; }
            }
        }
    }
}
constexpr int WRP = 1032;
constexpr int RT_WLO_OFF = 32 * WRP * 2;
constexpr int RT_REC_OFF = 2 * RT_WLO_OFF;
constexpr int RT_CNT_OFF = RT_REC_OFF + 288 * 4 * 4;
static_assert(RT_CNT_OFF + 256 <= MISC_OFF, "router LDS");

__device__ __forceinline__ void p_route1(const Frame& F, int l, int cl) {
    LAS bf16_t* whi = (LAS bf16_t*)F.lds; LAS bf16_t* wlo = (LAS bf16_t*)(F.lds + RT_WLO_OFF);
    LAS int* rec = (LAS int*)(F.lds + RT_REC_OFF); LAS int* lcnt = (LAS int*)(F.lds + RT_CNT_OFF); LAS int* lbase = lcnt + 32;
    __syncthreads();
    { const float* wr = F.in[I_WR] + (size_t)l * 1024 * 32;
      f32x4 t[16];
#pragma unroll
      for (int i = 0; i < 16; ++i) t[i] = *(const f32x4*)(wr + (size_t)(F.tid + 512 * i) * 4);
#pragma unroll
      for (int i = 0; i < 16; ++i) { const int i4 = F.tid + 512 * i, k = i4 >> 3, e0 = (i4 & 7) * 4;
#pragma unroll
          for (int j = 0; j < 4; ++j) { const bf16_t h = f2bf(t[i][j]); whi[(e0 + j) * WRP + k] = h; wlo[(e0 + j) * WRP + k] = f2bf(t[i][j] - bf2f(h)); } } }
    if (F.tid < 32) lcnt[F.tid] = 0;
    __syncthreads();
    const int g0 = (l == 0) ? (F.blk * 2176) >> 8 : F.blk * 8, g1 = (l == 0) ? ((F.blk + 1) * 2176) >> 8 : F.blk * 8 + 8, ngrp = g1 - g0;
    bf16_t* H2 = (bf16_t*)(F.ar + A_H2); unsigned char* H2f8 = F.ar + A_H2F8;
    const bf16_t* XB = (const bf16_t*)(F.ws + WS_XB);
    int* rowmap = (int*)(F.ws + WS_ROWMAP); float* selg = (float*)(F.ws + WS_SELG);
    for (int i = F.blk * 512 + F.tid; i < MAXROWS; i += GRID * 512) rowmap[i] = -1;
    const int lane = F.lane;
    const float* gn = F.in[I_N2G] + l * 1024;
    for (int rl0 = F.wave * 4; rl0 < ngrp * 32; rl0 += 32) {
        u32x4 xv[4][2]; float ss[4]; int Rr[4], mir[4];
#pragma unroll
        for (int q = 0; q < 4; ++q) {
            const int gr = g0 * 32 + rl0 + q;
            const int R = (l == 0) ? gr : (gr >> 12) * TPB + CTXL + (gr & 4095);
            const int b = R / TPB, p = R - b * TPB; const bool isctx = p < CTXL; Rr[q] = R; mir[q] = isctx ? 16 : b;
#pragma unroll
            for (int c = 0; c < 2; ++c) xv[q][c] = *(const u32x4*)(XB + (size_t)R * 1024 + lane * 8 + 512 * c);
        }
#pragma unroll
        for (int q = 0; q < 4; ++q) { ss[q] = 0.f;
#pragma unroll
            for (int c = 0; c < 2; ++c) { f32x4 a0, a1; unpack8(xv[q][c], a0, a1); ss[q] += ((a0[0] * a0[0] + a0[1] * a0[1]) + (a0[2] * a0[2] + a0[3] * a0[3])) + ((a1[0] * a1[0] + a1[1] * a1[1]) + (a1[2] * a1[2] + a1[3] * a1[3])); } }
#pragma unroll
        for (int q = 0; q < 4; ++q) {
            const float rstd = rsqrtf(wave_sum(ss[q]) * (1.f / 1024.f) + EPS);
            const float* sh = modv(F, l, mir[q], 3); const float* sc = modv(F, l, mir[q], 4); const int R = Rr[q];
#pragma unroll
            for (int c = 0; c < 2; ++c) { const int cc = lane * 8 + 512 * c;
                f32x4 a0, a1; unpack8(xv[q][c], a0, a1);
                const f32x4 h0 = a0 * rstd * *(const f32x4*)(gn + cc) * (*(const f32x4*)(sc + cc) + 1.f) + *(const f32x4*)(sh + cc);
                const f32x4 h1 = a1 * rstd * *(const f32x4*)(gn + cc + 4) * (*(const f32x4*)(sc + cc + 4) + 1.f) + *(const f32x4*)(sh + cc + 4);
                *(u32x4*)(H2 + (size_t)R * 1024 + cc) = pack8(h0, h1);
                int w0 = 0, w1 = 0; w0 = __builtin_amdgcn_cvt_pk_fp8_f32(h0[0], h0[1], w0, false); w0 = __builtin_amdgcn_cvt_pk_fp8_f32(h0[2], h0[3], w0, true);
                w1 = __builtin_amdgcn_cvt_pk_fp8_f32(h1[0], h1[1], w1, false); w1 = __builtin_amdgcn_cvt_pk_fp8_f32(h1[2], h1[3], w1, true);
                *(u32x2*)(H2f8 + (size_t)R * 1024 + cc) = (u32x2){(unsigned)w0, (unsigned)w1}; }
        }
    }
    VM_WAIT();
    __syncthreads();
    const int r = lane & 31, h2 = lane >> 5;
    for (int grp = F.wave; grp < ngrp; grp += 8) {
        const int gr = (g0 + grp) * 32 + r;
        const int R = (l == 0) ? gr : (gr >> 12) * TPB + CTXL + (gr & 4095);
        const bf16_t* bh = H2 + (size_t)R * 1024 + 8 * h2;
        const LAS bf16_t* ah = whi + r * WRP + 8 * h2; const LAS bf16_t* al = wlo + r * WRP + 8 * h2;
        f32x16 acc;
#pragma unroll
        for (int i = 0; i < 16; ++i) acc[i] = 0.f;
        bf16x8 xh[2][8];
#pragma unroll
        for (int j = 0; j < 8; ++j) { xh[0][j] = *(const bf16x8*)(bh + 16 * j); }
#pragma unroll
        for (int kc = 0; kc < 8; ++kc) {
            if (kc + 1 < 8) {
#pragma unroll
                for (int j = 0; j < 8; ++j) { xh[(kc + 1) & 1][j] = *(const bf16x8*)(bh + 16 * (8 * (kc + 1) + j)); }
            }
#pragma unroll
            for (int j = 0; j < 8; ++j) { asm volatile("" : "+v"(xh[kc & 1][j])); }
#pragma unroll
            for (int j = 0; j < 8; ++j) { const int ks = 8 * kc + j;
                const bf16x8 wh = *(const LAS bf16x8*)(ah + 16 * ks), wl = *(const LAS bf16x8*)(al + 16 * ks);
                acc = MFMA32(wh, xh[kc & 1][j], acc); acc = MFMA32(wl, xh[kc & 1][j], acc); }
        }
        float lg[32];
#pragma unroll
        for (int i = 0; i < 16; ++i) { const auto rr = __builtin_amdgcn_permlane32_swap(__float_as_uint(acc[i]), __float_as_uint(acc[i]), false, false);
            const int e = (i & 3) + 8 * (i >> 2); lg[e] = __uint_as_float(rr[0]) + F.in[I_BR][l * 32 + e]; lg[e + 4] = __uint_as_float(rr[1]) + F.in[I_BR][l * 32 + e + 4]; }
        if (lane < 32) {
            const int rl = grp * 32 + r;
            unsigned used = 0u; int se[4]; float sv[4];
#pragma unroll
            for (int k = 0; k < 4; ++k) {
                float best = -INFINITY; int bi = 0;
#pragma unroll
                for (int e = 0; e < 32; ++e) { const bool ok = !((used >> e) & 1u) && lg[e] > best; best = ok ? lg[e] : best; bi = ok ? e : bi; }
                used |= 1u << bi; se[k] = bi; sv[k] = best;
            }
            const float e1 = __expf(sv[1] - sv[0]), e2 = __expf(sv[2] - sv[0]), e3 = __expf(sv[3] - sv[0]); const float den = 1.f / (1.f + e1 + e2 + e3);
            *(f32x4*)(selg + (size_t)R * 4) = (f32x4){den, e1 * den, e2 * den, e3 * den};
#pragma unroll
            for (int k = 0; k < 4; ++k) { const int pos = __hip_atomic_fetch_add(lcnt + se[k], 1, __ATOMIC_RELAXED, __HIP_MEMORY_SCOPE_WORKGROUP); rec[rl * 4 + k] = (pos << 5) | se[k]; }
        }
    }
    __syncthreads();
    if (F.tid < 32) lbase[F.tid] = (int)atomicAdd((unsigned*)(F.ws + WS_CTL) + CW_GCNT + cl * 32 + F.tid, (unsigned)lcnt[F.tid]);
    __syncthreads();
    int* seli = (int*)(F.ws + WS_SELI);
    for (int idx = F.tid; idx < ngrp * 32 * 4; idx += 512) {
        const int rl = idx >> 2, k = idx & 3;
        const int gr = g0 * 32 + rl;
        const int R = (l == 0) ? gr : (gr >> 12) * TPB + CTXL + (gr & 4095);
        const int e = rec[idx] & 31, pos = rec[idx] >> 5;
        seli[(size_t)R * 4 + k] = ((lbase[e] + pos) << 5) | e;
    }
}

__device__ __forceinline__ int moe_tables(const Frame& F, int l) {
    LAS int* off = (LAS int*)(F.lds + MISC_OFF + 64); LAS int* texp = (LAS int*)(F.lds + MISC_OFF + 256);
    __syncthreads();
    if (F.tid == 0) { const unsigned* gc = (const unsigned*)(F.ws + WS_CTL) + CW_GCNT + l * 32; int o = 0;
        for (int e = 0; e < 32; ++e) { off[e] = o; o += (int)((__hip_atomic_load(gc + e, __ATOMIC_RELAXED, __HIP_MEMORY_SCOPE_AGENT) + 255u) & ~255u); } off[32] = o; }
    __syncthreads();
    const int nt = off[32] >> 8;
    for (int pm = F.tid; pm < nt; pm += 512) { int e = 0;
#pragma unroll
        for (int k = 1; k < 32; ++k) e += (off[k] <= pm * 256) ? 1 : 0;
        texp[pm] = e; }
    __syncthreads();
    return nt;
}

__device__ __forceinline__ void p_route2(const Frame& F, int l) {
    (void)moe_tables(F, l);
    const LAS int* off = (const LAS int*)(F.lds + MISC_OFF + 64);
    int* seli = (int*)(F.ws + WS_SELI); const float* selg = (const float*)(F.ws + WS_SELG);
    int* rowmap = (int*)(F.ws + WS_ROWMAP); float* gslot = (float*)(F.ws + WS_GSLOT);
    for (int idx = F.blk * 512 + F.tid; idx < NR * 4; idx += GRID * 512) {
        const int R = idx >> 2;
        if (l == 1 && (R % TPB) < CTXL) continue;
        const int s = seli[idx]; const int e = s & 31, dst = off[e] + (s >> 5);
        rowmap[dst] = idx; gslot[dst] = selg[idx]; seli[idx] = dst;
    }
}
constexpr int NPH = 24;

__global__ void __launch_bounds__(512, 2) mega(Args args) {
    extern __shared__ __attribute__((aligned(16))) unsigned char lds_raw[];
    Frame F;
    F.lds = (LAS unsigned char*)lds_raw;
    F.in = args.in; F.out = args.out; F.ws = args.ws; F.ar = args.ws + WS_ARENA;
    F.tid = threadIdx.x; F.lane = F.tid & 63; F.wave = __builtin_amdgcn_readfirstlane(F.tid >> 6); F.blk = blockIdx.x;
    if (F.tid < 64) ((LAS unsigned*)(F.lds + MISC_OFF))[F.tid] = 0u;
    __syncthreads();
    const int lo = args.ph_lo, hi = args.ph_hi;
    XcdBarrier bar; bar.bar = (unsigned*)(F.ws + WS_CTL) + CW_BAR; bar.x = 0; bar.st = (volatile LAS unsigned*)(F.lds + MISC_OFF);
    if (hi - lo > 1) bar = xcd_barrier_post((unsigned*)(F.ws + WS_CTL) + CW_BAR, (volatile LAS unsigned*)(F.lds + MISC_OFF));
#ifndef PH_MASK
#define PH_MASK 0x1fff
#endif
#define KON(kind) (((PH_MASK) >> (kind)) & 1)
#define IN(k) (lo <= (k) && (k) < hi)
#define SEAM(k) do { if (IN(k) && IN((k) + 1)) xcd_barrier(bar); } while (0)
#define FRESH(FF) Frame FF = F; { int ln_; asm volatile("v_mbcnt_lo_u32_b32 %0, -1, 0\n\tv_mbcnt_hi_u32_b32 %0, -1, %0" : "=v"(ln_)); int wv_ = F.wave, bk_ = F.blk; asm volatile("" : "+s"(wv_), "+s"(bk_)); FF.lane = ln_; FF.wave = wv_; FF.blk = bk_; FF.tid = wv_ * 64 + ln_; }

    if (KON(0) && IN(0)) { FRESH(FF); p_prologue(FF, args); }
    SEAM(0);
    for (int l = 0; l < 2; ++l) {
        const int pb = 1 + 11 * l;
        if (KON(1) && IN(pb + 0)) { FRESH(FF); if (l == 0) p_rowpass<0>(FF, 0); else p_rowpass<1>(FF, 1); }
        SEAM(pb + 0);
        if (KON(2) && IN(pb + 1)) { FRESH(FF);
            EpiTiles E{ptile(FF, 0), FF.in[I_BGATE] + l * 4096};
            {
                pg8::DenseOrder S;
                if (l == 0) S.init(NRT, T_GATE, GRID, FF.blk, false, FF.ar + A_H, (const bf16_t*)(FF.ws + WS_WIN) + (size_t)l * 7168 * 1024, 1024);
                else { S.init(256, T_GATE, GRID, FF.blk, true, FF.ar + A_H, (const bf16_t*)(FF.ws + WS_WIN) + (size_t)l * 7168 * 1024, 1024); S.nctx = 16 * 7; }
#if PROBE_REP & 512
                if ((FF.blk >> 3) & 1) { __builtin_amdgcn_s_sleep(127); __builtin_amdgcn_s_sleep(127); __builtin_amdgcn_s_sleep(127); }
#endif
                pg8::gemm_phase<EpiTiles, pg8::DenseOrder>(FF.lds, FF.tid, 1024, S, E);
#if PROBE_REP & 1
                pg8::gemm_phase<EpiTiles, pg8::DenseOrder>(FF.lds, FF.tid, 1024, S, E);
#endif
            }
        }
        SEAM(pb + 1);
        if (KON(3) && IN(pb + 2)) { FRESH(FF);
#if PROBE_REP & 64
            p_prep<false, true>(FF, l);
#endif
#if PROBE_REP & 128
            p_prep<true, false>(FF, l);
#endif
            p_prep(FF, l); }
        SEAM(pb + 2);
        if (KON(4) && IN(pb + 3)) { FRESH(FF);
#if PROBE_REP & 32
            for (int u = FF.blk; u < 16 * 34 * 4; u += GRID) { const int g = u & 3, bc = u >> 2, b = bc / 34, chunk = bc - b * 34; gmlp_unit(FF, l, b, chunk, g, (bf16_t*)(FF.ar + A_H + 3 * PT_BYTES)); }
#endif
            for (int u = FF.blk; u < 16 * 34 * 4; u += GRID) { const int g = u & 3, bc = u >> 2, b = bc / 34, chunk = bc - b * 34; gmlp_unit(FF, l, b, chunk, g); }
            gdn_chunk_phase(FF);
#if PROBE_REP & 16
            gdn_chunk_phase(FF);
#endif
        }
        SEAM(pb + 3);
        if (KON(5) && IN(pb + 4)) { FRESH(FF);
            gdn_scan_phase(FF, l);
            float lam; { float d1 = 0.f, d2 = 0.f; for (int i = 0; i < 32; ++i) { d1 += FF.in[I_LQ1][l * 32 + i] * FF.in[I_LK1][l * 32 + i]; d2 += FF.in[I_LQ2][l * 32 + i] * FF.in[I_LK2][l * 32 + i]; } lam = expf(d1) - expf(d2) + args.lam_init[l]; }
            const int nq = (l == 0) ? 17 : 16, nda = 64 * nq, nga = 32 * nq;
            volatile LAS int* qslot = (volatile LAS int*)(FF.lds + MISC_OFF + 32);
            unsigned* qctr = (unsigned*)(FF.ws + WS_CTL) + CW_QUEUE + 64 * l;
            bf16_t* oda = ptile(FF, T_AQ); bf16_t* oga = ptile(FF, T_GQ);
            for (;;) {
                __syncthreads();
                if (FF.tid == 0) *qslot = (int)__hip_atomic_fetch_add(qctr, 1u, __ATOMIC_RELAXED, __HIP_MEMORY_SCOPE_AGENT);
                __syncthreads();
                int u = *qslot;
                if (u >= nda + nga) break;
                if (u < nda) {
                    const int qi = u / 64, bh = u - qi * 64, b = bh >> 2, h = bh & 3, qt = (qi < 16) ? qi + 1 : 0;
                    attn_unit<32, 2, true>(FF, ptile(FF, T_AQ), 64 * h, ptile(FF, T_AK), 64 * h, ptile(FF, T_AV), 64 * h, oda, 64 * h, b, qt, lam, 1.f - args.lam_init[l], FF.in[I_DASUBG] + l * 64, FF.in[I_DAQG] + l * 32, 0.17677669529663687f * LOG2E * QSC, (const f32x2*)(FF.ws + WS_ROPE));
                } else {
                    u -= nda; const int qi = u / 32, bk = u - qi * 32, b = bk >> 1, kv = bk & 1, qt = (qi < 16) ? qi + 1 : 0;
                    attn_unit<64, 2, false>(FF, ptile(FF, T_GQ), 128 * kv, ptile(FF, T_GKV), 64 * kv, ptile(FF, T_GKV), 128 + 64 * kv, oga, 128 * kv, b, qt, 0.f, 1.f, nullptr, FF.in[I_GAQG] + l * 64, 0.125f * LOG2E * QSC, (const f32x2*)(FF.ws + WS_ROPE) + 512);
                }
            }
            __syncthreads();
            {
                EpiTiles E{ptile(FF, 0), FF.in[I_BGATE] + l * 4096};
                pg8::DenseOrderT<true> S; S.init((l == 0) ? NRT : 256, 16, GRID, FF.blk, l == 1, FF.ar + A_H8, FF.ws + WS_WG8 + (size_t)l * 4096 * 1024, 1024); S.pn_off = T_GATE;
                pg8::gemm_phase<EpiTiles, pg8::DenseOrderT<true>>(FF.lds, FF.tid, 1024, S, E);
#if PROBE_REP & 2
                pg8::gemm_phase<EpiTiles, pg8::DenseOrderT<true>>(FF.lds, FF.tid, 1024, S, E);
#endif
            }
        }
        SEAM(pb + 4);
        if (KON(6) && IN(pb + 5)) { FRESH(FF);
            MergeOrder S; S.G = GRID; S.c = FF.blk; S.skipctx = (l == 1); S.ntile = (l == 1) ? 1024 : 1088; S.P = (const char*)(FF.ar + A_P); S.Wbr = (const char*)((const bf16_t*)(FF.ws + WS_WBR) + (size_t)l * 4 * 1024 * 256);
            EpiMerge E{ptile(FF, 0), (bf16_t*)(FF.ar + A_MERGED)};
            pg8::gemm_phase<EpiMerge, MergeOrder>(FF.lds, FF.tid, 256, S, E);
        }
        SEAM(pb + 5);
        if (KON(7) && IN(pb + 6)) { FRESH(FF);
            pg8::DenseOrder S; S.init((l == 1) ? 256 : NRT, 4, GRID, FF.blk, l == 1, FF.ar + A_MERGED, (const bf16_t*)(FF.ws + WS_WO) + (size_t)l * 1024 * 1024, 1024);
            EpiWo E{(l == 0) ? FF.in[I_X] : nullptr, FF.in[I_CTX], (bf16_t*)(FF.ws + WS_XB), (const float*)(FF.ws + WS_MOD) + (size_t)l * 17 * 6144, 2};
            pg8::gemm_phase<EpiWo, pg8::DenseOrder>(FF.lds, FF.tid, 1024, S, E);
        }
        SEAM(pb + 6);
#if PROBE_REP & 256
        if (KON(8) && IN(pb + 7)) { FRESH(FF); p_route1(FF, l, l + 2); }
#endif
        if (KON(8) && IN(pb + 7)) { FRESH(FF); p_route1(FF, l, l); }
        SEAM(pb + 7);
        if (KON(9) && IN(pb + 8)) { FRESH(FF); p_route2(FF, l); }
        SEAM(pb + 8);
        if (KON(10) && IN(pb + 9)) { FRESH(FF);
            const int nt = moe_tables(FF, l);
            MoeOrder<8, true> S; S.G = GRID; S.c = FF.blk; S.nunits = nt * 8; S.texp = (const LAS int*)(FF.lds + MISC_OFF + 256); S.A = (const char*)(FF.ar + A_H2F8); S.rowmap = (const int*)(FF.ws + WS_ROWMAP);
            S.W = (const char*)(FF.ws + WS_WUP) + (size_t)l * 32 * 2048 * 1024; S.wstride = (size_t)2048 * 1024;
            EpiUp E{FF.in[I_BUP] + (size_t)l * 32 * 2048, (unsigned char*)(FF.ar + A_ACT)};
            pg8::gemm_phase<EpiUp, MoeOrder<8, true>>(FF.lds, FF.tid, 1024, S, E);
#if PROBE_REP & 4
            pg8::gemm_phase<EpiUp, MoeOrder<8, true>>(FF.lds, FF.tid, 1024, S, E);
#endif
        }
        SEAM(pb + 9);
        if (KON(11) && IN(pb + 10)) { FRESH(FF);
            const int nt = moe_tables(FF, l);
            MoeOrder<4, false> S; S.G = GRID; S.c = FF.blk; S.nunits = nt * 4; S.texp = (const LAS int*)(FF.lds + MISC_OFF + 256); S.A = (const char*)(FF.ar + A_ACT); S.rowmap = nullptr;
            S.W = (const char*)(FF.ws + WS_WDN) + (size_t)l * 32 * 1024 * 1024; S.wstride = (size_t)1024 * 1024;
            EpiDown E{FF.in[I_BDN] + (size_t)l * 32 * 1024, (const float*)(FF.ws + WS_GSLOT), FF.ar + A_YBUF};
            pg8::gemm_phase<EpiDown, MoeOrder<4, false>>(FF.lds, FF.tid, 1024, S, E);
#if PROBE_REP & 8
            pg8::gemm_phase<EpiDown, MoeOrder<4, false>>(FF.lds, FF.tid, 1024, S, E);
#endif
        }
        SEAM(pb + 10);
    }
    if (KON(12) && IN(23)) { FRESH(FF); p_rowpass<2>(FF, 2); }
#undef IN
#undef SEAM
}

extern "C" void kernel_launch(void* const* d_in, const int* in_sizes, int n_in, void* d_out, int out_size, void* d_ws, size_t ws_size, hipStream_t stream) {
    static int grid = 0;
    if (grid == 0) {
        if (n_in != 34 || out_size != NB * SEQ * D || ws_size < WS_NEED) { fprintf(stderr, "kernel_launch: unexpected shapes (n_in %d out %d ws %zu need %zu)\n", n_in, out_size, ws_size, (size_t)WS_NEED); grid = -1; return; }
        int dev = 0, cus = 0;
        if (hipGetDevice(&dev) != hipSuccess || hipDeviceGetAttribute(&cus, hipDeviceAttributeMultiprocessorCount, dev) != hipSuccess) { grid = -1; return; }
        if (hipFuncSetAttribute((const void*)mega, hipFuncAttributeMaxDynamicSharedMemorySize, LDS_BYTES) != hipSuccess) { fprintf(stderr, "kernel_launch: hipFuncSetAttribute failed\n"); grid = -1; return; }
        int per_cu = 0;
        (void)hipOccupancyMaxActiveBlocksPerMultiprocessor(&per_cu, (const void*)mega, 512, LDS_BYTES);
        (void)hipGetLastError();
        if (cus != 256 || per_cu < 1) { fprintf(stderr, "kernel_launch: needs 256 CUs with one resident workgroup each (cus %d, per_cu %d)\n", cus, per_cu); grid = -1; return; }
        grid = GRID;
    }
    if (grid < 0) return;
    (void)hipMemsetAsync((char*)d_ws + WS_CTL, 0, CTL_BYTES, stream);
    Args a;
    memset(&a, 0, sizeof(a));
    for (int i = 0; i < 34; ++i) a.in[i] = (const float*)d_in[i];
    a.out = (float*)d_out; a.ws = (unsigned char*)d_ws;
    for (int i = 0; i < 8; ++i) a.inv32[i] = (float)pow(10000.0, -(double)i / 8.0);
    for (int i = 0; i < 16; ++i) a.inv64[i] = (float)pow(10000.0, -(double)i / 16.0);
    for (int l = 0; l < 2; ++l) a.lam_init[l] = (float)(0.8 - 0.6 * exp(-0.3 * (double)l));
    a.ph_lo = 0; a.ph_hi = NPH;
    hipLaunchKernelGGL(mega, dim3(grid), dim3(512), LDS_BYTES, stream, a);
}
```

```cpp
#include <hip/hip_runtime.h>
#include <stdint.h>
#include <stdio.h>
#include <math.h>
#include <string.h>

#define LAS __attribute__((address_space(3)))
typedef unsigned short bf16_t;
typedef short bf16x8 __attribute__((ext_vector_type(8)));
typedef short s16x4 __attribute__((ext_vector_type(4)));
typedef short v4i16_t __attribute__((ext_vector_type(4)));
typedef float f32x2 __attribute__((ext_vector_type(2)));
typedef float f32x4 __attribute__((ext_vector_type(4)));
typedef float f32x16 __attribute__((ext_vector_type(16)));
typedef unsigned u32x2 __attribute__((ext_vector_type(2)));
typedef unsigned u32x4 __attribute__((ext_vector_type(4)));

constexpr int D = 1024, NB = 16, SEQ = 4096, CTXL = 256, TPB = SEQ + CTXL;
constexpr int NR = NB * TPB;
constexpr int NRT = NR / 256;
constexpr int NPT = 28;
constexpr int NE = 32;
constexpr int GRID = 256;
constexpr int MAXT = 1120, MAXROWS = MAXT * 256;
#ifndef PROBE_REP
#define PROBE_REP 0
#endif
constexpr float EPS = 1e-6f;
constexpr float LOG2E = 1.4426950408889634f;
constexpr float QSC = 128.f / 32767.f;
constexpr int T_AQ = 0, T_AK = 1, T_AV = 2, T_GQ = 3, T_GKV = 4, T_MU = 5, T_MV = 6, T_DQ = 7, T_DK = 8, T_DV = 9, T_DG = 10, T_DAB = 11, T_GATE = 12;

constexpr size_t WS_CTL = 0;
constexpr size_t CTL_BYTES = 65536;
constexpr int CW_BAR = 0;
constexpr int CW_GCNT = 4096;
constexpr int CW_QUEUE = 4352;
constexpr int CW_AQ = 6144;
constexpr int CW_GQ = 4608;
constexpr size_t WS_MOD = 65536;
constexpr size_t WS_ROPE = WS_MOD + 2ull * 17 * 6144 * 4;
constexpr size_t WS_WIN = 1048576;
constexpr size_t WS_WBR = WS_WIN + 2ull * 7168 * 1024 * 2;
constexpr size_t WS_WO = WS_WBR + 2ull * 4 * 1024 * 256 * 2;
constexpr size_t WS_WUP = WS_WO + 2ull * 1024 * 1024 * 2;
constexpr size_t WS_WG8 = WS_WUP + 2ull * 32 * 2048 * 1024;
constexpr size_t WS_WDN = WS_WG8 + 2ull * 4096 * 1024;
constexpr size_t WS_GMWS = WS_WDN + 2ull * 32 * 1024 * 1024;
constexpr size_t WS_XB = WS_GMWS + 2ull * 4 * 128 * 128 * 2;
constexpr size_t WS_SELI = WS_XB + (size_t)NR * 1024 * 2;
constexpr size_t WS_SELG = WS_SELI + (size_t)NR * 4 * 4;
constexpr size_t WS_GB = WS_SELG + (size_t)NR * 4 * 4;
constexpr size_t WS_ROWMAP = WS_GB + (size_t)NR * 16 * 4;
constexpr size_t WS_GSLOT = WS_ROWMAP + (size_t)MAXROWS * 4;
constexpr size_t WS_CHG = WS_GSLOT + (size_t)MAXROWS * 4;
constexpr size_t WS_ARENA = (WS_CHG + 8704 * 4 + 4095) & ~(size_t)4095;
constexpr size_t PT_BYTES = (size_t)NR * 256 * 2;
constexpr size_t A_H = 0;
constexpr size_t A_P = (size_t)NR * 1024 * 2;
constexpr size_t A_CH = A_P + NPT * PT_BYTES;
constexpr size_t CH_ITEM = 40960;
constexpr size_t A_END = A_CH + 8704ull * CH_ITEM;
constexpr size_t A_MERGED = A_CH;
constexpr size_t A_H2 = 0;
constexpr size_t A_XS = A_P;
constexpr size_t A_ACT = A_XS + (size_t)MAXROWS * 1024 * 2;
constexpr size_t A_H2F8 = A_XS + (size_t)NR * 1024 * 2;
constexpr size_t A_YBUF = A_XS;
static_assert(A_ACT + (size_t)MAXROWS * 1024 * 2 <= A_END, "arena");
static_assert((size_t)NR * 4 * 1024 * 2 <= (size_t)MAXROWS * 1024 * 2, "ybuf fits xs");
constexpr size_t A_H8 = A_END;
constexpr size_t WS_NEED = WS_ARENA + A_END + (size_t)NR * 1024;

constexpr int RING_BYTES = 131072;
constexpr int MISC_OFF = 140544;
constexpr int LDS_BYTES = 147456;

typedef __bf16 bf16x2_t __attribute__((ext_vector_type(2)));
__device__ __forceinline__ unsigned cvt_pk(float lo, float hi) { const f32x2 v = {lo, hi}; const bf16x2_t b = __builtin_convertvector(v, bf16x2_t); return __builtin_bit_cast(unsigned, b); }
__device__ __forceinline__ float bf_lo(unsigned u) { return __uint_as_float(u << 16); }
__device__ __forceinline__ float bf_hi(unsigned u) { return __uint_as_float(u & 0xffff0000u); }
__device__ __forceinline__ float bf2f(bf16_t h) { return __uint_as_float(((unsigned)h) << 16); }
__device__ __forceinline__ bf16_t f2bf(float f) { return (bf16_t)(cvt_pk(f, 0.f) & 0xffffu); }
template <int O> __device__ __forceinline__ float xor_f(float v) { return __int_as_float(__builtin_amdgcn_ds_swizzle(__float_as_int(v), (O << 10) | 0x1f)); }
__device__ __forceinline__ float add_xor32(float v) { const auto rr = __builtin_amdgcn_permlane32_swap(__float_as_uint(v), __float_as_uint(v), false, false); return __uint_as_float(rr[0]) + __uint_as_float(rr[1]); }
__device__ __forceinline__ float sum16(float v) { v += xor_f<1>(v); v += xor_f<2>(v); v += xor_f<4>(v); v += xor_f<8>(v); return v; }
__device__ __forceinline__ float wave_sum(float v) { v = sum16(v); v += xor_f<16>(v); return add_xor32(v); }
__device__ __forceinline__ float sigmoidf_(float x) { return __builtin_amdgcn_rcpf(1.f + __builtin_amdgcn_exp2f(x * -LOG2E)); }
__device__ __forceinline__ float siluf_(float x) { return x * __builtin_amdgcn_rcpf(1.f + __builtin_amdgcn_exp2f(x * -LOG2E)); }
__device__ __forceinline__ float gelu_erf(float v) {
    const float av = fabsf(v), t = __builtin_amdgcn_rcpf(av * 0.2316418882f + 1.0f);
    float q = t * 0.5307027145f + (-0.7265760135f); q = q * t + 0.7107068705f; q = q * t + (-0.142248368f); q = q * t + 0.127414796f; q = q * t;
    const float e = __builtin_amdgcn_exp2f((v * v) * (-0.72134752044f));
    const float m = v * (q * e);
    return v < 0.f ? m : v - m;
}
#define VM_WAIT() asm volatile("s_waitcnt vmcnt(0)" ::: "memory")
#define LDS_WAIT() asm volatile("s_waitcnt lgkmcnt(0)" ::: "memory")

#define XB_TMO      128
#define XB_XCNT(j)  (256  + 64 * (j))
#define XB_XSUB(j)  (1280 + 64 * (j))
#define XB_XGEN(j)  (2304 + 64 * (j))
#define XB_TOP      3328
#define XB_TOPGEN   3392
#define XCD_BAR_WORDS 3456
#define XB_SPIN_CAP (1u << 18)
__device__ __forceinline__ unsigned xb_ld(unsigned* p)              { return __hip_atomic_load(p, __ATOMIC_RELAXED, __HIP_MEMORY_SCOPE_AGENT); }
__device__ __forceinline__ unsigned xb_add(unsigned* p, unsigned v) { return __hip_atomic_fetch_add(p, v, __ATOMIC_RELAXED, __HIP_MEMORY_SCOPE_AGENT); }
__device__ __forceinline__ unsigned xb_xcc_id() { return (unsigned)__builtin_amdgcn_s_getreg((3 << 11) | 20) & 0xFu; }
#define XB_SPIN(cond, bar) do { unsigned _sp = 0; while (cond) { __builtin_amdgcn_s_sleep(1); \
    if ((++_sp & 255u) == 0u) { if (xb_ld(&(bar)[XB_TMO])) break; if (_sp > XB_SPIN_CAP) { atomicAdd(&(bar)[XB_TMO], 1u); break; } } } } while (0)
struct XcdBarrier { unsigned* bar; unsigned x; volatile LAS unsigned* st; };
__device__ __forceinline__ XcdBarrier xcd_barrier_post(unsigned* bar, volatile LAS unsigned* st) {
    XcdBarrier b; b.bar = bar; b.x = xb_xcc_id(); b.st = st;
    if (threadIdx.x == 0) (void)xb_add(&bar[XB_XCNT(b.x)], 1u);
    return b;
}
__device__ __forceinline__ void xcd_barrier_complete(unsigned* bar, unsigned x, unsigned& nloc, unsigned& nx) {
    const unsigned G = gridDim.x * gridDim.y * gridDim.z;
    unsigned sum, cnt, mine, sp = 0u;
    for (;;) {
        sum = 0u; cnt = 0u; mine = 0u;
#pragma unroll
        for (unsigned j = 0; j < 16; ++j) { const unsigned c = xb_ld(&bar[XB_XCNT(j)]); sum += c; cnt += (c > 0u) ? 1u : 0u; mine = (j == x) ? c : mine; }
        if (sum == G) break;
        __builtin_amdgcn_s_sleep(1);
        if ((++sp & 255u) == 0u) { if (xb_ld(&bar[XB_TMO])) break; if (sp > XB_SPIN_CAP) { atomicAdd(&bar[XB_TMO], 1u); break; } }
    }
    nloc = mine > 0u ? mine : 1u; nx = cnt > 0u ? cnt : 1u;
}
__device__ __forceinline__ void xcd_barrier(const XcdBarrier& b) {
    asm volatile("s_waitcnt vmcnt(0)" ::: "memory");
    __syncthreads();
    if (threadIdx.x == 0) {
        unsigned* bar = b.bar;
        __builtin_amdgcn_s_waitcnt(0);
        unsigned nloc = b.st[0], nx = b.st[1];
        if (nloc == 0u) { xcd_barrier_complete(bar, b.x, nloc, nx); b.st[0] = nloc; b.st[1] = nx; }
        const unsigned old = xb_add(&bar[XB_XSUB(b.x)], 1u);
        const unsigned gen = old / nloc;
        if (old + 1u == (gen + 1u) * nloc) {
            __builtin_amdgcn_fence(__ATOMIC_RELEASE, "agent");
            asm volatile("s_waitcnt vmcnt(0)" ::: "memory");
            const unsigned og = xb_add(&bar[XB_TOP], 1u);
            const unsigned tg = og / nx;
            if (og + 1u == (tg + 1u) * nx) xb_add(&bar[XB_TOPGEN], 1u);
            else XB_SPIN(xb_ld(&bar[XB_TOPGEN]) == tg, bar);
            __builtin_amdgcn_fence(__ATOMIC_ACQUIRE, "agent");
            xb_add(&bar[XB_XGEN(b.x)], 1u);
            asm volatile("s_waitcnt vmcnt(0)" ::: "memory");
        } else {
            XB_SPIN(xb_ld(&bar[XB_XGEN(b.x)]) == gen, bar);
            __builtin_amdgcn_fence(__ATOMIC_ACQUIRE, "agent");
            asm volatile("s_waitcnt vmcnt(0)" ::: "memory");
        }
    }
    __syncthreads();
}

struct Args { const float* in[34]; float* out; unsigned char* ws; float inv32[8]; float inv64[16]; float lam_init[2]; int ph_lo, ph_hi; };
struct Frame {
    LAS unsigned char* lds;
    const float* const* in;
    float* out; unsigned char* ws; unsigned char* ar;
    int tid, lane, wave, blk;
};
enum InIdx { I_X = 0, I_C, I_CTX, I_CCTX, I_WMOD, I_BMOD, I_N1G, I_N2G, I_WIN, I_BGATE, I_DAQG, I_DAKG, I_LQ1, I_LK1, I_LQ2, I_LK2, I_DASUBG, I_GAQG, I_GAKG, I_GMVG, I_GMWS, I_GMBS,
             I_CONVW, I_ALOG, I_DTB, I_GDOUTG, I_WBR, I_WO, I_WR, I_BR, I_WUP, I_BUP, I_WDN, I_BDN };
__device__ __forceinline__ bf16_t* ptile(const Frame& F, int t) { return (bf16_t*)(F.ar + A_P + (size_t)t * PT_BYTES); }
__device__ __forceinline__ const float* modv(const Frame& F, int l, int mi, int which) { return (const float*)(F.ws + WS_MOD) + ((size_t)(l * 17 + mi) * 6144 + which * 1024); }
namespace pg8 {
typedef int v4i_t __attribute__((ext_vector_type(4)));
typedef int v8i_t __attribute__((ext_vector_type(8)));
constexpr int BM = 256, BK = 64, HALF = 128, HTB = HALF * BK * 2, STAGE_BYTES = 8 * HTB, NXCD = 8, WGM = 8;
__host__ __device__ __forceinline__ int lds_byte(int r, int c) { const int st = (r >> 4) * 2 + (c >> 5), rr = r & 15, cc = c & 31, ob = rr * 64 + cc * 2; return st * 1024 + (ob ^ (((ob >> 9) & 1) << 5)); }
__host__ __device__ __forceinline__ void stage_rc(int b, int& R, int& C) { const int st = b / 1024, sb = b % 1024, swz = sb ^ (((sb >> 9) & 1) << 5); R = (st >> 1) * 16 + swz / 64; C = (st & 1) * 32 + (swz % 64) / 2; }
__host__ __device__ __forceinline__ int perm32(int rho) { const int n = rho >> 4, i = rho & 15; return 8 * (i >> 2) + 4 * n + (i & 3); }

struct Unit { int pm, pn, z; };

template <bool F8_>
struct DenseOrderT {
    static constexpr bool GATHER = false, FP8 = F8_;
    __device__ __forceinline__ int scale_w() const { return 0x7a7a7a7a; }
    __device__ __forceinline__ int scale_x() const { return 0x7f7f7f7f; }
    int pn_off = 0;
    __device__ __forceinline__ int arow(const Unit&, int) const { return 0; }
    __device__ __forceinline__ int araw(const Unit&, int) const { return 0; }
    int imax = 1 << 30, single = -1;
    int nM, nN, nwg, G, c; bool skipctx; const char* A; const char* Bt; size_t tstep; int nctx = 0;
    __device__ void init(int nM_, int nN_, int G_, int c_, bool skip, const void* A_, const void* Bt_, int K) { nM = nM_; nN = nN_; nwg = nM * nN; G = G_; c = c_; skipctx = skip; A = (const char*)A_; Bt = (const char*)Bt_; tstep = (size_t)BM * K * (F8_ ? 1 : 2); }
    __device__ bool next(int i, Unit& u) const {
        long L = (long)i * G + c; if (single >= 0) { if (i > 0) return false; L = single; } else if (i >= imax) return false;
        if (L >= nwg + nctx) return false;
        if (L >= nwg) { const int idx = (int)L - nwg, q = idx / 7, t = idx - q * 7;
            u.pm = q * 17; u.pn = (t == 0) ? 1 : (t == 1) ? 2 : (t == 2) ? 4 : (t == 3) ? 7 : (t == 4) ? 8 : (t == 5) ? 9 : 11; u.z = 0; return true; }
        int wgid = (int)L; { const int q = nwg / NXCD, r = nwg % NXCD, xcd = wgid % NXCD, off = wgid / NXCD; wgid = (xcd < r ? xcd * (q + 1) : r * (q + 1) + (xcd - r) * q) + off; }
        const int nig = WGM * nN, gid = wgid / nig, fm = gid * WGM, gsz = (nM - fm) < WGM ? (nM - fm) : WGM;
        int pm = fm + ((wgid % nig) % gsz); u.pn = (wgid % nig) / gsz + pn_off; u.z = 0;
        if (skipctx) pm = (pm >> 4) * 17 + 1 + (pm & 15);
        u.pm = pm; return true;
    }
    __device__ __forceinline__ const char* abase(const Unit& u) const { return A + (size_t)u.pm * tstep; }
    __device__ __forceinline__ const char* bbase(const Unit& u) const { return Bt + (size_t)(u.pn - pn_off) * tstep; }
};
typedef DenseOrderT<false> DenseOrder;

template <class Epi, class Sched, bool ALIGN = true>
__device__ __forceinline__ void gemm_phase(LAS unsigned char* lds, const int tid, const int K, const Sched& S, const Epi& E) {
    const int wid = __builtin_amdgcn_readfirstlane(tid >> 6), lane = tid & 63, wr = wid >> 2, wc = wid & 3, fr = lane & 15, fq = lane >> 4;
    constexpr bool F8 = Sched::FP8;
    const int RB = F8 ? K : 2 * K;
    const int nt = RB / 128;
    unsigned voffA[2], voffB[2];
#pragma unroll
    for (int i = 0; i < 2; ++i) { int R, C; stage_rc(tid * 16 + i * 8192, R, C); const int Rb = (R & ~31) + perm32(R & 31);
        voffA[i] = (unsigned)(R * RB + C * 2); voffB[i] = (unsigned)(Rb * RB + C * 2); }
    const size_t kstep = (size_t)(BK * 2);
    const size_t hstep = (size_t)HALF * RB;
    int Rst[2], Cst[2];
#pragma unroll
    for (int i = 0; i < 2; ++i) stage_rc(tid * 16 + i * 8192, Rst[i], Cst[i]);
    unsigned gA[2][2], ngA[2][2];
    const unsigned ldsw = (unsigned)wid * 1024u;
    const int aoff = lds_byte(wr * 64 + fr, fq * 8), boff = lds_byte(wc * 32 + fr, fq * 8);
#define PG8_SA(b, h) (((b) * 2 + (h)) * HTB)
#define PG8_SB(b, h) ((4 + (b) * 2 + (h)) * HTB)
#define PG8_STAGE(bufoff, gbase, voff) do { _Pragma("unroll") for (int _i = 0; _i < 2; ++_i) \
        __builtin_amdgcn_global_load_lds((const unsigned*)((const char*)(gbase) + (voff)[_i]), (LAS unsigned*)(lds + (bufoff) + ldsw + _i * 8192), 16, 0, 0); } while (0)
#define PG8_GLOAD(dst, u_) do { if constexpr (Sched::GATHER) { _Pragma("unroll") for (int _h = 0; _h < 2; ++_h) _Pragma("unroll") for (int _i = 0; _i < 2; ++_i) \
        dst[_h][_i] = (unsigned)S.arow((u_), _h * HALF + Rst[_i]) * (unsigned)RB + (unsigned)(Cst[_i] * 2); } } while (0)
#define PG8_STAGE_A(bufoff, gbase, h_, nx_) do { if constexpr (Sched::GATHER) { _Pragma("unroll") for (int _i = 0; _i < 2; ++_i) \
        __builtin_amdgcn_global_load_lds((const unsigned*)((const char*)(gbase) + ((nx_) ? ngA[h_][_i] : gA[h_][_i])), (LAS unsigned*)(lds + (bufoff) + ldsw + _i * 8192), 16, 0, 0); } \
        else PG8_STAGE(bufoff, (gbase) + (h_) * hstep, voffA); } while (0)
#define PG8_LD32(p_) __builtin_shufflevector(*(const LAS v4i_t*)(p_), *(const LAS v4i_t*)((p_) + 1024), 0, 1, 2, 3, 4, 5, 6, 7)
#define PG8_LDA(dst, b, h) do { if constexpr (F8) { _Pragma("unroll") for (int m = 0; m < 4; ++m) dst##8[m] = PG8_LD32(lds + PG8_SA(b, h) + aoff + m * 2048); } \
        else { _Pragma("unroll") for (int m = 0; m < 4; ++m) _Pragma("unroll") for (int k = 0; k < 2; ++k) dst[m][k] = *(const LAS bf16x8*)(lds + PG8_SA(b, h) + aoff + m * 2048 + k * 1024); } } while (0)
#define PG8_LDB(dst, b, h) do { if constexpr (F8) { _Pragma("unroll") for (int n = 0; n < 2; ++n) dst##8[n] = PG8_LD32(lds + PG8_SB(b, h) + boff + n * 2048); } \
        else { _Pragma("unroll") for (int n = 0; n < 2; ++n) _Pragma("unroll") for (int k = 0; k < 2; ++k) dst[n][k] = *(const LAS bf16x8*)(lds + PG8_SB(b, h) + boff + n * 2048 + k * 1024); } } while (0)
#define PG8_MMA(ai, bj, At, Bt) do { __builtin_amdgcn_s_setprio(1); _Pragma("unroll") for (int m = 0; m < 4; ++m) _Pragma("unroll") for (int n = 0; n < 2; ++n) { \
        if constexpr (F8) asm volatile("v_mfma_scale_f32_16x16x128_f8f6f4 %0, %1, %2, %0, %3, %4 op_sel_hi:[0,0,0]" : "+v"(acc[ai][bj][m][n]) : "v"(Bt##8[n]), "v"(At##8[m]), "v"(sclw), "v"(sclx)); \
        else { _Pragma("unroll") for (int k = 0; k < 2; ++k) acc[ai][bj][m][n] = __builtin_amdgcn_mfma_f32_16x16x32_bf16(Bt[n][k], At[m][k], acc[ai][bj][m][n], 0, 0, 0); } } \
        __builtin_amdgcn_s_setprio(0); } while (0)
#define PG8_WAIT_V(n) asm volatile("s_waitcnt vmcnt(" #n ")" ::: "memory")
#define PG8_WAIT_L(n) asm volatile("s_waitcnt lgkmcnt(" #n ")" ::: "memory")
#define PG8_BAR __builtin_amdgcn_s_barrier()
#define PG8_SCHED __builtin_amdgcn_sched_barrier(0)
    Unit cur, nxt; int ui = 0;
    if (!S.next(0, cur)) return;
    f32x4 acc[2][2][4][2];
#pragma unroll
    for (int a = 0; a < 2; ++a)
#pragma unroll
        for (int b = 0; b < 2; ++b)
#pragma unroll
            for (int m = 0; m < 4; ++m)
#pragma unroll
                for (int n = 0; n < 2; ++n) acc[a][b][m][n] = (f32x4){0.f, 0.f, 0.f, 0.f};
    bf16x8 At[4][2], B0[2][2], B1[2][2];
    v8i_t At8[4], B08[2], B18[2];
    const int sclw = S.scale_w(), sclx = S.scale_x();
    const char* cA = S.abase(cur); const char* cB = S.bbase(cur);
    PG8_GLOAD(gA, cur);
    if constexpr (Sched::GATHER) { _Pragma("unroll") for (int _h = 0; _h < 2; ++_h) _Pragma("unroll") for (int _i = 0; _i < 2; ++_i) ngA[_h][_i] = gA[_h][_i]; asm volatile("s_waitcnt vmcnt(0)" ::: "memory"); }
    PG8_STAGE(PG8_SB(0, 0), cB, voffB); PG8_STAGE(PG8_SB(0, 1), cB + hstep, voffB); PG8_STAGE_A(PG8_SA(0, 0), cA, 0, false); PG8_STAGE_A(PG8_SA(0, 1), cA, 1, false);
    if (wr == 1) PG8_BAR;
    PG8_WAIT_V(2); PG8_BAR;
    PG8_STAGE(PG8_SB(1, 0), cB + kstep, voffB); PG8_STAGE_A(PG8_SA(1, 0), cA + kstep, 0, false); PG8_STAGE(PG8_SB(1, 1), cB + hstep + kstep, voffB);
    PG8_WAIT_V(6); PG8_BAR;
    for (;;) {
        const bool has_next = S.next(ui + 1, nxt);
        const char* nA = has_next ? S.abase(nxt) : cA; const char* nB = has_next ? S.bbase(nxt) : cB;
        int rawn[2][2];
        if constexpr (Sched::GATHER) { if (has_next) { _Pragma("unroll") for (int _h = 0; _h < 2; ++_h) _Pragma("unroll") for (int _i = 0; _i < 2; ++_i) rawn[_h][_i] = S.araw(nxt, _h * HALF + Rst[_i]); } }
#pragma unroll 1
        for (int t = 0; t < nt; t += 2) {
            const bool last = (t == nt - 2);
            const char* a1 = cA + (size_t)(t + 1) * kstep;
            const char* a2 = last ? nA : cA + (size_t)(t + 2) * kstep; const char* b2 = last ? nB : cB + (size_t)(t + 2) * kstep;
            const char* a3 = a2 + kstep; const char* b3 = b2 + kstep;
            if constexpr (Sched::GATHER) { if (last && has_next) { _Pragma("unroll") for (int _h = 0; _h < 2; ++_h) _Pragma("unroll") for (int _i = 0; _i < 2; ++_i)
                ngA[_h][_i] = (unsigned)(rawn[_h][_i] < 0 ? 0 : rawn[_h][_i] >> 2) * (unsigned)RB + (unsigned)(Cst[_i] * 2); } }
            PG8_LDB(B0, 0, 0); PG8_LDB(B1, 0, 1); PG8_SCHED; PG8_LDA(At, 0, 0); PG8_STAGE_A(PG8_SA(1, 1), a1, 1, false);
            PG8_WAIT_V(8); PG8_WAIT_L(0); PG8_BAR; PG8_MMA(0, 0, At, B0); PG8_MMA(0, 1, At, B1); PG8_BAR; PG8_SCHED;
            PG8_LDA(At, 0, 1); PG8_STAGE(PG8_SB(0, 0), b2, voffB); PG8_STAGE(PG8_SB(0, 1), b2 + hstep, voffB); PG8_STAGE_A(PG8_SA(0, 0), a2, 0, last);
            PG8_WAIT_V(8); PG8_WAIT_L(0); PG8_BAR; PG8_MMA(1, 0, At, B0); PG8_MMA(1, 1, At, B1); PG8_BAR; PG8_SCHED;
            PG8_LDB(B0, 1, 0); PG8_LDB(B1, 1, 1); PG8_SCHED; PG8_LDA(At, 1, 0); PG8_STAGE_A(PG8_SA(0, 1), a2, 1, last);
            PG8_WAIT_V(8); PG8_WAIT_L(0); PG8_BAR; PG8_MMA(0, 0, At, B0); PG8_MMA(0, 1, At, B1); PG8_BAR; PG8_SCHED;
            PG8_LDA(At, 1, 1); PG8_STAGE(PG8_SB(1, 0), b3, voffB); PG8_STAGE(PG8_SB(1, 1), b3 + hstep, voffB); PG8_STAGE_A(PG8_SA(1, 0), a3, 0, last);
            PG8_WAIT_V(8); PG8_WAIT_L(0); PG8_BAR; PG8_MMA(1, 0, At, B0); PG8_MMA(1, 1, At, B1); PG8_BAR; PG8_SCHED;
        }
        if (ALIGN) { if (wr == 0) PG8_BAR; }
        bool keep = false;
        if constexpr (F8) asm volatile("s_nop 15\n\ts_nop 15" ::: "memory");
        { int tz = tid; asm volatile("" : "+v"(tz)); const int wid2 = __builtin_amdgcn_readfirstlane(tz >> 6), lane2 = tz & 63;
          if constexpr (Epi::CHAIN) keep = E(acc, cur, wid2 >> 2, wid2 & 3, lane2 & 15, lane2 >> 4); else { E(acc, cur, wid2 >> 2, wid2 & 3, lane2 & 15, lane2 >> 4); if constexpr (Epi::TWICE) { asm volatile("" ::: "memory"); E(acc, cur, wid2 >> 2, wid2 & 3, lane2 & 15, lane2 >> 4); } } }
        if (!has_next) break;
        if (!keep)
#pragma unroll
        for (int a = 0; a < 2; ++a)
#pragma unroll
            for (int b = 0; b < 2; ++b)
#pragma unroll
                for (int m = 0; m < 4; ++m)
#pragma unroll
                    for (int n = 0; n < 2; ++n) acc[a][b][m][n] = (f32x4){0.f, 0.f, 0.f, 0.f};
        cur = nxt; cA = nA; cB = nB; ++ui;
        if constexpr (Sched::GATHER) { _Pragma("unroll") for (int _h = 0; _h < 2; ++_h) _Pragma("unroll") for (int _i = 0; _i < 2; ++_i) gA[_h][_i] = ngA[_h][_i]; }
        if (ALIGN) { if (wr == 1) PG8_BAR; }
    }
    PG8_WAIT_V(0);
    if (!ALIGN) { if (wr == 0) PG8_BAR; }
    PG8_BAR;
#undef PG8_SA
#undef PG8_SB
#undef PG8_STAGE
#undef PG8_STAGE_A
#undef PG8_GLOAD
#undef PG8_LDA
#undef PG8_LDB
#undef PG8_MMA
#undef PG8_LD32
#undef PG8_WAIT_V
#undef PG8_WAIT_L
#undef PG8_BAR
#undef PG8_SCHED
}
}
using pg8::Unit;
typedef f32x4 AccT[2][2][4][2];

__device__ __forceinline__ u32x4 pack8(const f32x4 v0, const f32x4 v1) { u32x4 w; w.x = cvt_pk(v0[0], v0[1]); w.y = cvt_pk(v0[2], v0[3]); w.z = cvt_pk(v1[0], v1[1]); w.w = cvt_pk(v1[2], v1[3]); return w; }
constexpr float YSCL = 16.f;
__device__ __forceinline__ u32x2 pack8f8(const f32x4 v0, const f32x4 v1) { int w0 = 0, w1 = 0;
    w0 = __builtin_amdgcn_cvt_pk_fp8_f32(v0[0], v0[1], w0, false); w0 = __builtin_amdgcn_cvt_pk_fp8_f32(v0[2], v0[3], w0, true);
    w1 = __builtin_amdgcn_cvt_pk_fp8_f32(v1[0], v1[1], w1, false); w1 = __builtin_amdgcn_cvt_pk_fp8_f32(v1[2], v1[3], w1, true); return (u32x2){(unsigned)w0, (unsigned)w1}; }
__device__ __forceinline__ void unpack8f8(const u32x2 w, f32x4& v0, f32x4& v1) {
    const f32x2 a = __builtin_amdgcn_cvt_pk_f32_fp8((int)w.x, false), b = __builtin_amdgcn_cvt_pk_f32_fp8((int)w.x, true), c = __builtin_amdgcn_cvt_pk_f32_fp8((int)w.y, false), d = __builtin_amdgcn_cvt_pk_f32_fp8((int)w.y, true);
    v0 = (f32x4){a[0], a[1], b[0], b[1]}; v1 = (f32x4){c[0], c[1], d[0], d[1]}; }
__device__ __forceinline__ void unpack8(const u32x4 w, f32x4& v0, f32x4& v1) { v0 = (f32x4){bf_lo(w.x), bf_hi(w.x), bf_lo(w.y), bf_hi(w.y)}; v1 = (f32x4){bf_lo(w.z), bf_hi(w.z), bf_lo(w.w), bf_hi(w.w)}; }

struct EpiTiles {
    static constexpr bool CHAIN = false, TWICE = (PROBE_REP & 1024) != 0;
    bf16_t* P; const float* bgate;
    __device__ __forceinline__ void operator()(const AccT& acc, const Unit& u, int wr, int wc, int fr, int fq) const {
        bf16_t* base = P + (size_t)u.pn * ((size_t)NR * 256) + (size_t)(u.pm * 256 + wr * 64 + fr) * 256 + wc * 32 + 8 * fq;
        if (u.pn < T_GATE) {
#pragma unroll
            for (int ai = 0; ai < 2; ++ai)
#pragma unroll
                for (int m = 0; m < 4; ++m)
#pragma unroll
                    for (int bj = 0; bj < 2; ++bj)
                        *(u32x4*)(base + (size_t)(ai * 128 + m * 16) * 256 + bj * 128) = pack8(acc[ai][bj][m][0], acc[ai][bj][m][1]);
        } else {
            unsigned char* gb = (unsigned char*)(P + (size_t)u.pn * ((size_t)NR * 256)) + (size_t)u.pm * 65536 + (((wr * 4 + wc) * 64 + fq * 16 + fr) * 16);
            const float* bg = bgate + ((u.pn - T_GATE) >> 2) * 1024 + ((u.pn - T_GATE) & 3) * 256 + wc * 32 + 8 * fq;
#pragma unroll
            for (int bj = 0; bj < 2; ++bj) {
                const f32x4 b0 = *(const f32x4*)(bg + bj * 128) * -LOG2E, b1 = *(const f32x4*)(bg + bj * 128 + 4) * -LOG2E;
#define GATE255(a_, b_) __builtin_amdgcn_rcpf(__builtin_fmaf(__builtin_amdgcn_exp2f(__builtin_fmaf((a_), -LOG2E, (b_))), 1.f / 255.f, 1.f / 255.f))
#pragma unroll
                for (int ai = 0; ai < 2; ++ai)
#pragma unroll
                    for (int mp = 0; mp < 2; ++mp) {
                        u32x4 o = (u32x4){0u, 0u, 0u, 0u};
#pragma unroll
                        for (int j = 0; j < 4; ++j) {
                            o.x = __builtin_amdgcn_cvt_pk_u8_f32(GATE255(acc[ai][bj][2 * mp][0][j], b0[j]), j, o.x); o.y = __builtin_amdgcn_cvt_pk_u8_f32(GATE255(acc[ai][bj][2 * mp][1][j], b1[j]), j, o.y);
                            o.z = __builtin_amdgcn_cvt_pk_u8_f32(GATE255(acc[ai][bj][2 * mp + 1][0][j], b0[j]), j, o.z); o.w = __builtin_amdgcn_cvt_pk_u8_f32(GATE255(acc[ai][bj][2 * mp + 1][1][j], b1[j]), j, o.w); }
#undef GATE255
                        o.x |= 0x01010101u; o.y |= 0x01010101u; o.z |= 0x01010101u; o.w |= 0x01010101u;
                        *(u32x4*)(gb + ((bj * 2 + ai) * 2 + mp) * 8192) = o;
                    }
            }
        }
    }
};

struct MergeOrder {
    static constexpr bool GATHER = false, FP8 = false;
    __device__ __forceinline__ int scale_w() const { return 0; }
    __device__ __forceinline__ int scale_x() const { return 0; }
    __device__ __forceinline__ int arow(const Unit&, int) const { return 0; }
    __device__ __forceinline__ int araw(const Unit&, int) const { return 0; }
    int G, c, ntile; bool skipctx; const char* P; const char* Wbr;
    __device__ bool next(int i, Unit& u) const {
        const int w = (i >> 2) * (G >> 3) + (c >> 3); if (w >= (ntile >> 3)) return false;
        int pm = (c & 7) + 8 * (w >> 2); u.pn = w & 3; u.z = i & 3;
        if (skipctx) pm = (pm >> 4) * 17 + 1 + (pm & 15);
        u.pm = pm; return true;
    }
    __device__ __forceinline__ const char* abase(const Unit& u) const { const int tz = (u.z == 0) ? T_AQ : (u.z == 1) ? T_GQ : (u.z == 2) ? T_MU : T_DG; return P + (size_t)tz * PT_BYTES + (size_t)u.pm * (256 * 256 * 2); }
    __device__ __forceinline__ const char* bbase(const Unit& u) const { return Wbr + (size_t)u.z * (1024 * 256 * 2) + (size_t)u.pn * (256 * 256 * 2); }
};
struct EpiMerge {
    static constexpr bool CHAIN = true, TWICE = false;
    const bf16_t* P; bf16_t* merged;
    __device__ __forceinline__ bool operator()(AccT& acc, const Unit& u, int wr, int wc, int fr, int fq) const {
        const int row0 = u.pm * 256 + wr * 64 + fr, colt = wc * 32 + 8 * fq;
        const unsigned char* g0p = (const unsigned char*)(P + (size_t)(T_GATE + 4 * u.z + u.pn) * ((size_t)NR * 256)) + (size_t)u.pm * 65536 + (((wr * 4 + wc) * 64 + fq * 16 + fr) * 16);
        if (u.z < 3) {
            const unsigned char* g1p = g0p + (size_t)4 * PT_BYTES;
            u32x4 ga[2][2], gb[2][2];
#pragma unroll
            for (int q = 0; q < 2; ++q)
#pragma unroll
                for (int h = 0; h < 2; ++h) { ga[q][h] = *(const u32x4*)(g0p + (2 * q + h) * 8192); gb[q][h] = *(const u32x4*)(g1p + (2 * q + h) * 8192); }
#pragma unroll
            for (int q = 0; q < 4; ++q) {
                const int bj = q >> 1, ai = q & 1;
#pragma unroll
                for (int m = 0; m < 4; ++m) {
                    const u32x4 A = ga[q & 1][m >> 1], B = gb[q & 1][m >> 1];
                    const unsigned a0 = (m & 1) ? A.z : A.x, a1 = (m & 1) ? A.w : A.y, b0 = (m & 1) ? B.z : B.x, b1 = (m & 1) ? B.w : B.y;
#pragma unroll
                    for (int j = 0; j < 4; ++j) {
                        acc[ai][bj][m][0][j] *= (float)((a0 >> (8 * j)) & 0xffu) * __builtin_amdgcn_rcpf((float)((b0 >> (8 * j)) & 0xffu));
                        acc[ai][bj][m][1][j] *= (float)((a1 >> (8 * j)) & 0xffu) * __builtin_amdgcn_rcpf((float)((b1 >> (8 * j)) & 0xffu));
                    }
                }
                if (q < 2) {
#pragma unroll
                    for (int h = 0; h < 2; ++h) { ga[q & 1][h] = *(const u32x4*)(g0p + (2 * (q + 2) + h) * 8192); gb[q & 1][h] = *(const u32x4*)(g1p + (2 * (q + 2) + h) * 8192); }
                }
            }
            return true;
        }
        u32x4 ga[8];
#pragma unroll
        for (int i = 0; i < 8; ++i) ga[i] = *(const u32x4*)(g0p + i * 8192);
        bf16_t* mp = merged + (size_t)row0 * 1024 + u.pn * 256 + colt;
#pragma unroll
        for (int bj = 0; bj < 2; ++bj)
#pragma unroll
            for (int ai = 0; ai < 2; ++ai)
#pragma unroll
                for (int m = 0; m < 4; ++m) {
                    const int i = (bj * 2 + ai) * 2 + (m >> 1);
                    const unsigned a0 = (m & 1) ? ga[i].z : ga[i].x, a1 = (m & 1) ? ga[i].w : ga[i].y;
                    f32x4 o0, o1;
#pragma unroll
                    for (int j = 0; j < 4; ++j) { o0[j] = acc[ai][bj][m][0][j] * ((float)((a0 >> (8 * j)) & 0xffu) * (1.f / 255.f)); o1[j] = acc[ai][bj][m][1][j] * ((float)((a1 >> (8 * j)) & 0xffu) * (1.f / 255.f)); }
                    *(u32x4*)(mp + (size_t)(ai * 128 + m * 16) * 1024 + bj * 128) = pack8(o0, o1);
                }
        return false;
    }
};

struct EpiWo {
    static constexpr bool CHAIN = false, TWICE = false;
    const float* xin_lat; const float* xin_ctx; bf16_t* xb; const float* mod_l;
    int which;
    __device__ __forceinline__ void operator()(const AccT& acc, const Unit& u, int wr, int wc, int fr, int fq) const {
        const int b = u.pm / 17, j = u.pm - b * 17; const bool isctx = (j == 0);
        const float* gv = mod_l + (size_t)(isctx ? 16 : b) * 6144 + which * 1024 + u.pn * 256 + wc * 32 + 8 * fq;
        const int r0 = wr * 64 + fr; const int c0 = u.pn * 256 + wc * 32 + 8 * fq;
        bf16_t* xo = xb + (size_t)u.pm * 256 * 1024;
        if (xin_lat != nullptr) {
            const float* xin = isctx ? xin_ctx + (size_t)b * 256 * 1024 : xin_lat + ((size_t)b * 4096 + (size_t)(j - 1) * 256) * 1024;
#pragma unroll
            for (int bj = 0; bj < 2; ++bj) {
                const f32x4 g0 = *(const f32x4*)(gv + bj * 128), g1 = *(const f32x4*)(gv + bj * 128 + 4);
#pragma unroll
                for (int ai = 0; ai < 2; ++ai)
#pragma unroll
                    for (int m = 0; m < 4; ++m) {
                        const size_t off = (size_t)(r0 + ai * 128 + m * 16) * 1024 + c0 + bj * 128;
                        const f32x4 x0 = *(const f32x4*)(xin + off), x1 = *(const f32x4*)(xin + off + 4);
                        *(u32x4*)(xo + off) = pack8(x0 + g0 * acc[ai][bj][m][0], x1 + g1 * acc[ai][bj][m][1]);
                    }
            }
        } else {
#pragma unroll
            for (int bj = 0; bj < 2; ++bj) {
                const f32x4 g0 = *(const f32x4*)(gv + bj * 128), g1 = *(const f32x4*)(gv + bj * 128 + 4);
#pragma unroll
                for (int ai = 0; ai < 2; ++ai)
#pragma unroll
                    for (int m = 0; m < 4; ++m) {
                        const size_t off = (size_t)(r0 + ai * 128 + m * 16) * 1024 + c0 + bj * 128;
                        f32x4 x0, x1; unpack8(*(const u32x4*)(xo + off), x0, x1);
                        *(u32x4*)(xo + off) = pack8(x0 + g0 * acc[ai][bj][m][0], x1 + g1 * acc[ai][bj][m][1]);
                    }
            }
        }
    }
};

template <int NPN, bool GATH>
struct MoeOrder {
    static constexpr bool GATHER = GATH, FP8 = true;
    __device__ __forceinline__ int scale_w() const { return 0x7a7a7a7a; }
    __device__ __forceinline__ int scale_x() const { return 0x7f7f7f7f; }
    int G, c, nunits; const LAS int* texp; const char* A; const char* W; size_t wstride; const int* rowmap;
    __device__ __forceinline__ int arow(const Unit& u, int r) const { const int rm = rowmap[u.pm * 256 + r]; return rm < 0 ? 0 : rm >> 2; }
    __device__ __forceinline__ int araw(const Unit& u, int r) const { return rowmap[u.pm * 256 + r]; }
    __device__ bool next(int i, Unit& u) const {
        constexpr int RT = 32 / NPN;
        const int xcd = c & 7, idx = c >> 3, rt = idx / NPN;
        const int pm = (i * RT + rt) * 8 + xcd; if (pm * NPN >= nunits) return false;
        u.pm = pm; u.pn = idx % NPN; u.z = texp[pm]; return true;
    }
    __device__ __forceinline__ const char* abase(const Unit& u) const { return GATH ? A : A + (size_t)u.pm * (256 * 1024); }
    __device__ __forceinline__ const char* bbase(const Unit& u) const { return W + (size_t)u.z * wstride + (size_t)u.pn * (256 * 1024); }
};
struct EpiUp {
    static constexpr bool CHAIN = false, TWICE = false;
    const float* bup; unsigned char* act;
    __device__ __forceinline__ void operator()(const AccT& acc, const Unit& u, int wr, int wc, int fr, int fq) const {
        const int colt = u.pn * 128 + wc * 32 + 8 * fq;
        const float* bb = bup + (size_t)u.z * 2048 + colt;
        const f32x4 bg0 = *(const f32x4*)(bb), bg1 = *(const f32x4*)(bb + 4), bl0 = *(const f32x4*)(bb + 1024) + 1.f, bl1 = *(const f32x4*)(bb + 1028) + 1.f;
        unsigned char* base = act + (size_t)(u.pm * 256 + wr * 64 + fr) * 1024 + colt;
#pragma unroll
        for (int ai = 0; ai < 2; ++ai)
#pragma unroll
            for (int m = 0; m < 4; ++m) {
                f32x4 o0, o1;
#pragma unroll
                for (int j = 0; j < 4; ++j) {
                    float g = fminf(acc[ai][0][m][0][j] + bg0[j], 7.f), li = fminf(fmaxf(acc[ai][1][m][0][j] + bl0[j], -6.f), 8.f);
                    o0[j] = g * sigmoidf_(1.702f * g) * li;
                    g = fminf(acc[ai][0][m][1][j] + bg1[j], 7.f); li = fminf(fmaxf(acc[ai][1][m][1][j] + bl1[j], -6.f), 8.f);
                    o1[j] = g * sigmoidf_(1.702f * g) * li;
                }
                int w0 = 0, w1 = 0;
                w0 = __builtin_amdgcn_cvt_pk_fp8_f32(o0[0], o0[1], w0, false); w0 = __builtin_amdgcn_cvt_pk_fp8_f32(o0[2], o0[3], w0, true);
                w1 = __builtin_amdgcn_cvt_pk_fp8_f32(o1[0], o1[1], w1, false); w1 = __builtin_amdgcn_cvt_pk_fp8_f32(o1[2], o1[3], w1, true);
                *(u32x2*)(base + (size_t)(ai * 128 + m * 16) * 1024) = (u32x2){(unsigned)w0, (unsigned)w1};
            }
    }
};
struct EpiDown {
    static constexpr bool CHAIN = false, TWICE = false;
    const float* bdn; const float* gslot; unsigned char* ybuf;
    __device__ __forceinline__ void operator()(const AccT& acc, const Unit& u, int wr, int wc, int fr, int fq) const {
        const int colt = u.pn * 256 + wc * 32 + 8 * fq;
        const float* bb = bdn + (size_t)u.z * 1024 + colt;
        const f32x4 b00 = *(const f32x4*)(bb), b01 = *(const f32x4*)(bb + 4), b10 = *(const f32x4*)(bb + 128), b11 = *(const f32x4*)(bb + 132);
        const int row0 = u.pm * 256 + wr * 64 + fr;
        float gtv[2][4];
#pragma unroll
        for (int ai = 0; ai < 2; ++ai)
#pragma unroll
            for (int m = 0; m < 4; ++m) gtv[ai][m] = gslot[row0 + ai * 128 + m * 16];
#pragma unroll
        for (int ai = 0; ai < 2; ++ai)
#pragma unroll
            for (int m = 0; m < 4; ++m) {
                const float gt = gtv[ai][m] * YSCL;
                unsigned char* yp = ybuf + (size_t)(row0 + ai * 128 + m * 16) * 1024 + colt;
                *(u32x2*)(yp) = pack8f8((acc[ai][0][m][0] + b00) * gt, (acc[ai][0][m][1] + b01) * gt);
                *(u32x2*)(yp + 128) = pack8f8((acc[ai][1][m][0] + b10) * gt, (acc[ai][1][m][1] + b11) * gt);
            }
    }
};
__device__ __forceinline__ void xpose_tile(const float* __restrict__ src, int ld, int valid, bf16_t* __restrict__ dst, int Kd, LAS float* scr, int lane) {
    const int c4 = (lane & 15) * 4, kr = lane >> 4;
    f32x4 v[16];
#pragma unroll
    for (int i = 0; i < 16; ++i) v[i] = (c4 < valid) ? *(const f32x4*)(src + (size_t)(i * 4 + kr) * ld + c4) : (f32x4){0.f, 0.f, 0.f, 0.f};
#pragma unroll
    for (int i = 0; i < 16; ++i) { LAS float* s = scr + (i * 4 + kr) * 65 + c4; s[0] = v[i][0]; s[1] = v[i][1]; s[2] = v[i][2]; s[3] = v[i][3]; }
    LDS_WAIT(); asm volatile("" ::: "memory");
    const int c = lane & 7;
#pragma unroll
    for (int j = 0; j < 8; ++j) { const int n = (lane >> 3) + 8 * j; const LAS float* s = scr + (8 * c) * 65 + n;
        u32x4 o; o.x = cvt_pk(s[0 * 65], s[1 * 65]); o.y = cvt_pk(s[2 * 65], s[3 * 65]); o.z = cvt_pk(s[4 * 65], s[5 * 65]); o.w = cvt_pk(s[6 * 65], s[7 * 65]);
        *(u32x4*)(dst + (size_t)n * Kd + 8 * c) = o; }
    LDS_WAIT(); asm volatile("" ::: "memory");
}

__device__ __forceinline__ void xpose_tile8(const float* __restrict__ src, int ld, unsigned char* __restrict__ dst, int Kd, LAS float* scr, int lane) {
    const int c4 = (lane & 7) * 4, kr = lane >> 3;
    const float* sp = src + (size_t)kr * ld + c4; const size_t rstep = (size_t)8 * ld;
    f32x4 v[16];
#pragma unroll
    for (int i = 0; i < 16; ++i) v[i] = *(const f32x4*)(sp + i * rstep);
    LAS float* sw = scr + kr * 33 + c4;
#pragma unroll
    for (int i = 0; i < 16; ++i) { LAS float* s = sw + i * (8 * 33); s[0] = v[i][0]; s[1] = v[i][1]; s[2] = v[i][2]; s[3] = v[i][3]; }
    LDS_WAIT(); asm volatile("" ::: "memory");
    const int c = lane & 7;
#pragma unroll
    for (int j = 0; j < 4; ++j) { const int n = (lane >> 3) + 8 * j; const LAS float* s = scr + (16 * c) * 33 + n;
#define F8W(q_) __builtin_amdgcn_cvt_pk_fp8_f32(s[(4 * (q_) + 2) * 33] * 32.f, s[(4 * (q_) + 3) * 33] * 32.f, __builtin_amdgcn_cvt_pk_fp8_f32(s[(4 * (q_)) * 33] * 32.f, s[(4 * (q_) + 1) * 33] * 32.f, 0, false), true)
        const int w0 = F8W(0), w1 = F8W(1), w2 = F8W(2), w3 = F8W(3);
#undef F8W
        *(u32x4*)(dst + (size_t)n * Kd + 16 * c) = (u32x4){(unsigned)w0, (unsigned)w1, (unsigned)w2, (unsigned)w3}; }
    LDS_WAIT(); asm volatile("" ::: "memory");
}

__device__ __forceinline__ void p_prologue(const Frame& F, const Args& a) {
    LAS float* scr = (LAS float*)(F.lds + F.wave * 16896);
    const int gw = F.blk * 8 + F.wave, NGW = GRID * 8;
    constexpr int N_IN = 16 * 112, N_BR = 4 * 4 * 16, N_O = 256, N_UP = 32 * 16 * 32, N_DN = 32 * 16 * 16, N_L = N_IN + N_BR + N_O + N_UP + N_DN;
    for (int it = gw; it < 2 * N_L; it += NGW) {
        const int l = it / N_L; int r = it - l * N_L;
        if (r < N_IN) {
            const int kt = r / 112, ntile = r - kt * 112, n0 = ntile * 64;
            int src0, valid;
            if (n0 < 2816) { src0 = n0; valid = 64; } else if (n0 == 2816) { src0 = 2816; valid = 16; } else if (n0 < 3072) { src0 = 0; valid = 0; } else { src0 = n0 - 240; valid = 64; }
            if (n0 < 3072) xpose_tile(F.in[I_WIN] + (size_t)l * 1024 * 6928 + (size_t)(kt * 64) * 6928 + src0, 6928, valid,
                       (bf16_t*)(F.ws + WS_WIN) + (size_t)l * 7168 * 1024 + (size_t)n0 * 1024 + kt * 64, 1024, scr, F.lane);
            else { const int k8 = (kt >> 1) * 128, ns = (kt & 1) * 32;
                xpose_tile8(F.in[I_WIN] + (size_t)l * 1024 * 6928 + (size_t)k8 * 6928 + src0 + ns, 6928,
                       (unsigned char*)(F.ws + WS_WG8) + (size_t)l * 4096 * 1024 + (size_t)(n0 - 3072 + ns) * 1024 + k8, 1024, scr, F.lane); }
            continue; }
        r -= N_IN;
        if (r < N_BR) {
            const int n = r >> 6, rr = r & 63, kt = rr >> 4, ntile = rr & 15;
            xpose_tile(F.in[I_WBR] + ((size_t)(l * 4 + n) * 256 + kt * 64) * 1024 + ntile * 64, 1024, 64,
                       (bf16_t*)(F.ws + WS_WBR) + (size_t)(l * 4 + n) * 1024 * 256 + (size_t)(ntile * 64) * 256 + kt * 64, 256, scr, F.lane);
            continue; }
        r -= N_BR;
        if (r < N_O) {
            const int kt = r >> 4, ntile = r & 15;
            xpose_tile(F.in[I_WO] + ((size_t)l * 1024 + kt * 64) * 1024 + ntile * 64, 1024, 64,
                       (bf16_t*)(F.ws + WS_WO) + (size_t)l * 1024 * 1024 + (size_t)(ntile * 64) * 1024 + kt * 64, 1024, scr, F.lane);
            continue; }
        r -= N_O;
        if (r < N_UP) {
            const int e = r >> 9, rr = r & 511, kt = rr >> 5, ntile = rr & 31, k8 = (kt >> 1) * 128, n0 = ntile * 64 + (kt & 1) * 32;
            const int j = n0 >> 8, w = n0 & 255, src0 = (w < 128) ? (128 * j + w) : (1024 + 128 * j + (w - 128));
            xpose_tile8(F.in[I_WUP] + ((size_t)(l * 32 + e) * 1024 + k8) * 2048 + src0, 2048,
                        (unsigned char*)(F.ws + WS_WUP) + (size_t)(l * 32 + e) * 2048 * 1024 + (size_t)n0 * 1024 + k8, 1024, scr, F.lane);
            continue; }
        r -= N_UP;
        {
            const int e = r >> 8, rr = r & 255, kt = rr >> 4, ntile = rr & 15, k8 = (kt >> 1) * 128, n0 = ntile * 64 + (kt & 1) * 32;
            xpose_tile8(F.in[I_WDN] + ((size_t)(l * 32 + e) * 1024 + k8) * 1024 + n0, 1024,
                        (unsigned char*)(F.ws + WS_WDN) + (size_t)(l * 32 + e) * 1024 * 1024 + (size_t)n0 * 1024 + k8, 1024, scr, F.lane);
        }
    }
    { const int gt = F.blk * 512 + F.tid, NT = GRID * 512; const float* s = F.in[I_GMWS]; bf16_t* d = (bf16_t*)(F.ws + WS_GMWS);
      for (int i = gt; i < 2 * 4 * 128 * 128 / 4; i += NT) { const f32x4 v = *(const f32x4*)(s + (size_t)i * 4); u32x2 o; o.x = cvt_pk(v[0], v[1]); o.y = cvt_pk(v[2], v[3]); *(u32x2*)(d + (size_t)i * 4) = o; } }
    { const int gt = F.blk * 512 + F.tid;
      if (gt < 1536) {
          const int sel = gt >= 512, idx = sel ? gt - 512 : gt, Q = sel ? 16 : 8, pos = idx / Q, i = idx - pos * Q;
          const float inv = sel ? a.inv64[i] : a.inv32[i];
          const float af = (float)pos * inv;
          double x = (double)af; const double twopi = 6.283185307179586476925287;
          x -= twopi * rint(x / twopi);
          const double x2 = x * x;
          double sn = 1.0, cs = 1.0;
#pragma unroll
          for (int k = 13; k >= 1; --k) { sn = 1.0 - sn * x2 / (double)((2 * k) * (2 * k + 1)); cs = 1.0 - cs * x2 / (double)((2 * k - 1) * (2 * k)); }
          sn *= x;
          f32x2* T = (f32x2*)(F.ws + WS_ROPE);
          T[gt] = (f32x2){(float)cs, (float)sn};
      } }
    __syncthreads();
    if (F.blk < 192) {
        LAS float* s = (LAS float*)F.lds;
        LAS float* red = s + 17 * 1024;
        for (int idx = F.tid; idx < 17 * 1024; idx += 512) { const int i = idx >> 10, k = idx & 1023; const float c = (i < 16) ? F.in[I_C][i * 1024 + k] : F.in[I_CCTX][k]; s[idx] = siluf_(c); }
        __syncthreads();
        float* mod = (float*)(F.ws + WS_MOD);
        for (int item = F.blk; item < 192; item += GRID) {
            const int l = item / 96, j0 = (item - l * 96) * 64, jj = F.tid & 63, kp = F.tid >> 6;
            float acc[17];
#pragma unroll
            for (int i = 0; i < 17; ++i) acc[i] = 0.f;
            const float* w = F.in[I_WMOD] + (size_t)l * 1024 * 6144 + (size_t)(kp * 128) * 6144 + j0 + jj;
            const LAS float* sk = s + kp * 128;
#pragma unroll 2
            for (int k = 0; k < 128; k += 4) {
                const float w0 = w[(size_t)k * 6144], w1 = w[(size_t)(k + 1) * 6144], w2 = w[(size_t)(k + 2) * 6144], w3 = w[(size_t)(k + 3) * 6144];
#pragma unroll
                for (int i = 0; i < 17; ++i) { const f32x4 sv = *(const LAS f32x4*)(sk + i * 1024 + k); acc[i] += (sv[0] * w0 + sv[1] * w1) + (sv[2] * w2 + sv[3] * w3); } }
#pragma unroll
            for (int i = 0; i < 17; ++i) red[(kp * 17 + i) * 64 + jj] = acc[i];
            __syncthreads();
            for (int idx = F.tid; idx < 17 * 64; idx += 512) { const int i = idx >> 6, j = idx & 63;
                float t = F.in[I_BMOD][l * 6144 + j0 + j];
#pragma unroll
                for (int p8 = 0; p8 < 8; ++p8) t += red[(p8 * 17 + i) * 64 + j];
                mod[(size_t)(l * 17 + i) * 6144 + j0 + j] = t; }
            __syncthreads();
        }
    }
}
template <int MODE>
__device__ __forceinline__ void p_rowpass(const Frame& F, int l) {
    const int gw = F.blk * 8 + F.wave, NGW = GRID * 8;
    const unsigned char* ybuf = F.ar + A_YBUF; const unsigned* seli = (const unsigned*)(F.ws + WS_SELI);
    bf16_t* H = (bf16_t*)(F.ar + A_H); unsigned char* H8 = F.ar + A_H8;
    bf16_t* XB = (bf16_t*)(F.ws + WS_XB);
    constexpr int NQ = 2;
    const int lc = F.lane * 8;
    static_assert(NR % (GRID * 8 * NQ) == 0, "rows per wave");
    constexpr int RPW = NR / (GRID * 8);
    const int Rw0 = gw * RPW;
    int mcur = -1; f32x4 A1[4], B1[4], G2[4];
    u32x4 slv[NQ];
    if (MODE >= 1) {
#pragma unroll
        for (int q = 0; q < NQ; ++q) slv[q] = *(const u32x4*)(seli + (size_t)(Rw0 + q) * 4);
    }
    for (int R0 = Rw0; R0 < Rw0 + RPW; R0 += NQ) {
        f32x4 v[NQ][4]; u32x4 xw[NQ][2]; u32x2 yv[NQ][2][4]; int mir[NQ]; bool act[NQ];
        u32x4 sln[NQ];
        if (MODE >= 1) { const int Rn = (R0 + NQ < Rw0 + RPW) ? R0 + NQ : R0;
#pragma unroll
            for (int q = 0; q < NQ; ++q) sln[q] = *(const u32x4*)(seli + (size_t)(Rn + q) * 4); }
#pragma unroll
        for (int q = 0; q < NQ; ++q) {
            const int R = R0 + q;
            const int b = R / TPB, p = R - b * TPB; const bool isctx = p < CTXL; mir[q] = isctx ? 16 : b;
            act[q] = !(MODE == 2 && isctx);
            if (MODE == 0) {
                const float* xin = isctx ? F.in[I_CTX] + ((size_t)b * 256 + p) * 1024 : F.in[I_X] + ((size_t)b * 4096 + (p - 256)) * 1024;
#pragma unroll
                for (int c = 0; c < 2; ++c) { v[q][2 * c] = *(const f32x4*)(xin + lc + 512 * c); v[q][2 * c + 1] = *(const f32x4*)(xin + lc + 512 * c + 4); }
            } else if (act[q]) {
#pragma unroll
                for (int c = 0; c < 2; ++c) xw[q][c] = *(const u32x4*)(XB + (size_t)R * 1024 + lc + 512 * c);
                const u32x4 sl = slv[q];
#pragma unroll
                for (int c = 0; c < 2; ++c) {
                    yv[q][c][0] = *(const u32x2*)(ybuf + (size_t)sl.x * 1024 + lc + 512 * c); yv[q][c][1] = *(const u32x2*)(ybuf + (size_t)sl.y * 1024 + lc + 512 * c);
                    yv[q][c][2] = *(const u32x2*)(ybuf + (size_t)sl.z * 1024 + lc + 512 * c); yv[q][c][3] = *(const u32x2*)(ybuf + (size_t)sl.w * 1024 + lc + 512 * c); }
            }
        }
#pragma unroll
        for (int q = 0; q < NQ; ++q) {
            if (!act[q]) continue;
            const int R = R0 + q;
            if (mir[q] != mcur) {
                mcur = mir[q];
                if (MODE >= 1) { const float* g2 = modv(F, l - 1, mcur, 5);
#pragma unroll
                    for (int c = 0; c < 2; ++c) { G2[2 * c] = *(const f32x4*)(g2 + lc + 512 * c) * (1.f / YSCL); G2[2 * c + 1] = *(const f32x4*)(g2 + lc + 512 * c + 4) * (1.f / YSCL); } }
                if (MODE <= 1) { const float* gn = F.in[I_N1G] + l * 1024; const float* sh = modv(F, l, mcur, 0); const float* sc = modv(F, l, mcur, 1);
#pragma unroll
                    for (int c = 0; c < 2; ++c) { const int cc = lc + 512 * c;
                        A1[2 * c] = *(const f32x4*)(gn + cc) * (*(const f32x4*)(sc + cc) + 1.f); A1[2 * c + 1] = *(const f32x4*)(gn + cc + 4) * (*(const f32x4*)(sc + cc + 4) + 1.f);
                        B1[2 * c] = *(const f32x4*)(sh + cc); B1[2 * c + 1] = *(const f32x4*)(sh + cc + 4); } }
            }
            if (MODE >= 1) {
#pragma unroll
                for (int c = 0; c < 2; ++c) {
                    f32x4 s0 = (f32x4){0.f, 0.f, 0.f, 0.f}, s1 = s0;
#pragma unroll
                    for (int k = 0; k < 4; ++k) { f32x4 a0, a1; unpack8f8(yv[q][c][k], a0, a1); s0 += a0; s1 += a1; }
                    f32x4 x0, x1; unpack8(xw[q][c], x0, x1);
                    v[q][2 * c] = x0 + G2[2 * c] * s0; v[q][2 * c + 1] = x1 + G2[2 * c + 1] * s1;
                    if (MODE == 1) *(u32x4*)(XB + (size_t)R * 1024 + lc + 512 * c) = pack8(v[q][2 * c], v[q][2 * c + 1]);
                    else { const int b = R / TPB, p = R - b * TPB; float* xo = F.out + ((size_t)b * 4096 + (p - 256)) * 1024 + lc + 512 * c;
                        *(f32x4*)xo = v[q][2 * c]; *(f32x4*)(xo + 4) = v[q][2 * c + 1]; }
                }
            }
            if (MODE <= 1) {
                float ss = 0.f;
#pragma unroll
                for (int j = 0; j < 4; ++j) ss += (v[q][j][0] * v[q][j][0] + v[q][j][1] * v[q][j][1]) + (v[q][j][2] * v[q][j][2] + v[q][j][3] * v[q][j][3]);
                const float rstd = rsqrtf(wave_sum(ss) * (1.f / 1024.f) + EPS);
#pragma unroll
                for (int c = 0; c < 2; ++c) { const int cc = lc + 512 * c;
                    const f32x4 h0 = (v[q][2 * c] * rstd) * A1[2 * c] + B1[2 * c];
                    const f32x4 h1 = (v[q][2 * c + 1] * rstd) * A1[2 * c + 1] + B1[2 * c + 1];
                    *(u32x4*)(H + (size_t)R * 1024 + cc) = pack8(h0, h1);
                    int w0 = 0, w1 = 0; w0 = __builtin_amdgcn_cvt_pk_fp8_f32(h0[0], h0[1], w0, false); w0 = __builtin_amdgcn_cvt_pk_fp8_f32(h0[2], h0[3], w0, true);
                    w1 = __builtin_amdgcn_cvt_pk_fp8_f32(h1[0], h1[1], w1, false); w1 = __builtin_amdgcn_cvt_pk_fp8_f32(h1[2], h1[3], w1, true);
                    *(u32x2*)(H8 + (size_t)R * 1024 + cc) = (u32x2){(unsigned)w0, (unsigned)w1}; }
            }
        }
        if (MODE >= 1) {
#pragma unroll
            for (int q = 0; q < NQ; ++q) slv[q] = sln[q]; }
    }
}

template <int HD>
__device__ __forceinline__ void qk_norm_rope(bf16_t* p, const float* gain, float post, int pos, const f32x2* rt, bf16_t* po = nullptr) {
    if (!po) po = p;
    float x[HD];
#pragma unroll
    for (int i = 0; i < HD / 8; ++i) { const u32x4 w = *(const u32x4*)(p + 8 * i); x[8 * i] = bf_lo(w.x); x[8 * i + 1] = bf_hi(w.x); x[8 * i + 2] = bf_lo(w.y); x[8 * i + 3] = bf_hi(w.y);
        x[8 * i + 4] = bf_lo(w.z); x[8 * i + 5] = bf_hi(w.z); x[8 * i + 6] = bf_lo(w.w); x[8 * i + 7] = bf_hi(w.w); }
    float ss = 0.f;
#pragma unroll
    for (int i = 0; i < HD; ++i) ss += x[i] * x[i];
    const float r = rsqrtf(ss * (1.f / HD) + EPS);
#pragma unroll
    for (int i = 0; i < HD; ++i) x[i] = x[i] * r * gain[i];
    if (pos >= 0) {
        constexpr int Q = HD / 4; const int row = pos >> 6, col = pos & 63;
#pragma unroll
        for (int i = 0; i < Q; ++i) {
            const f32x2 cr = rt[row * Q + i], cc = rt[col * Q + i];
            const float a = x[i], b = x[i + Q]; x[i] = a * cr[0] - b * cr[1]; x[i + Q] = b * cr[0] + a * cr[1];
            const float c = x[2 * Q + i], d = x[3 * Q + i]; x[2 * Q + i] = c * cc[0] - d * cc[1]; x[3 * Q + i] = d * cc[0] + c * cc[1];
        }
    }
#pragma unroll
    for (int i = 0; i < HD / 8; ++i) { u32x4 w; w.x = cvt_pk(x[8 * i] * post, x[8 * i + 1] * post); w.y = cvt_pk(x[8 * i + 2] * post, x[8 * i + 3] * post);
        w.z = cvt_pk(x[8 * i + 4] * post, x[8 * i + 5] * post); w.w = cvt_pk(x[8 * i + 6] * post, x[8 * i + 7] * post); *(u32x4*)(po + 8 * i) = w; }
}

template <bool gdn_only = false, bool dry = false>
__device__ __forceinline__ void p_prep(const Frame& F, int l) {
    bf16_t* dummy = (bf16_t*)(F.ar + A_CH);
    const int gt = F.blk * 512 + F.tid, NT = GRID * 512;
    const f32x2* rope = (const f32x2*)(F.ws + WS_ROPE);
    if (!gdn_only) for (int idx = gt; idx < NR * 8; idx += NT) {
        const int R = idx >> 3, grp = idx & 7, p = R % TPB; const int pos = (p < CTXL) ? -1 : p - CTXL;
        qk_norm_rope<32>(ptile(F, T_AK) + (size_t)R * 256 + grp * 32, F.in[I_DAKG] + l * 32, 1.f, pos, rope, dry ? dummy + (size_t)R * 256 + grp * 32 : nullptr);
    }
    if (!gdn_only) for (int idx = gt; idx < NR * 2; idx += NT) {
        const int R = idx >> 1, grp = idx & 1, p = R % TPB; const int pos = (p < CTXL) ? -1 : p - CTXL;
        qk_norm_rope<64>(ptile(F, T_GKV) + (size_t)R * 256 + grp * 64, F.in[I_GAKG] + l * 64, 1.f, pos, rope + 512, dry ? dummy + (size_t)R * 256 + grp * 64 : nullptr);
    }
    if (dry) return;
    const int gw = F.blk * 8 + F.wave, NGW = GRID * 8;
    bf16_t* Gq = (bf16_t*)(F.ar + A_H); bf16_t* Gk = Gq + (size_t)NR * 256; bf16_t* Gv = Gk + (size_t)NR * 256;
    float* GB = (float*)(F.ws + WS_GB);
    const float* cw = F.in[I_CONVW] + (size_t)l * 5 * 768;
    const int c = F.lane * 4;
    f32x4 cwv[5][3];
#pragma unroll
    for (int j = 0; j < 5; ++j)
#pragma unroll
        for (int part = 0; part < 3; ++part) cwv[j][part] = *(const f32x4*)(cw + j * 768 + part * 256 + c);
    const f32x4 vg = *(const f32x4*)(F.in[I_GMVG] + l * 256 + c);
    for (int G4 = gw; G4 < NR / 4; G4 += NGW) {
        const int R0 = G4 * 4, p0 = R0 % TPB, Rb = R0 - p0;
        const int lo = (p0 < CTXL) ? 0 : CTXL, hi = (p0 < CTXL) ? CTXL : TPB;
        u32x2 win[8][3];
#pragma unroll
        for (int w = 0; w < 8; ++w) { const int pp = p0 - 2 + w; const int pc = pp < lo ? lo : (pp >= hi ? hi - 1 : pp);
#pragma unroll
            for (int part = 0; part < 3; ++part) win[w][part] = *(const u32x2*)(ptile(F, T_DQ + part) + (size_t)(Rb + pc) * 256 + c); }
        u32x2 vw[4];
        if (!gdn_only) {
#pragma unroll
            for (int r = 0; r < 4; ++r) vw[r] = *(const u32x2*)(ptile(F, T_MV) + (size_t)(R0 + r) * 256 + c);
        }
        float ab; { const int rr = F.lane >> 4, cc = F.lane & 15; ab = bf2f(ptile(F, T_DAB)[(size_t)(R0 + rr) * 256 + cc]); }
#pragma unroll
        for (int w = 0; w < 8; ++w) { const int pp = p0 - 2 + w; if (pp < lo || pp >= hi) {
#pragma unroll
            for (int part = 0; part < 3; ++part) win[w][part] = (u32x2){0u, 0u}; } }
        if (!gdn_only) {
#pragma unroll
            for (int r = 0; r < 4; ++r) {
                const float v0 = gelu_erf(bf_lo(vw[r].x)), v1 = gelu_erf(bf_hi(vw[r].x)), v2 = gelu_erf(bf_lo(vw[r].y)), v3 = gelu_erf(bf_hi(vw[r].y));
                const float rs = rsqrtf(wave_sum((v0 * v0 + v1 * v1) + (v2 * v2 + v3 * v3)) * (1.f / 256.f) + EPS);
                u32x2 o; o.x = cvt_pk(v0 * rs * vg[0], v1 * rs * vg[1]); o.y = cvt_pk(v2 * rs * vg[2], v3 * rs * vg[3]); *(u32x2*)(ptile(F, T_MV) + (size_t)(R0 + r) * 256 + c) = o;
            }
        }
#pragma unroll
        for (int r = 0; r < 4; ++r) {
            float y[3][4];
#pragma unroll
            for (int part = 0; part < 3; ++part) {
                f32x4 a = (f32x4){0.f, 0.f, 0.f, 0.f};
#pragma unroll
                for (int j = 0; j < 5; ++j) { const u32x2 w = win[r + j][part]; a += (f32x4){bf_lo(w.x), bf_hi(w.x), bf_lo(w.y), bf_hi(w.y)} * cwv[j][part]; }
#pragma unroll
                for (int i = 0; i < 4; ++i) y[part][i] = siluf_(a[i]);
            }
            float sq = (y[0][0] * y[0][0] + y[0][1] * y[0][1]) + (y[0][2] * y[0][2] + y[0][3] * y[0][3]);
            float sk = (y[1][0] * y[1][0] + y[1][1] * y[1][1]) + (y[1][2] * y[1][2] + y[1][3] * y[1][3]);
            sq = sum16(sq); sk = sum16(sk);
            const float rq = rsqrtf(sq + EPS) * 0.125f, rk = rsqrtf(sk + EPS);
            const size_t off = (size_t)(R0 + r) * 256 + c;
            u32x2 o; o.x = cvt_pk(y[0][0] * rq, y[0][1] * rq); o.y = cvt_pk(y[0][2] * rq, y[0][3] * rq); *(u32x2*)(Gq + off) = o;
            o.x = cvt_pk(y[1][0] * rk, y[1][1] * rk); o.y = cvt_pk(y[1][2] * rk, y[1][3] * rk); *(u32x2*)(Gk + off) = o;
            o.x = cvt_pk(y[2][0], y[2][1]); o.y = cvt_pk(y[2][2], y[2][3]); *(u32x2*)(Gv + off) = o;
        }
        {
            const int rr = F.lane >> 4, cc = F.lane & 15;
            float r;
            if (cc < 8) { const float xx = ab + F.in[I_DTB][l * 8 + cc]; const float ex = __expf(fminf(xx, 20.f)); const float sp = (xx > 20.f) ? xx : ((xx < -4.f) ? ex * (1.f - ex * (0.5f - ex * (1.f / 3.f))) : __logf(1.f + ex)); r = -__expf(F.in[I_ALOG][l * 8 + cc]) * sp; }
            else r = sigmoidf_(ab);
            GB[(size_t)(R0 + rr) * 16 + cc] = r;
        }
    }
}
__device__ __forceinline__ s16x4 tr_read(const LAS unsigned char* p) { return __builtin_bit_cast(s16x4, __builtin_amdgcn_ds_read_tr16_b64_v4i16((LAS v4i16_t*)p)); }
__device__ __forceinline__ bf16x8 cat8(const s16x4 lo, const s16x4 hi) { return (bf16x8){lo[0], lo[1], lo[2], lo[3], hi[0], hi[1], hi[2], hi[3]}; }
#define MFMA32(a, b, c) __builtin_amdgcn_mfma_f32_32x32x16_bf16((a), (b), (c), 0, 0, 0)
#define MFMA16(a, b, c) __builtin_amdgcn_mfma_f32_16x16x32_bf16((a), (b), (c), 0, 0, 0)
constexpr int KP = 144, VP = 192;
constexpr int ATT_KT = 64;
constexpr int ATT_K_OFF = 0, ATT_V_OFF = ATT_KT * KP;

template <int HD>
__device__ __forceinline__ void q_prep(bf16x8 (&qf)[HD / 16], const bf16_t* qrow, const float* gain, float post, int pos, const f32x2* rt, int h2) {
    constexpr int NKS = HD / 16, Q = HD / 4;
    float x[NKS][8];
#pragma unroll
    for (int ks = 0; ks < NKS; ++ks) { const u32x4 w = *(const u32x4*)(qrow + 16 * ks + 8 * h2);
        x[ks][0] = bf_lo(w.x); x[ks][1] = bf_hi(w.x); x[ks][2] = bf_lo(w.y); x[ks][3] = bf_hi(w.y); x[ks][4] = bf_lo(w.z); x[ks][5] = bf_hi(w.z); x[ks][6] = bf_lo(w.w); x[ks][7] = bf_hi(w.w); }
    float ss = 0.f;
#pragma unroll
    for (int ks = 0; ks < NKS; ++ks)
#pragma unroll
        for (int j = 0; j < 8; ++j) ss += x[ks][j] * x[ks][j];
    const float rr = rsqrtf(add_xor32(ss) * (1.f / HD) + EPS);
#pragma unroll
    for (int ks = 0; ks < NKS; ++ks) { const f32x4 g0 = *(const f32x4*)(gain + 16 * ks + 8 * h2), g1 = *(const f32x4*)(gain + 16 * ks + 8 * h2 + 4);
#pragma unroll
        for (int j = 0; j < 4; ++j) { x[ks][j] *= rr * g0[j]; x[ks][4 + j] *= rr * g1[j]; } }
    if (pos >= 0) {
        const int row = pos >> 6, col = pos & 63;
        if (HD == 64) {
#pragma unroll
            for (int j = 0; j < 8; ++j) {
                const f32x2 cr = rt[row * Q + 8 * h2 + j], cc = rt[col * Q + 8 * h2 + j];
                const float a = x[0][j], b = x[1][j]; x[0][j] = a * cr[0] - b * cr[1]; x[1][j] = b * cr[0] + a * cr[1];
                const float c = x[NKS - 2][j], d = x[NKS - 1][j]; x[NKS - 2][j] = c * cc[0] - d * cc[1]; x[NKS - 1][j] = d * cc[0] + c * cc[1];
            }
        } else {
#pragma unroll
            for (int j = 0; j < 8; ++j) {
                const f32x2 cr = rt[row * Q + j], cc = rt[col * Q + j];
                const auto s0 = __builtin_amdgcn_permlane32_swap(__float_as_uint(x[0][j]), __float_as_uint(x[0][j]), false, false);
                const auto s1 = __builtin_amdgcn_permlane32_swap(__float_as_uint(x[1][j]), __float_as_uint(x[1][j]), false, false);
                const float pa = __uint_as_float(h2 ? s0[0] : s0[1]), pc = __uint_as_float(h2 ? s1[0] : s1[1]);
                x[0][j] = h2 ? (x[0][j] * cr[0] + pa * cr[1]) : (x[0][j] * cr[0] - pa * cr[1]);
                x[1][j] = h2 ? (x[1][j] * cc[0] + pc * cc[1]) : (x[1][j] * cc[0] - pc * cc[1]);
            }
        }
    }
#pragma unroll
    for (int ks = 0; ks < NKS; ++ks) { u32x4 w; w.x = cvt_pk(x[ks][0] * post, x[ks][1] * post); w.y = cvt_pk(x[ks][2] * post, x[ks][3] * post); w.z = cvt_pk(x[ks][4] * post, x[ks][5] * post); w.w = cvt_pk(x[ks][6] * post, x[ks][7] * post);
        qf[ks] = __builtin_bit_cast(bf16x8, w); }
}

template <int HD, int NMAP, bool DIFF>
__device__ __forceinline__ void attn_unit(const Frame& F, const bf16_t* Qb, int qcol, const bf16_t* Kb, int kcol, const bf16_t* Vb, int vcol, bf16_t* Ob, int ocol,
                                          int b, int qt, float lam, float fin_scale, const float* subg, const float* qgain, float qpost, const f32x2* qrt) {
    const int lane = F.lane, r = lane & 31, h2 = lane >> 5, x = lane & 15, g1 = (lane >> 4) & 1;
    const size_t R0 = (size_t)b * TPB + (size_t)qt * 256 + F.wave * 32;
    const int nkt = (qt == 0) ? 256 / ATT_KT : 4352 / ATT_KT;
    constexpr int NKS = HD / 16;
    bf16x8 qf[NMAP][NKS];
    { const int qpos = (qt == 0) ? -1 : (qt - 1) * 256 + F.wave * 32 + r;
#pragma unroll
      for (int m = 0; m < NMAP; ++m) q_prep<HD>(qf[m], Qb + (R0 + r) * 256 + qcol + m * HD, qgain, qpost, qpos, qrt, h2); }
    f32x16 O[NMAP][2]; f32x4 lacc[NMAP];
    bf16x8 onesA; { const int mrow = lane & 15, kg = lane >> 4; const unsigned o = ((mrow == 0 && (kg & 1) == 0) || (mrow == 1 && (kg & 1) == 1)) ? 0x3f803f80u : 0u; onesA = __builtin_bit_cast(bf16x8, (u32x4){o, o, o, o}); }
#pragma unroll
    for (int m = 0; m < NMAP; ++m) { lacc[m] = (f32x4){0.f, 0.f, 0.f, 0.f};
#pragma unroll
        for (int d = 0; d < 2; ++d)
#pragma unroll
            for (int i = 0; i < 16; ++i) O[m][d][i] = 0.f; }
    constexpr int ATT_BUF = ATT_KT * KP + ATT_KT * VP;
    constexpr int NST = ATT_KT / 64;
    const int skey = F.tid >> 3, sseg = F.tid & 7;
    const bf16_t* kg = Kb + ((size_t)b * TPB + skey) * 256 + kcol + sseg * 8;
    const bf16_t* vg = Vb + ((size_t)b * TPB + skey) * 256 + vcol + sseg * 8;
    u32x4 kreg[NST], vreg[NST];
#pragma unroll
    for (int i = 0; i < NST; ++i) { kreg[i] = *(const u32x4*)(kg + (size_t)(64 * i) * 256); vreg[i] = *(const u32x4*)(vg + (size_t)(64 * i) * 256); }
    __syncthreads();
#pragma unroll
    for (int i = 0; i < NST; ++i) { *(LAS u32x4*)(F.lds + ATT_K_OFF + (skey + 64 * i) * KP + sseg * 16) = kreg[i]; *(LAS u32x4*)(F.lds + ATT_V_OFF + (skey + 64 * i) * VP + sseg * 16) = vreg[i]; }
    __syncthreads();
    if (F.wave >= 4) __builtin_amdgcn_s_setprio(1);
    for (int kt = 0; kt < nkt; ++kt) {
        LAS unsigned char* Ks = F.lds + (kt & 1) * ATT_BUF + ATT_K_OFF; LAS unsigned char* Vs = F.lds + (kt & 1) * ATT_BUF + ATT_V_OFF;
        if (kt + 1 < nkt) {
#pragma unroll
            for (int i = 0; i < NST; ++i) { kreg[i] = *(const u32x4*)(kg + (size_t)((kt + 1) * ATT_KT + 64 * i) * 256); vreg[i] = *(const u32x4*)(vg + (size_t)((kt + 1) * ATT_KT + 64 * i) * 256); } }
#pragma unroll
        for (int grp = 0; grp < ATT_KT / 32; ++grp) {
            f32x16 S[2];
            constexpr int NKF = (NMAP == 2 && !DIFF) ? 1 : 2;
            bf16x8 kfr[NKF][NKS];
#pragma unroll
            for (int t = 0; t < NKF; ++t) {
                const int kb = (NMAP == 2) ? grp : t, m = (NMAP == 2) ? t : 0;
#pragma unroll
                for (int ks = 0; ks < NKS; ++ks) kfr[t][ks] = *(const LAS bf16x8*)(Ks + (kb * 32 + r) * KP + ((DIFF ? m * HD : 0) + 16 * ks + 8 * h2) * 2);
            }
#pragma unroll
            for (int t = 0; t < NKF; ++t)
#pragma unroll
                for (int ks = 0; ks < NKS; ++ks) { asm volatile("" : "+v"(kfr[t][ks])); }
#pragma unroll
            for (int t = 0; t < 2; ++t) {
                const int m = (NMAP == 2) ? t : 0;
                const f32x16 half16 = {0.5f, 0.5f, 0.5f, 0.5f, 0.5f, 0.5f, 0.5f, 0.5f, 0.5f, 0.5f, 0.5f, 0.5f, 0.5f, 0.5f, 0.5f, 0.5f};
                S[t] = MFMA32(kfr[t % NKF][0], qf[m][0], half16);
#pragma unroll
                for (int ks = 1; ks < NKS; ++ks) S[t] = MFMA32(kfr[t % NKF][ks], qf[m][ks], S[t]);
            }
            bf16x8 vf[(NMAP == 2) ? 1 : 2][2][2];
#pragma unroll
            for (int t = 0; t < ((NMAP == 2) ? 1 : 2); ++t) {
                const int kb = (NMAP == 2) ? grp : t;
#pragma unroll
                for (int d = 0; d < 2; ++d)
#pragma unroll
                    for (int s2 = 0; s2 < 2; ++s2) {
                        const LAS unsigned char* vp = Vs + (kb * 32 + 16 * s2 + 4 * h2 + (x >> 2)) * VP + (32 * d + 16 * g1 + 4 * (x & 3)) * 2;
                        vf[t][d][s2] = cat8(tr_read(vp), tr_read(vp + 8 * VP));
                    }
            }
#pragma unroll
            for (int t = 0; t < 2; ++t) {
                const int m = (NMAP == 2) ? t : 0, vt = (NMAP == 2) ? 0 : t;
                bf16x8 pb[2];
#pragma unroll
                for (int s2 = 0; s2 < 2; ++s2) {
                    unsigned w[4];
#pragma unroll
                    for (int j = 0; j < 4; ++j) w[j] = __builtin_bit_cast(unsigned, __builtin_amdgcn_cvt_pknorm_i16(S[t][8 * s2 + 2 * j], S[t][8 * s2 + 2 * j + 1]));
                    pb[s2] = __builtin_bit_cast(bf16x8, (u32x4){w[0], w[1], w[2], w[3]});
                    lacc[m] = MFMA16(onesA, pb[s2], lacc[m]);
                }
#pragma unroll
                for (int d = 0; d < 2; ++d)
#pragma unroll
                    for (int s2 = 0; s2 < 2; ++s2) O[m][d] = MFMA32(vf[vt][d][s2], pb[s2], O[m][d]);
            }
        }
        if (kt + 1 < nkt) { LAS unsigned char* nb = F.lds + ((kt + 1) & 1) * ATT_BUF;
#pragma unroll
            for (int i = 0; i < NST; ++i) { *(LAS u32x4*)(nb + ATT_K_OFF + (skey + 64 * i) * KP + sseg * 16) = kreg[i]; *(LAS u32x4*)(nb + ATT_V_OFF + (skey + 64 * i) * VP + sseg * 16) = vreg[i]; } }
        __syncthreads();
    }
    __builtin_amdgcn_s_setprio(0);
    float inv[NMAP];
#pragma unroll
    for (int m = 0; m < NMAP; ++m) {
        const float s0 = __int_as_float(__builtin_amdgcn_ds_bpermute((lane & 15) << 2, __float_as_int(lacc[m][0]))), s1 = __int_as_float(__builtin_amdgcn_ds_bpermute((lane & 15) << 2, __float_as_int(lacc[m][1])));
        inv[m] = 1.f / ((r < 16) ? s0 : s1); }
    bf16_t* op = Ob + (R0 + r) * 256 + ocol;
    if (DIFF) {
        float ss = 0.f;
#pragma unroll
        for (int d = 0; d < 2; ++d)
#pragma unroll
            for (int i = 0; i < 16; ++i) { const float v = O[0][d][i] * inv[0] - lam * (O[NMAP - 1][d][i] * inv[NMAP - 1]); O[0][d][i] = v; ss += v * v; }
        ss = add_xor32(ss);
        const float rr = rsqrtf(ss * (1.f / 64.f) + EPS) * fin_scale;
#pragma unroll
        for (int d = 0; d < 2; ++d)
#pragma unroll
            for (int g4 = 0; g4 < 4; ++g4) { const int dv0 = 32 * d + 8 * g4 + 4 * h2; const f32x4 sg = *(const f32x4*)(subg + dv0);
                u32x2 o; o.x = cvt_pk(O[0][d][4 * g4] * rr * sg[0], O[0][d][4 * g4 + 1] * rr * sg[1]); o.y = cvt_pk(O[0][d][4 * g4 + 2] * rr * sg[2], O[0][d][4 * g4 + 3] * rr * sg[3]);
                *(u32x2*)(op + dv0) = o; }
    } else {
#pragma unroll
        for (int m = 0; m < NMAP; ++m)
#pragma unroll
            for (int d = 0; d < 2; ++d)
#pragma unroll
                for (int g4 = 0; g4 < 4; ++g4) { const int dv0 = 32 * d + 8 * g4 + 4 * h2;
                    u32x2 o; o.x = cvt_pk(O[m][d][4 * g4] * inv[m], O[m][d][4 * g4 + 1] * inv[m]); o.y = cvt_pk(O[m][d][4 * g4 + 2] * inv[m], O[m][d][4 * g4 + 3] * inv[m]);
                    *(u32x2*)(op + m * HD + dv0) = o; }
    }
}

__device__ __forceinline__ void gmlp_unit(const Frame& F, int l, int b, int chunk, int g, bf16_t* dry = nullptr) {
    const int lane = F.lane, r = lane & 31, h2 = lane >> 5, x = lane & 15, g1 = (lane >> 4) & 1;
    const size_t R0 = (size_t)b * TPB + (size_t)chunk * 128;
    LAS unsigned char* Vs = F.lds;
    const bf16_t* vsrc = ptile(F, T_MV) + R0 * 256 + g * 64;
    __syncthreads();
#pragma unroll
    for (int i = 0; i < 2; ++i) { const int pc = F.tid + i * 512, q = pc >> 3, seg = pc & 7; *(LAS u32x4*)(Vs + q * VP + seg * 16) = *(const u32x4*)(vsrc + (size_t)q * 256 + seg * 8); }
    __syncthreads();
    const int cb = F.wave & 1, pb = F.wave >> 1;
    const bf16_t* ws = (const bf16_t*)(F.ws + WS_GMWS) + ((size_t)(l * 4 + g) * 128 + pb * 32 + r) * 128 + 8 * h2;
    f32x16 acc;
#pragma unroll
    for (int i = 0; i < 16; ++i) acc[i] = 0.f;
#pragma unroll
    for (int ks = 0; ks < 8; ++ks) {
        const LAS unsigned char* vp = Vs + (16 * ks + 8 * h2 + (x >> 2)) * VP + (32 * cb + 16 * g1 + 4 * (x & 3)) * 2;
        const bf16x8 af = cat8(tr_read(vp), tr_read(vp + 4 * VP));
        const bf16x8 bfr = *(const bf16x8*)(ws + 16 * ks);
        acc = MFMA32(af, bfr, acc);
    }
    const int pp = pb * 32 + r; const float bs = F.in[I_GMBS][(l * 4 + g) * 128 + pp];
    bf16_t* up = ptile(F, T_MU) + (R0 + pp) * 256 + g * 64 + cb * 32;
#pragma unroll
    for (int g4 = 0; g4 < 4; ++g4) { const int c0 = 8 * g4 + 4 * h2; const u32x2 uw = *(const u32x2*)(up + c0);
        u32x2 o; o.x = cvt_pk(gelu_erf(bf_lo(uw.x)) * (acc[4 * g4] + bs), gelu_erf(bf_hi(uw.x)) * (acc[4 * g4 + 1] + bs)); o.y = cvt_pk(gelu_erf(bf_lo(uw.y)) * (acc[4 * g4 + 2] + bs), gelu_erf(bf_hi(uw.y)) * (acc[4 * g4 + 3] + bs));
        *(u32x2*)((dry ? dry + (R0 + pp) * 256 + g * 64 + cb * 32 : up) + c0) = o; }
}
__device__ __forceinline__ int chunk_p(int dir, int n, int i) { const int f = 64 * n + i; return dir == 0 ? f : (n < 4 ? 255 - f : 4351 + 256 - f); }
__device__ __forceinline__ int crow16(int i, int h2) { return (i & 3) + 8 * (i >> 2) + 4 * h2; }
__device__ __forceinline__ int img_idx(int row, int k) { const int kk = k & 31; return (((row >> 4) * 2 + (k >> 5)) * 64 + ((kk >> 2) & 3) * 16 + (row & 15)) * 8 + 4 * (kk >> 4) + (kk & 3); }
constexpr int CH_NW = 0, CH_QD = 8192, CH_QK = 16384, CH_KDT = 24576, CH_U = 32768;

constexpr int CHS_BYTES = 33792;
__device__ __forceinline__ void gdn_chunk_phase(const Frame& F) {
    const int slot = F.wave >> 1, ws2 = F.wave & 1;
    LAS float* Am = (LAS float*)(F.lds + slot * CHS_BYTES); LAS float* gcv = Am + 4096; LAS float* btv = gcv + 64; LAS float* egv = btv + 64; LAS float* dkv = egv + 64;
    LAS bf16_t* kvt = (LAS bf16_t*)(F.lds + slot * CHS_BYTES + 17408);
    const bf16_t* Gq = (const bf16_t*)(F.ar + A_H); const bf16_t* Gk = Gq + (size_t)NR * 256; const bf16_t* Gv = Gk + (size_t)NR * 256;
    const float* GB = (const float*)(F.ws + WS_GB);
    float* CHG = (float*)(F.ws + WS_CHG);
    for (int it0 = F.blk * 4; it0 < 8704; it0 += GRID * 4) {
        int tq = F.tid; asm volatile("" : "+v"(tq));
        const int t2 = tq & 127, lane = tq & 63, r = lane & 31, h2 = lane >> 5;
        const int idx = it0 + slot, dir = idx & 1, rest = idx >> 1, m = rest % 68, h = (rest / 68) & 3, b = rest / 272;
        const int n = dir ? ((m < 4) ? 3 - m : 71 - m) : m; const int item = dir * 4352 + b * 272 + h * 68 + n;
        unsigned char* chp = F.ar + A_CH + (size_t)item * CH_ITEM;
        const size_t Rb = (size_t)b * TPB;
        __syncthreads();
        u32x4 stg[8];
#pragma unroll
        for (int j = 0; j < 8; ++j) { const int pc = t2 + 128 * j, i = pc >> 4, seg = pc & 15;
            stg[j] = *(const u32x4*)(((seg < 8) ? Gk : Gv) + (Rb + chunk_p(dir, n, i)) * 256 + 64 * h + (seg & 7) * 8); }
        bf16x8 qfr[2][4];
#pragma unroll
        for (int tI = 0; tI < 2; ++tI)
#pragma unroll
            for (int ks = 0; ks < 4; ++ks) qfr[tI][ks] = *(const bf16x8*)(Gq + (Rb + chunk_p(dir, n, 32 * tI + r)) * 256 + 64 * h + 8 * h2 + 16 * ks);
#pragma unroll
        for (int j = 0; j < 8; ++j) { const int pc = t2 + 128 * j, i = pc >> 4, seg = pc & 15; *(LAS u32x4*)(kvt + i * 128 + seg * 8) = stg[j]; }
        if (ws2 == 0) {
            const size_t R = Rb + chunk_p(dir, n, lane);
            float g = GB[R * 16 + dir * 4 + h]; const float bt = GB[R * 16 + 8 + dir * 4 + h];
#pragma unroll
            for (int o = 1; o < 64; o <<= 1) { const float t = __int_as_float(__builtin_amdgcn_ds_bpermute(((lane - o) & 63) << 2, __float_as_int(g))); if (lane >= o) g += t; }
            const float gl = __int_as_float(__builtin_amdgcn_readlane(__float_as_int(g), 63));
            gcv[lane] = g; btv[lane] = bt; egv[lane] = __expf(g); dkv[lane] = __expf(gl - g);
            if (lane == 0) CHG[item] = __expf(gl);
        }
        __syncthreads();
        u32x2 qpa[4], qpb[4];
#pragma unroll
        for (int t = 0; t < 4; ++t) { const int pidx = t2 + 128 * t, lp = pidx & 63, q4 = lp >> 4, row = lp & 15, rs = pidx >> 6, rb = rs >> 1, s2 = rs & 1;
            const bf16_t* qp = Gq + (Rb + chunk_p(dir, n, 16 * rb + row)) * 256 + 64 * h + 32 * s2 + 4 * q4;
            qpa[t] = *(const u32x2*)qp; qpb[t] = *(const u32x2*)(qp + 16); }
        if (ws2 == 0) {
#pragma unroll
            for (int tI = 0; tI < 2; ++tI)
#pragma unroll
                for (int tJ = 0; tJ <= tI; ++tJ) {
                    f32x16 acc;
#pragma unroll
                    for (int i = 0; i < 16; ++i) acc[i] = 0.f;
#pragma unroll
                    for (int ks = 0; ks < 4; ++ks) {
                        const bf16x8 af = *(const LAS bf16x8*)(kvt + (32 * tI + r) * 128 + 16 * ks + 8 * h2);
                        const bf16x8 bf = *(const LAS bf16x8*)(kvt + (32 * tJ + r) * 128 + 16 * ks + 8 * h2);
                        acc = MFMA32(af, bf, acc);
                    }
                    const int j = 32 * tJ + r; const float gj = gcv[j];
                    LAS float* ab = Am + (4 * h2) * 64 + j; const LAS float* gb = gcv + 4 * h2; const int dj = 4 * h2 - j;
#pragma unroll
                    for (int i = 0; i < 16; ++i) { const int io = 32 * tI + (i & 3) + 8 * (i >> 2);
                        const float val = gb[64 + io] * acc[i] * __expf(fminf(gb[io] - gj, 0.f));
                        ab[io * 64] = (io + dj > 0) ? val : 0.f; }
                }
        } else {
#pragma unroll
            for (int tJ = 0; tJ < 2; ++tJ)
#pragma unroll
                for (int tI = 0; tI < 2; ++tI) {
                    f32x16 acc;
#pragma unroll
                    for (int i = 0; i < 16; ++i) acc[i] = 0.f;
                    if (tJ <= tI) {
#pragma unroll
                        for (int ks = 0; ks < 4; ++ks) {
                            const bf16x8 af = *(const LAS bf16x8*)(kvt + (32 * tJ + r) * 128 + 16 * ks + 8 * h2);
                            acc = MFMA32(af, qfr[tI][ks], acc);
                        }
                    }
                    const int i = 32 * tI + r; const float gi = gcv[i];
                    const LAS float* gb = gcv + 4 * h2; const int di = i - 4 * h2;
                    unsigned char* qkp = chp + CH_QK + 2 * img_idx(i, 4 * h2);
#pragma unroll
                    for (int g4 = 0; g4 < 4; ++g4) {
                        float v[4];
#pragma unroll
                        for (int e = 0; e < 4; ++e) { const int jo = 32 * tJ + 8 * g4 + e; const float val = acc[4 * g4 + e] * __expf(fminf(gi - gb[jo], 0.f)); v[e] = (di >= jo) ? val : 0.f; }
                        u32x2 o; o.x = cvt_pk(v[0], v[1]); o.y = cvt_pk(v[2], v[3]);
                        *(u32x2*)(qkp + (tJ * 64 + ((2 * g4) & 3) * 16) * 16 + 8 * (g4 >> 1)) = o;
                    }
                }
        }
        __syncthreads();
        {
#pragma unroll
            for (int t = 0; t < 4; ++t) {
                const int pidx = t2 + 128 * t, lp = pidx & 63, q4 = lp >> 4, row = lp & 15, rs = pidx >> 6, rb = rs >> 1, s2 = rs & 1;
                const int i = 16 * rb + row, kdA = 32 * s2 + 4 * q4;
                const u32x2 qa = qpa[t], qb = qpb[t];
                const float eg = egv[i];
                u32x4 o; o.x = cvt_pk(bf_lo(qa.x) * eg, bf_hi(qa.x) * eg); o.y = cvt_pk(bf_lo(qa.y) * eg, bf_hi(qa.y) * eg); o.z = cvt_pk(bf_lo(qb.x) * eg, bf_hi(qb.x) * eg); o.w = cvt_pk(bf_lo(qb.y) * eg, bf_hi(qb.y) * eg);
                *(u32x4*)(chp + CH_QD + pidx * 16) = o;
                const int kd = i, cA = kdA;
                float kv[8];
#pragma unroll
                for (int e = 0; e < 8; ++e) { const int cc = cA + 16 * (e >> 2) + (e & 3); kv[e] = bf2f(kvt[cc * 128 + kd]) * dkv[cc]; }
                o.x = cvt_pk(kv[0], kv[1]); o.y = cvt_pk(kv[2], kv[3]); o.z = cvt_pk(kv[4], kv[5]); o.w = cvt_pk(kv[6], kv[7]);
                *(u32x4*)(chp + CH_KDT + pidx * 16) = o;
            }
        }
        {
            const int c = t2; const bool isw = c < 64;
            float X[64];
#pragma unroll
            for (int i = 0; i < 64; ++i) { const float val = bf2f(kvt[i * 128 + c]); X[i] = val * btv[i] * (isw ? egv[i] : 1.f); }
            __syncthreads();
            f32x4 ra[2][16];
#pragma unroll
            for (int q = 0; q < 1; ++q) ra[1][q] = *(const LAS f32x4*)(Am + 1 * 64 + 4 * q);
#pragma unroll
            for (int i = 1; i < 64; ++i) {
                if (i + 1 < 64) {
#pragma unroll
                    for (int q = 0; q < (i + 4) / 4; ++q) ra[(i + 1) & 1][q] = *(const LAS f32x4*)(Am + (i + 1) * 64 + 4 * q);
                }
#pragma unroll
                for (int q = 0; q < (i + 3) / 4; ++q) asm volatile("" : "+v"(ra[i & 1][q]));
                float s0 = X[i], s1 = 0.f;
#pragma unroll
                for (int j = 0; j < i; ++j) { if (j & 1) s1 -= ra[i & 1][j >> 2][j & 3] * X[j]; else s0 -= ra[i & 1][j >> 2][j & 3] * X[j]; }
                X[i] = s0 + s1;
            }
#pragma unroll
            for (int i = 0; i < 64; ++i) kvt[i * 128 + c] = f2bf(X[i]);
        }
        __syncthreads();
        {
#pragma unroll
            for (int t = 0; t < 4; ++t) {
                const int pidx = t2 + 128 * t, lp = pidx & 63, q4 = lp >> 4, row = lp & 15, rs = pidx >> 6, rb = rs >> 1, s2 = rs & 1;
                const int i = 16 * rb + row, kdA = 32 * s2 + 4 * q4;
                const u32x2 wa = *(const LAS u32x2*)(kvt + i * 128 + kdA), wb = *(const LAS u32x2*)(kvt + i * 128 + kdA + 16);
                u32x4 o; o.x = wa.x ^ 0x80008000u; o.y = wa.y ^ 0x80008000u; o.z = wb.x ^ 0x80008000u; o.w = wb.y ^ 0x80008000u;
                *(u32x4*)(chp + CH_NW + pidx * 16) = o;
            }
#pragma unroll
            for (int t = 0; t < 2; ++t) {
                const int pidx = t2 + 128 * t, sl = pidx >> 6, lp = pidx & 63, q4 = lp >> 4, vcol = 64 + 16 * sl + (lp & 15);
                unsigned w[8];
#pragma unroll
                for (int e = 0; e < 8; ++e) { const int i0 = 16 * (e >> 1) + 4 * q4 + 2 * (e & 1); w[e] = (unsigned)kvt[i0 * 128 + vcol] | ((unsigned)kvt[(i0 + 1) * 128 + vcol] << 16); }
                *(u32x4*)(chp + CH_U + pidx * 32) = (u32x4){w[0], w[1], w[2], w[3]}; *(u32x4*)(chp + CH_U + pidx * 32 + 16) = (u32x4){w[4], w[5], w[6], w[7]};
            }
        }
    }
}

__device__ __forceinline__ void gdn_scan_phase(const Frame& F, int l) {
    constexpr bool do_finish = true;
    const int lane = F.lane, q = lane >> 4, dir = F.wave >> 2, sl = F.wave & 3;
    const float* CHG = (const float*)(F.ws + WS_CHG);
    bf16_t* Ob0 = ptile(F, T_DQ); bf16_t* Ob1 = ptile(F, T_DK);
    for (int bh = F.blk; bh < 64; bh += GRID) {
        const int b = bh >> 2, h = bh & 3;
        const int item0d0 = ((0 * 16 + b) * 4 + h) * 68, item0d1 = ((1 * 16 + b) * 4 + h) * 68;
        const int item0 = dir ? item0d1 : item0d0;
        f32x4 S[4];
#pragma unroll
        for (int kb = 0; kb < 4; ++kb) S[kb] = (f32x4){0.f, 0.f, 0.f, 0.f};
        __syncthreads();
#define GDN_ISSUE(n_) do { _Pragma("unroll") for (int i_ = 0; i_ < 8; ++i_) { const int pc_ = F.wave * 8 + i_, d_ = pc_ >> 5, off_ = (pc_ & 31) * 1024; \
                const unsigned char* src_ = F.ar + A_CH + (size_t)((d_ ? item0d1 : item0d0) + (n_)) * CH_ITEM + off_ + lane * 16; \
                __builtin_amdgcn_global_load_lds((const unsigned*)src_, (LAS unsigned*)(F.lds + ((n_) & 1) * 65536 + d_ * 32768 + off_), 16, 0, 0); } } while (0)
        GDN_ISSUE(0);
        bf16_t* Ob = dir ? Ob1 : Ob0;
        for (int n = 0; n < 68; ++n) {
            const unsigned char* chp = F.ar + A_CH + (size_t)(item0 + n) * CH_ITEM;
            const u32x4 u0 = *(const u32x4*)(chp + CH_U + (sl * 64 + lane) * 32), u1 = *(const u32x4*)(chp + CH_U + (sl * 64 + lane) * 32 + 16);
            const float gl = CHG[item0 + n];
            VM_WAIT();
            __syncthreads();
            if (n + 1 < 68) GDN_ISSUE(n + 1);
            const LAS unsigned char* base = F.lds + (n & 1) * 65536 + dir * 32768 + lane * 16;
#define FRAG(mat, rb, s) (*(const LAS bf16x8*)(base + (mat) + ((rb) * 2 + (s)) * 1024))
            bf16x8 bS[2], bV[2];
#pragma unroll
            for (int s = 0; s < 2; ++s) { u32x4 w; w.x = cvt_pk(S[2 * s][0], S[2 * s][1]); w.y = cvt_pk(S[2 * s][2], S[2 * s][3]); w.z = cvt_pk(S[2 * s + 1][0], S[2 * s + 1][1]); w.w = cvt_pk(S[2 * s + 1][2], S[2 * s + 1][3]); bS[s] = __builtin_bit_cast(bf16x8, w); }
            f32x4 vn[4];
            vn[0] = (f32x4){bf_lo(u0.x), bf_hi(u0.x), bf_lo(u0.y), bf_hi(u0.y)}; vn[1] = (f32x4){bf_lo(u0.z), bf_hi(u0.z), bf_lo(u0.w), bf_hi(u0.w)};
            vn[2] = (f32x4){bf_lo(u1.x), bf_hi(u1.x), bf_lo(u1.y), bf_hi(u1.y)}; vn[3] = (f32x4){bf_lo(u1.z), bf_hi(u1.z), bf_lo(u1.w), bf_hi(u1.w)};
#pragma unroll
            for (int rb = 0; rb < 4; ++rb)
#pragma unroll
                for (int s = 0; s < 2; ++s) vn[rb] = MFMA16(FRAG(CH_NW, rb, s), bS[s], vn[rb]);
#pragma unroll
            for (int s = 0; s < 2; ++s) { u32x4 w; w.x = cvt_pk(vn[2 * s][0], vn[2 * s][1]); w.y = cvt_pk(vn[2 * s][2], vn[2 * s][3]); w.z = cvt_pk(vn[2 * s + 1][0], vn[2 * s + 1][1]); w.w = cvt_pk(vn[2 * s + 1][2], vn[2 * s + 1][3]); bV[s] = __builtin_bit_cast(bf16x8, w); }
            f32x4 o[4];
#pragma unroll
            for (int rb = 0; rb < 4; ++rb) { o[rb] = (f32x4){0.f, 0.f, 0.f, 0.f};
#pragma unroll
                for (int s = 0; s < 2; ++s) { o[rb] = MFMA16(FRAG(CH_QD, rb, s), bS[s], o[rb]); o[rb] = MFMA16(FRAG(CH_QK, rb, s), bV[s], o[rb]); } }
#pragma unroll
            for (int kb = 0; kb < 4; ++kb) { S[kb] = S[kb] * gl;
#pragma unroll
                for (int s = 0; s < 2; ++s) S[kb] = MFMA16(FRAG(CH_KDT, kb, s), bV[s], S[kb]); }
#undef FRAG
#pragma unroll
            for (int rb = 0; rb < 4; ++rb)
#pragma unroll
                for (int e = 0; e < 4; ++e) { const int i = 16 * rb + 4 * q + e;
                    Ob[((size_t)b * TPB + chunk_p(dir, n, i)) * 256 + 64 * h + 16 * sl + (lane & 15)] = f2bf(o[rb][e]); }
        }
        VM_WAIT();
        __syncthreads();
        if (do_finish) {
            const int sub = F.tid >> 4, c = (F.tid & 15) * 4;
            const f32x4 og = *(const f32x4*)(F.in[I_GDOUTG] + l * 64 + c);
            for (int p0 = sub; p0 < TPB; p0 += 128) {
                u32x2 a0[4], a1[4], gw[4];
#pragma unroll
                for (int t = 0; t < 4; ++t) { const size_t off = ((size_t)b * TPB + p0 + 32 * t) * 256 + 64 * h + c;
                    a0[t] = *(const u32x2*)(Ob0 + off); a1[t] = *(const u32x2*)(Ob1 + off); gw[t] = *(const u32x2*)(ptile(F, T_DG) + off); }
#pragma unroll
                for (int t = 0; t < 4; ++t) { const size_t off = ((size_t)b * TPB + p0 + 32 * t) * 256 + 64 * h + c;
                    const float o0 = bf_lo(a0[t].x) + bf_lo(a1[t].x), o1 = bf_hi(a0[t].x) + bf_hi(a1[t].x), o2 = bf_lo(a0[t].y) + bf_lo(a1[t].y), o3 = bf_hi(a0[t].y) + bf_hi(a1[t].y);
                    const float ss = sum16((o0 * o0 + o1 * o1) + (o2 * o2 + o3 * o3));
                    const float rr = rsqrtf(ss * (1.f / 64.f) + EPS);
                    u32x2 w; w.x = cvt_pk(o0 * rr * og[0] * siluf_(bf_lo(gw[t].x)), o1 * rr * og[1] * siluf_(bf_hi(gw[t].x))); w.y = cvt_pk(o2 * rr * og[2] * siluf_(bf_lo(gw[t].y)), o3 * rr * og[3] * siluf_(bf_hi(gw[t].y)));
                    *(u32x2*)(ptile(F, T_DG) + off) = w; }
            }
        }
    }
}
constexpr int WRP = 1032;
constexpr int RT_WLO_OFF = 32 * WRP * 2;
constexpr int RT_REC_OFF = 2 * RT_WLO_OFF;
constexpr int RT_CNT_OFF = RT_REC_OFF + 288 * 4 * 4;
static_assert(RT_CNT_OFF + 256 <= MISC_OFF, "router LDS");

__device__ __forceinline__ void p_route1(const Frame& F, int l, int cl) {
    LAS bf16_t* whi = (LAS bf16_t*)F.lds; LAS bf16_t* wlo = (LAS bf16_t*)(F.lds + RT_WLO_OFF);
    LAS int* rec = (LAS int*)(F.lds + RT_REC_OFF); LAS int* lcnt = (LAS int*)(F.lds + RT_CNT_OFF); LAS int* lbase = lcnt + 32;
    __syncthreads();
    { const float* wr = F.in[I_WR] + (size_t)l * 1024 * 32;
      f32x4 t[16];
#pragma unroll
      for (int i = 0; i < 16; ++i) t[i] = *(const f32x4*)(wr + (size_t)(F.tid + 512 * i) * 4);
#pragma unroll
      for (int i = 0; i < 16; ++i) { const int i4 = F.tid + 512 * i, k = i4 >> 3, e0 = (i4 & 7) * 4;
#pragma unroll
          for (int j = 0; j < 4; ++j) { const bf16_t h = f2bf(t[i][j]); whi[(e0 + j) * WRP + k] = h; wlo[(e0 + j) * WRP + k] = f2bf(t[i][j] - bf2f(h)); } } }
    if (F.tid < 32) lcnt[F.tid] = 0;
    __syncthreads();
    const int g0 = (l == 0) ? (F.blk * 2176) >> 8 : F.blk * 8, g1 = (l == 0) ? ((F.blk + 1) * 2176) >> 8 : F.blk * 8 + 8, ngrp = g1 - g0;
    bf16_t* H2 = (bf16_t*)(F.ar + A_H2); unsigned char* H2f8 = F.ar + A_H2F8;
    const bf16_t* XB = (const bf16_t*)(F.ws + WS_XB);
    int* rowmap = (int*)(F.ws + WS_ROWMAP); float* selg = (float*)(F.ws + WS_SELG);
    for (int i = F.blk * 512 + F.tid; i < MAXROWS; i += GRID * 512) rowmap[i] = -1;
    const int lane = F.lane;
    const float* gn = F.in[I_N2G] + l * 1024;
    int mcur = -1; f32x4 A2[4], B2[4];
    for (int rl0 = F.wave * 4; rl0 < ngrp * 32; rl0 += 32) {
        u32x4 xv[4][2]; float ss[4]; int Rr[4], mir[4];
#pragma unroll
        for (int q = 0; q < 4; ++q) {
            const int gr = g0 * 32 + rl0 + q;
            const int R = (l == 0) ? gr : (gr >> 12) * TPB + CTXL + (gr & 4095);
            const int b = R / TPB, p = R - b * TPB; const bool isctx = p < CTXL; Rr[q] = R; mir[q] = isctx ? 16 : b;
#pragma unroll
            for (int c = 0; c < 2; ++c) xv[q][c] = *(const u32x4*)(XB + (size_t)R * 1024 + lane * 8 + 512 * c);
        }
#pragma unroll
        for (int q = 0; q < 4; ++q) { ss[q] = 0.f;
#pragma unroll
            for (int c = 0; c < 2; ++c) { f32x4 a0, a1; unpack8(xv[q][c], a0, a1); ss[q] += ((a0[0] * a0[0] + a0[1] * a0[1]) + (a0[2] * a0[2] + a0[3] * a0[3])) + ((a1[0] * a1[0] + a1[1] * a1[1]) + (a1[2] * a1[2] + a1[3] * a1[3])); } }
#pragma unroll
        for (int q = 0; q < 4; ++q) {
            const float rstd = rsqrtf(wave_sum(ss[q]) * (1.f / 1024.f) + EPS);
            const int R = Rr[q];
            if (mir[q] != mcur) { mcur = mir[q]; const float* sh = modv(F, l, mcur, 3); const float* sc = modv(F, l, mcur, 4);
#pragma unroll
                for (int c = 0; c < 2; ++c) { const int cc = lane * 8 + 512 * c;
                    A2[2 * c] = *(const f32x4*)(gn + cc) * (*(const f32x4*)(sc + cc) + 1.f); A2[2 * c + 1] = *(const f32x4*)(gn + cc + 4) * (*(const f32x4*)(sc + cc + 4) + 1.f);
                    B2[2 * c] = *(const f32x4*)(sh + cc); B2[2 * c + 1] = *(const f32x4*)(sh + cc + 4); } }
#pragma unroll
            for (int c = 0; c < 2; ++c) { const int cc = lane * 8 + 512 * c;
                f32x4 a0, a1; unpack8(xv[q][c], a0, a1);
                const f32x4 h0 = (a0 * rstd) * A2[2 * c] + B2[2 * c];
                const f32x4 h1 = (a1 * rstd) * A2[2 * c + 1] + B2[2 * c + 1];
                *(u32x4*)(H2 + (size_t)R * 1024 + cc) = pack8(h0, h1);
                int w0 = 0, w1 = 0; w0 = __builtin_amdgcn_cvt_pk_fp8_f32(h0[0], h0[1], w0, false); w0 = __builtin_amdgcn_cvt_pk_fp8_f32(h0[2], h0[3], w0, true);
                w1 = __builtin_amdgcn_cvt_pk_fp8_f32(h1[0], h1[1], w1, false); w1 = __builtin_amdgcn_cvt_pk_fp8_f32(h1[2], h1[3], w1, true);
                *(u32x2*)(H2f8 + (size_t)R * 1024 + cc) = (u32x2){(unsigned)w0, (unsigned)w1}; }
        }
    }
    VM_WAIT();
    __syncthreads();
    const int r = lane & 31, h2 = lane >> 5;
    for (int grp = F.wave; grp < ngrp; grp += 8) {
        const int gr = (g0 + grp) * 32 + r;
        const int R = (l == 0) ? gr : (gr >> 12) * TPB + CTXL + (gr & 4095);
        const bf16_t* bh = H2 + (size_t)R * 1024 + 8 * h2;
        const LAS bf16_t* ah = whi + r * WRP + 8 * h2; const LAS bf16_t* al = wlo + r * WRP + 8 * h2;
        f32x16 acc;
#pragma unroll
        for (int i = 0; i < 16; ++i) acc[i] = 0.f;
        bf16x8 xh[2][8];
#pragma unroll
        for (int j = 0; j < 8; ++j) { xh[0][j] = *(const bf16x8*)(bh + 16 * j); }
#pragma unroll
        for (int kc = 0; kc < 8; ++kc) {
            if (kc + 1 < 8) {
#pragma unroll
                for (int j = 0; j < 8; ++j) { xh[(kc + 1) & 1][j] = *(const bf16x8*)(bh + 16 * (8 * (kc + 1) + j)); }
            }
#pragma unroll
            for (int j = 0; j < 8; ++j) { asm volatile("" : "+v"(xh[kc & 1][j])); }
#pragma unroll
            for (int j = 0; j < 8; ++j) { const int ks = 8 * kc + j;
                const bf16x8 wh = *(const LAS bf16x8*)(ah + 16 * ks), wl = *(const LAS bf16x8*)(al + 16 * ks);
                acc = MFMA32(wh, xh[kc & 1][j], acc); acc = MFMA32(wl, xh[kc & 1][j], acc); }
        }
        float lg[32];
#pragma unroll
        for (int i = 0; i < 16; ++i) { const auto rr = __builtin_amdgcn_permlane32_swap(__float_as_uint(acc[i]), __float_as_uint(acc[i]), false, false);
            const int e = (i & 3) + 8 * (i >> 2); lg[e] = __uint_as_float(rr[0]) + F.in[I_BR][l * 32 + e]; lg[e + 4] = __uint_as_float(rr[1]) + F.in[I_BR][l * 32 + e + 4]; }
        if (lane < 32) {
            const int rl = grp * 32 + r;
            unsigned used = 0u; int se[4]; float sv[4];
#pragma unroll
            for (int k = 0; k < 4; ++k) {
                float best = -INFINITY; int bi = 0;
#pragma unroll
                for (int e = 0; e < 32; ++e) { const bool ok = !((used >> e) & 1u) && lg[e] > best; best = ok ? lg[e] : best; bi = ok ? e : bi; }
                used |= 1u << bi; se[k] = bi; sv[k] = best;
            }
            const float e1 = __expf(sv[1] - sv[0]), e2 = __expf(sv[2] - sv[0]), e3 = __expf(sv[3] - sv[0]); const float den = 1.f / (1.f + e1 + e2 + e3);
            *(f32x4*)(selg + (size_t)R * 4) = (f32x4){den, e1 * den, e2 * den, e3 * den};
#pragma unroll
            for (int k = 0; k < 4; ++k) { const int pos = __hip_atomic_fetch_add(lcnt + se[k], 1, __ATOMIC_RELAXED, __HIP_MEMORY_SCOPE_WORKGROUP); rec[rl * 4 + k] = (pos << 5) | se[k]; }
        }
    }
    __syncthreads();
    if (F.tid < 32) lbase[F.tid] = (int)atomicAdd((unsigned*)(F.ws + WS_CTL) + CW_GCNT + cl * 32 + F.tid, (unsigned)lcnt[F.tid]);
    __syncthreads();
    int* seli = (int*)(F.ws + WS_SELI);
    for (int idx = F.tid; idx < ngrp * 32 * 4; idx += 512) {
        const int rl = idx >> 2, k = idx & 3;
        const int gr = g0 * 32 + rl;
        const int R = (l == 0) ? gr : (gr >> 12) * TPB + CTXL + (gr & 4095);
        const int e = rec[idx] & 31, pos = rec[idx] >> 5;
        seli[(size_t)R * 4 + k] = ((lbase[e] + pos) << 5) | e;
    }
}

__device__ __forceinline__ int moe_tables(const Frame& F, int l) {
    LAS int* off = (LAS int*)(F.lds + MISC_OFF + 64); LAS int* texp = (LAS int*)(F.lds + MISC_OFF + 256);
    __syncthreads();
    if (F.tid == 0) { const unsigned* gc = (const unsigned*)(F.ws + WS_CTL) + CW_GCNT + l * 32; int o = 0;
        for (int e = 0; e < 32; ++e) { off[e] = o; o += (int)((__hip_atomic_load(gc + e, __ATOMIC_RELAXED, __HIP_MEMORY_SCOPE_AGENT) + 255u) & ~255u); } off[32] = o; }
    __syncthreads();
    const int nt = off[32] >> 8;
    for (int pm = F.tid; pm < nt; pm += 512) { int e = 0;
#pragma unroll
        for (int k = 1; k < 32; ++k) e += (off[k] <= pm * 256) ? 1 : 0;
        texp[pm] = e; }
    __syncthreads();
    return nt;
}

__device__ __forceinline__ void p_route2(const Frame& F, int l) {
    (void)moe_tables(F, l);
    const LAS int* off = (const LAS int*)(F.lds + MISC_OFF + 64);
    int* seli = (int*)(F.ws + WS_SELI); const float* selg = (const float*)(F.ws + WS_SELG);
    int* rowmap = (int*)(F.ws + WS_ROWMAP); float* gslot = (float*)(F.ws + WS_GSLOT);
    for (int idx = F.blk * 512 + F.tid; idx < NR * 4; idx += GRID * 512) {
        const int R = idx >> 2;
        if (l == 1 && (R % TPB) < CTXL) continue;
        const int s = seli[idx]; const int e = s & 31, dst = off[e] + (s >> 5);
        rowmap[dst] = idx; gslot[dst] = selg[idx]; seli[idx] = dst;
    }
}
constexpr int NPH = 24;

__global__ void __launch_bounds__(512, 2) mega(Args args) {
    extern __shared__ __attribute__((aligned(16))) unsigned char lds_raw[];
    Frame F;
    F.lds = (LAS unsigned char*)lds_raw;
    F.in = args.in; F.out = args.out; F.ws = args.ws; F.ar = args.ws + WS_ARENA;
    F.tid = threadIdx.x; F.lane = F.tid & 63; F.wave = __builtin_amdgcn_readfirstlane(F.tid >> 6); F.blk = blockIdx.x;
    if (F.tid < 64) ((LAS unsigned*)(F.lds + MISC_OFF))[F.tid] = 0u;
    __syncthreads();
    const int lo = args.ph_lo, hi = args.ph_hi;
    XcdBarrier bar; bar.bar = (unsigned*)(F.ws + WS_CTL) + CW_BAR; bar.x = 0; bar.st = (volatile LAS unsigned*)(F.lds + MISC_OFF);
    if (hi - lo > 1) bar = xcd_barrier_post((unsigned*)(F.ws + WS_CTL) + CW_BAR, (volatile LAS unsigned*)(F.lds + MISC_OFF));
#ifndef PH_MASK
#define PH_MASK 0x1fff
#endif
#define KON(kind) (((PH_MASK) >> (kind)) & 1)
#define IN(k) (lo <= (k) && (k) < hi)
#define SEAM(k) do { if (IN(k) && IN((k) + 1)) xcd_barrier(bar); } while (0)
#define FRESH(FF) Frame FF = F; { int ln_; asm volatile("v_mbcnt_lo_u32_b32 %0, -1, 0\n\tv_mbcnt_hi_u32_b32 %0, -1, %0" : "=v"(ln_)); int wv_ = F.wave, bk_ = F.blk; asm volatile("" : "+s"(wv_), "+s"(bk_)); FF.lane = ln_; FF.wave = wv_; FF.blk = bk_; FF.tid = wv_ * 64 + ln_; }

    if (KON(0) && IN(0)) { FRESH(FF); p_prologue(FF, args); }
    SEAM(0);
    for (int l = 0; l < 2; ++l) {
        const int pb = 1 + 11 * l;
        if (KON(1) && IN(pb + 0)) { FRESH(FF); if (FF.wave >= 4) __builtin_amdgcn_s_setprio(1); if (l == 0) p_rowpass<0>(FF, 0); else p_rowpass<1>(FF, 1); __builtin_amdgcn_s_setprio(0); }
        SEAM(pb + 0);
        if (KON(2) && IN(pb + 1)) { FRESH(FF);
            EpiTiles E{ptile(FF, 0), FF.in[I_BGATE] + l * 4096};
            {
                pg8::DenseOrder S;
                if (l == 0) S.init(NRT, T_GATE, GRID, FF.blk, false, FF.ar + A_H, (const bf16_t*)(FF.ws + WS_WIN) + (size_t)l * 7168 * 1024, 1024);
                else { S.init(256, T_GATE, GRID, FF.blk, true, FF.ar + A_H, (const bf16_t*)(FF.ws + WS_WIN) + (size_t)l * 7168 * 1024, 1024); S.nctx = 16 * 7; }
#if PROBE_REP & 512
                if ((FF.blk >> 3) & 1) { __builtin_amdgcn_s_sleep(127); __builtin_amdgcn_s_sleep(127); __builtin_amdgcn_s_sleep(127); }
#endif
                pg8::gemm_phase<EpiTiles, pg8::DenseOrder>(FF.lds, FF.tid, 1024, S, E);
#if PROBE_REP & 1
                pg8::gemm_phase<EpiTiles, pg8::DenseOrder>(FF.lds, FF.tid, 1024, S, E);
#endif
            }
        }
        SEAM(pb + 1);
        if (KON(3) && IN(pb + 2)) { FRESH(FF);
#if PROBE_REP & 64
            p_prep<false, true>(FF, l);
#endif
#if PROBE_REP & 128
            p_prep<true, false>(FF, l);
#endif
            if (FF.wave >= 4) __builtin_amdgcn_s_setprio(1); p_prep(FF, l); __builtin_amdgcn_s_setprio(0); }
        SEAM(pb + 2);
        if (KON(4) && IN(pb + 3)) { FRESH(FF);
#if PROBE_REP & 32
            for (int u = FF.blk; u < 16 * 34 * 4; u += GRID) { const int g = u & 3, bc = u >> 2, b = bc / 34, chunk = bc - b * 34; gmlp_unit(FF, l, b, chunk, g, (bf16_t*)(FF.ar + A_H + 3 * PT_BYTES)); }
#endif
            for (int u = FF.blk; u < 16 * 34 * 4; u += GRID) { const int g = u & 3, bc = u >> 2, b = bc / 34, chunk = bc - b * 34; gmlp_unit(FF, l, b, chunk, g); }
            gdn_chunk_phase(FF);
#if PROBE_REP & 16
            gdn_chunk_phase(FF);
#endif
        }
        SEAM(pb + 3);
        if (KON(5) && IN(pb + 4)) { FRESH(FF);
            gdn_scan_phase(FF, l);
            float lam; { float d1 = 0.f, d2 = 0.f; for (int i = 0; i < 32; ++i) { d1 += FF.in[I_LQ1][l * 32 + i] * FF.in[I_LK1][l * 32 + i]; d2 += FF.in[I_LQ2][l * 32 + i] * FF.in[I_LK2][l * 32 + i]; } lam = expf(d1) - expf(d2) + args.lam_init[l]; }
            const int nq = (l == 0) ? 17 : 16, nda = 8 * nq, nga = 4 * nq, xq = FF.blk & 7;
            volatile LAS int* qslot = (volatile LAS int*)(FF.lds + MISC_OFF + 32);
            unsigned* qctr = (unsigned*)(FF.ws + WS_CTL) + CW_AQ + (l * 8 + xq) * 64;
            bf16_t* oda = ptile(FF, T_AQ); bf16_t* oga = ptile(FF, T_GQ);
            for (;;) {
                __syncthreads();
                if (FF.tid == 0) *qslot = (int)__hip_atomic_fetch_add(qctr, 1u, __ATOMIC_RELAXED, __HIP_MEMORY_SCOPE_AGENT);
                __syncthreads();
                int u = *qslot;
                if (u >= nda + nga) break;
                if (u < nda) {
                    const int g = u / nq, qi = u - g * nq, bh = xq * 8 + g, b = bh >> 2, h = bh & 3, qt = (qi < 16) ? qi + 1 : 0;
                    attn_unit<32, 2, true>(FF, ptile(FF, T_AQ), 64 * h, ptile(FF, T_AK), 64 * h, ptile(FF, T_AV), 64 * h, oda, 64 * h, b, qt, lam, 1.f - args.lam_init[l], FF.in[I_DASUBG] + l * 64, FF.in[I_DAQG] + l * 32, 0.17677669529663687f * LOG2E * QSC, (const f32x2*)(FF.ws + WS_ROPE));
                } else {
                    u -= nda; const int g = u / nq, qi = u - g * nq, bk = xq * 4 + g, b = bk >> 1, kv = bk & 1, qt = (qi < 16) ? qi + 1 : 0;
                    attn_unit<64, 2, false>(FF, ptile(FF, T_GQ), 128 * kv, ptile(FF, T_GKV), 64 * kv, ptile(FF, T_GKV), 128 + 64 * kv, oga, 128 * kv, b, qt, 0.f, 1.f, nullptr, FF.in[I_GAQG] + l * 64, 0.125f * LOG2E * QSC, (const f32x2*)(FF.ws + WS_ROPE) + 512);
                }
            }
            __syncthreads();
            {
                EpiTiles E{ptile(FF, 0), FF.in[I_BGATE] + l * 4096};
                pg8::DenseOrderT<true> S; S.init((l == 0) ? NRT : 256, 16, GRID, FF.blk, l == 1, FF.ar + A_H8, FF.ws + WS_WG8 + (size_t)l * 4096 * 1024, 1024); S.pn_off = T_GATE;
                constexpr int NDYN = 3;
                const int rounds = S.nwg / GRID; S.imax = rounds - NDYN;
                unsigned* gq = (unsigned*)(FF.ws + WS_CTL) + CW_GQ + (l * 8 + (FF.blk & 7)) * 64;
                if (FF.tid == 0) *qslot = (int)__hip_atomic_fetch_add(gq, 1u, __ATOMIC_RELAXED, __HIP_MEMORY_SCOPE_AGENT);
                for (int it = 0;; ++it) {
                    pg8::gemm_phase<EpiTiles, pg8::DenseOrderT<true>>(FF.lds, FF.tid, 1024, S, E);
                    __syncthreads();
                    const int v = *qslot;
                    if (v >= NDYN * (GRID / 8)) break;
                    S.single = (rounds - NDYN) * GRID + 8 * v + (FF.blk & 7);
                    __syncthreads();
                    if (FF.tid == 0) *qslot = (int)__hip_atomic_fetch_add(gq, 1u, __ATOMIC_RELAXED, __HIP_MEMORY_SCOPE_AGENT);
                }
#if PROBE_REP & 2
                pg8::gemm_phase<EpiTiles, pg8::DenseOrderT<true>>(FF.lds, FF.tid, 1024, S, E);
#endif
            }
        }
        SEAM(pb + 4);
        if (KON(6) && IN(pb + 5)) { FRESH(FF);
            MergeOrder S; S.G = GRID; S.c = FF.blk; S.skipctx = (l == 1); S.ntile = (l == 1) ? 1024 : 1088; S.P = (const char*)(FF.ar + A_P); S.Wbr = (const char*)((const bf16_t*)(FF.ws + WS_WBR) + (size_t)l * 4 * 1024 * 256);
            EpiMerge E{ptile(FF, 0), (bf16_t*)(FF.ar + A_MERGED)};
            pg8::gemm_phase<EpiMerge, MergeOrder>(FF.lds, FF.tid, 256, S, E);
        }
        SEAM(pb + 5);
        if (KON(7) && IN(pb + 6)) { FRESH(FF);
            pg8::DenseOrder S; S.init((l == 1) ? 256 : NRT, 4, GRID, FF.blk, l == 1, FF.ar + A_MERGED, (const bf16_t*)(FF.ws + WS_WO) + (size_t)l * 1024 * 1024, 1024);
            EpiWo E{(l == 0) ? FF.in[I_X] : nullptr, FF.in[I_CTX], (bf16_t*)(FF.ws + WS_XB), (const float*)(FF.ws + WS_MOD) + (size_t)l * 17 * 6144, 2};
            pg8::gemm_phase<EpiWo, pg8::DenseOrder>(FF.lds, FF.tid, 1024, S, E);
        }
        SEAM(pb + 6);
#if PROBE_REP & 256
        if (KON(8) && IN(pb + 7)) { FRESH(FF); p_route1(FF, l, l + 2); }
#endif
        if (KON(8) && IN(pb + 7)) { FRESH(FF); if (FF.wave >= 4) __builtin_amdgcn_s_setprio(1); p_route1(FF, l, l); __builtin_amdgcn_s_setprio(0); }
        SEAM(pb + 7);
        if (KON(9) && IN(pb + 8)) { FRESH(FF); p_route2(FF, l); }
        SEAM(pb + 8);
        if (KON(10) && IN(pb + 9)) { FRESH(FF);
            const int nt = moe_tables(FF, l);
            MoeOrder<8, true> S; S.G = GRID; S.c = FF.blk; S.nunits = nt * 8; S.texp = (const LAS int*)(FF.lds + MISC_OFF + 256); S.A = (const char*)(FF.ar + A_H2F8); S.rowmap = (const int*)(FF.ws + WS_ROWMAP);
            S.W = (const char*)(FF.ws + WS_WUP) + (size_t)l * 32 * 2048 * 1024; S.wstride = (size_t)2048 * 1024;
            EpiUp E{FF.in[I_BUP] + (size_t)l * 32 * 2048, (unsigned char*)(FF.ar + A_ACT)};
            pg8::gemm_phase<EpiUp, MoeOrder<8, true>>(FF.lds, FF.tid, 1024, S, E);
#if PROBE_REP & 4
            pg8::gemm_phase<EpiUp, MoeOrder<8, true>>(FF.lds, FF.tid, 1024, S, E);
#endif
        }
        SEAM(pb + 9);
        if (KON(11) && IN(pb + 10)) { FRESH(FF);
            const int nt = moe_tables(FF, l);
            MoeOrder<4, false> S; S.G = GRID; S.c = FF.blk; S.nunits = nt * 4; S.texp = (const LAS int*)(FF.lds + MISC_OFF + 256); S.A = (const char*)(FF.ar + A_ACT); S.rowmap = nullptr;
            S.W = (const char*)(FF.ws + WS_WDN) + (size_t)l * 32 * 1024 * 1024; S.wstride = (size_t)1024 * 1024;
            EpiDown E{FF.in[I_BDN] + (size_t)l * 32 * 1024, (const float*)(FF.ws + WS_GSLOT), FF.ar + A_YBUF};
            pg8::gemm_phase<EpiDown, MoeOrder<4, false>>(FF.lds, FF.tid, 1024, S, E);
#if PROBE_REP & 8
            pg8::gemm_phase<EpiDown, MoeOrder<4, false>>(FF.lds, FF.tid, 1024, S, E);
#endif
        }
        SEAM(pb + 10);
    }
    if (KON(12) && IN(23)) { FRESH(FF); if (FF.wave >= 4) __builtin_amdgcn_s_setprio(1); p_rowpass<2>(FF, 2); __builtin_amdgcn_s_setprio(0); }
#undef IN
#undef SEAM
}

extern "C" void kernel_launch(void* const* d_in, const int* in_sizes, int n_in, void* d_out, int out_size, void* d_ws, size_t ws_size, hipStream_t stream) {
    static int grid = 0;
    if (grid == 0) {
        if (n_in != 34 || out_size != NB * SEQ * D || ws_size < WS_NEED) { fprintf(stderr, "kernel_launch: unexpected shapes (n_in %d out %d ws %zu need %zu)\n", n_in, out_size, ws_size, (size_t)WS_NEED); grid = -1; return; }
        int dev = 0, cus = 0;
        if (hipGetDevice(&dev) != hipSuccess || hipDeviceGetAttribute(&cus, hipDeviceAttributeMultiprocessorCount, dev) != hipSuccess) { grid = -1; return; }
        if (hipFuncSetAttribute((const void*)mega, hipFuncAttributeMaxDynamicSharedMemorySize, LDS_BYTES) != hipSuccess) { fprintf(stderr, "kernel_launch: hipFuncSetAttribute failed\n"); grid = -1; return; }
        int per_cu = 0;
        (void)hipOccupancyMaxActiveBlocksPerMultiprocessor(&per_cu, (const void*)mega, 512, LDS_BYTES);
        (void)hipGetLastError();
        if (cus != 256 || per_cu < 1) { fprintf(stderr, "kernel_launch: needs 256 CUs with one resident workgroup each (cus %d, per_cu %d)\n", cus, per_cu); grid = -1; return; }
        grid = GRID;
    }
    if (grid < 0) return;
    (void)hipMemsetAsync((char*)d_ws + WS_CTL, 0, CTL_BYTES, stream);
    Args a;
    memset(&a, 0, sizeof(a));
    for (int i = 0; i < 34; ++i) a.in[i] = (const float*)d_in[i];
    a.out = (float*)d_out; a.ws = (unsigned char*)d_ws;
    for (int i = 0; i < 8; ++i) a.inv32[i] = (float)pow(10000.0, -(double)i / 8.0);
    for (int i = 0; i < 16; ++i) a.inv64[i] = (float)pow(10000.0, -(double)i / 16.0);
    for (int l = 0; l < 2; ++l) a.lam_init[l] = (float)(0.8 - 0.6 * exp(-0.3 * (double)l));
    a.ph_lo = 0; a.ph_hi = NPH;
    hipLaunchKernelGGL(mega, dim3(grid), dim3(512), LDS_BYTES, stream, a);
}
```

```cpp
#include <hip/hip_runtime.h>
#include <stdint.h>
#include <stdio.h>
#include <math.h>
#include <string.h>

#define LAS __attribute__((address_space(3)))
typedef unsigned short bf16_t;
typedef short bf16x8 __attribute__((ext_vector_type(8)));
typedef short s16x4 __attribute__((ext_vector_type(4)));
typedef short v4i16_t __attribute__((ext_vector_type(4)));
typedef float f32x2 __attribute__((ext_vector_type(2)));
typedef float f32x4 __attribute__((ext_vector_type(4)));
typedef float f32x16 __attribute__((ext_vector_type(16)));
typedef unsigned u32x2 __attribute__((ext_vector_type(2)));
typedef unsigned u32x4 __attribute__((ext_vector_type(4)));

constexpr int D = 1024, NB = 16, SEQ = 4096, CTXL = 256, TPB = SEQ + CTXL;
constexpr int NR = NB * TPB;
constexpr int NRT = NR / 256;
constexpr int NPT = 28;
constexpr int NE = 32;
constexpr int GRID = 256;
constexpr int MAXT = 1120, MAXROWS = MAXT * 256;
#ifndef PROBE_REP
#define PROBE_REP 0
#endif
constexpr float EPS = 1e-6f;
constexpr float LOG2E = 1.4426950408889634f;
constexpr float QSC = 128.f / 32767.f;
constexpr int T_AQ = 0, T_AK = 1, T_AV = 2, T_GQ = 3, T_GKV = 4, T_MU = 5, T_MV = 6, T_DQ = 7, T_DK = 8, T_DV = 9, T_DG = 10, T_DAB = 11, T_GATE = 12;

constexpr size_t WS_CTL = 0;
constexpr size_t CTL_BYTES = 65536;
constexpr int CW_BAR = 0;
constexpr int CW_GCNT = 4096;
constexpr int CW_QUEUE = 4352;
constexpr int CW_AQ = 6144;
constexpr int CW_GQ = 4608;
constexpr size_t WS_MOD = 65536;
constexpr size_t WS_ROPE = WS_MOD + 2ull * 17 * 6144 * 4;
constexpr size_t WS_WIN = 1048576;
constexpr size_t WS_WBR = WS_WIN + 2ull * 7168 * 1024 * 2;
constexpr size_t WS_WO = WS_WBR + 2ull * 4 * 1024 * 256 * 2;
constexpr size_t WS_WUP = WS_WO + 2ull * 1024 * 1024 * 2;
constexpr size_t WS_WG8 = WS_WUP + 2ull * 32 * 2048 * 1024;
constexpr size_t WS_WDN = WS_WG8 + 2ull * 4096 * 1024;
constexpr size_t WS_GMWS = WS_WDN + 2ull * 32 * 1024 * 1024;
constexpr size_t WS_XB = WS_GMWS + 2ull * 4 * 128 * 128 * 2;
constexpr size_t WS_SELI = WS_XB + (size_t)NR * 1024 * 2;
constexpr size_t WS_SELG = WS_SELI + (size_t)NR * 4 * 4;
constexpr size_t WS_GB = WS_SELG + (size_t)NR * 4 * 4;
constexpr size_t WS_ROWMAP = WS_GB + (size_t)NR * 16 * 4;
constexpr size_t WS_GSLOT = WS_ROWMAP + (size_t)MAXROWS * 4;
constexpr size_t WS_CHG = WS_GSLOT + (size_t)MAXROWS * 4;
constexpr size_t WS_ARENA = (WS_CHG + 8704 * 4 + 4095) & ~(size_t)4095;
constexpr size_t PT_BYTES = (size_t)NR * 256 * 2;
constexpr size_t A_H = 0;
constexpr size_t A_P = (size_t)NR * 1024 * 2;
constexpr size_t A_CH = A_P + NPT * PT_BYTES;
constexpr size_t CH_ITEM = 40960;
constexpr size_t A_END = A_CH + 8704ull * CH_ITEM;
constexpr size_t A_MERGED = A_CH;
constexpr size_t A_H2 = 0;
constexpr size_t A_XS = A_P;
constexpr size_t A_ACT = A_XS + (size_t)MAXROWS * 1024 * 2;
constexpr size_t A_H2F8 = A_XS + (size_t)NR * 1024 * 2;
constexpr size_t A_YBUF = A_XS;
static_assert(A_ACT + (size_t)MAXROWS * 1024 * 2 <= A_END, "arena");
static_assert((size_t)NR * 4 * 1024 * 2 <= (size_t)MAXROWS * 1024 * 2, "ybuf fits xs");
constexpr size_t A_H8 = A_END;
constexpr size_t WS_NEED = WS_ARENA + A_END + (size_t)NR * 1024;

constexpr int RING_BYTES = 131072;
constexpr int MISC_OFF = 140544;
constexpr int LDS_BYTES = 147456;

typedef __bf16 bf16x2_t __attribute__((ext_vector_type(2)));
__device__ __forceinline__ unsigned cvt_pk(float lo, float hi) { const f32x2 v = {lo, hi}; const bf16x2_t b = __builtin_convertvector(v, bf16x2_t); return __builtin_bit_cast(unsigned, b); }
__device__ __forceinline__ float bf_lo(unsigned u) { return __uint_as_float(u << 16); }
__device__ __forceinline__ float bf_hi(unsigned u) { return __uint_as_float(u & 0xffff0000u); }
__device__ __forceinline__ float bf2f(bf16_t h) { return __uint_as_float(((unsigned)h) << 16); }
__device__ __forceinline__ bf16_t f2bf(float f) { return (bf16_t)(cvt_pk(f, 0.f) & 0xffffu); }
template <int O> __device__ __forceinline__ float xor_f(float v) { return __int_as_float(__builtin_amdgcn_ds_swizzle(__float_as_int(v), (O << 10) | 0x1f)); }
__device__ __forceinline__ float add_xor32(float v) { const auto rr = __builtin_amdgcn_permlane32_swap(__float_as_uint(v), __float_as_uint(v), false, false); return __uint_as_float(rr[0]) + __uint_as_float(rr[1]); }
__device__ __forceinline__ float sum16(float v) { v += xor_f<1>(v); v += xor_f<2>(v); v += xor_f<4>(v); v += xor_f<8>(v); return v; }
__device__ __forceinline__ float wave_sum(float v) { v = sum16(v); v += xor_f<16>(v); return add_xor32(v); }
__device__ __forceinline__ float sigmoidf_(float x) { return __builtin_amdgcn_rcpf(1.f + __builtin_amdgcn_exp2f(x * -LOG2E)); }
__device__ __forceinline__ float siluf_(float x) { return x * __builtin_amdgcn_rcpf(1.f + __builtin_amdgcn_exp2f(x * -LOG2E)); }
__device__ __forceinline__ float gelu_erf(float v) {
    const float av = fabsf(v), t = __builtin_amdgcn_rcpf(av * 0.2316418882f + 1.0f);
    float q = t * 0.5307027145f + (-0.7265760135f); q = q * t + 0.7107068705f; q = q * t + (-0.142248368f); q = q * t + 0.127414796f; q = q * t;
    const float e = __builtin_amdgcn_exp2f((v * v) * (-0.72134752044f));
    const float m = v * (q * e);
    return v < 0.f ? m : v - m;
}
#define VM_WAIT() asm volatile("s_waitcnt vmcnt(0)" ::: "memory")
#define LDS_WAIT() asm volatile("s_waitcnt lgkmcnt(0)" ::: "memory")

#define XB_TMO      128
#define XB_XCNT(j)  (256  + 64 * (j))
#define XB_XSUB(j)  (1280 + 64 * (j))
#define XB_XGEN(j)  (2304 + 64 * (j))
#define XB_TOP      3328
#define XB_TOPGEN   3392
#define XCD_BAR_WORDS 3456
#define XB_SPIN_CAP (1u << 18)
__device__ __forceinline__ unsigned xb_ld(unsigned* p)              { return __hip_atomic_load(p, __ATOMIC_RELAXED, __HIP_MEMORY_SCOPE_AGENT); }
__device__ __forceinline__ unsigned xb_add(unsigned* p, unsigned v) { return __hip_atomic_fetch_add(p, v, __ATOMIC_RELAXED, __HIP_MEMORY_SCOPE_AGENT); }
__device__ __forceinline__ unsigned xb_xcc_id() { return (unsigned)__builtin_amdgcn_s_getreg((3 << 11) | 20) & 0xFu; }
#define XB_SPIN(cond, bar) do { unsigned _sp = 0; while (cond) { __builtin_amdgcn_s_sleep(1); \
    if ((++_sp & 255u) == 0u) { if (xb_ld(&(bar)[XB_TMO])) break; if (_sp > XB_SPIN_CAP) { atomicAdd(&(bar)[XB_TMO], 1u); break; } } } } while (0)
struct XcdBarrier { unsigned* bar; unsigned x; volatile LAS unsigned* st; };
__device__ __forceinline__ XcdBarrier xcd_barrier_post(unsigned* bar, volatile LAS unsigned* st) {
    XcdBarrier b; b.bar = bar; b.x = xb_xcc_id(); b.st = st;
    if (threadIdx.x == 0) (void)xb_add(&bar[XB_XCNT(b.x)], 1u);
    return b;
}
__device__ __forceinline__ void xcd_barrier_complete(unsigned* bar, unsigned x, unsigned& nloc, unsigned& nx) {
    const unsigned G = gridDim.x * gridDim.y * gridDim.z;
    unsigned sum, cnt, mine, sp = 0u;
    for (;;) {
        sum = 0u; cnt = 0u; mine = 0u;
#pragma unroll
        for (unsigned j = 0; j < 16; ++j) { const unsigned c = xb_ld(&bar[XB_XCNT(j)]); sum += c; cnt += (c > 0u) ? 1u : 0u; mine = (j == x) ? c : mine; }
        if (sum == G) break;
        __builtin_amdgcn_s_sleep(1);
        if ((++sp & 255u) == 0u) { if (xb_ld(&bar[XB_TMO])) break; if (sp > XB_SPIN_CAP) { atomicAdd(&bar[XB_TMO], 1u); break; } }
    }
    nloc = mine > 0u ? mine : 1u; nx = cnt > 0u ? cnt : 1u;
}
__device__ __forceinline__ void xcd_barrier(const XcdBarrier& b) {
    asm volatile("s_waitcnt vmcnt(0)" ::: "memory");
    __syncthreads();
    if (threadIdx.x == 0) {
        unsigned* bar = b.bar;
        __builtin_amdgcn_s_waitcnt(0);
        unsigned nloc = b.st[0], nx = b.st[1];
        if (nloc == 0u) { xcd_barrier_complete(bar, b.x, nloc, nx); b.st[0] = nloc; b.st[1] = nx; }
        const unsigned old = xb_add(&bar[XB_XSUB(b.x)], 1u);
        const unsigned gen = old / nloc;
        if (old + 1u == (gen + 1u) * nloc) {
            __builtin_amdgcn_fence(__ATOMIC_RELEASE, "agent");
            asm volatile("s_waitcnt vmcnt(0)" ::: "memory");
            const unsigned og = xb_add(&bar[XB_TOP], 1u);
            const unsigned tg = og / nx;
            if (og + 1u == (tg + 1u) * nx) xb_add(&bar[XB_TOPGEN], 1u);
            else XB_SPIN(xb_ld(&bar[XB_TOPGEN]) == tg, bar);
            __builtin_amdgcn_fence(__ATOMIC_ACQUIRE, "agent");
            xb_add(&bar[XB_XGEN(b.x)], 1u);
            asm volatile("s_waitcnt vmcnt(0)" ::: "memory");
        } else {
            XB_SPIN(xb_ld(&bar[XB_XGEN(b.x)]) == gen, bar);
            __builtin_amdgcn_fence(__ATOMIC_ACQUIRE, "agent");
            asm volatile("s_waitcnt vmcnt(0)" ::: "memory");
        }
    }
    __syncthreads();
}

struct Args { const float* in[34]; float* out; unsigned char* ws; float inv32[8]; float inv64[16]; float lam_init[2]; int ph_lo, ph_hi; };
struct Frame {
    LAS unsigned char* lds;
    const float* const* in;
    float* out; unsigned char* ws; unsigned char* ar;
    int tid, lane, wave, blk;
};
enum InIdx { I_X = 0, I_C, I_CTX, I_CCTX, I_WMOD, I_BMOD, I_N1G, I_N2G, I_WIN, I_BGATE, I_DAQG, I_DAKG, I_LQ1, I_LK1, I_LQ2, I_LK2, I_DASUBG, I_GAQG, I_GAKG, I_GMVG, I_GMWS, I_GMBS,
             I_CONVW, I_ALOG, I_DTB, I_GDOUTG, I_WBR, I_WO, I_WR, I_BR, I_WUP, I_BUP, I_WDN, I_BDN };
__device__ __forceinline__ bf16_t* ptile(const Frame& F, int t) { return (bf16_t*)(F.ar + A_P + (size_t)t * PT_BYTES); }
__device__ __forceinline__ const float* modv(const Frame& F, int l, int mi, int which) { return (const float*)(F.ws + WS_MOD) + ((size_t)(l * 17 + mi) * 6144 + which * 1024); }
namespace pg8 {
typedef int v4i_t __attribute__((ext_vector_type(4)));
typedef int v8i_t __attribute__((ext_vector_type(8)));
constexpr int BM = 256, BK = 64, HALF = 128, HTB = HALF * BK * 2, STAGE_BYTES = 8 * HTB, NXCD = 8, WGM = 8;
__host__ __device__ __forceinline__ int lds_byte(int r, int c) { const int st = (r >> 4) * 2 + (c >> 5), rr = r & 15, cc = c & 31, ob = rr * 64 + cc * 2; return st * 1024 + (ob ^ (((ob >> 9) & 1) << 5)); }
__host__ __device__ __forceinline__ void stage_rc(int b, int& R, int& C) { const int st = b / 1024, sb = b % 1024, swz = sb ^ (((sb >> 9) & 1) << 5); R = (st >> 1) * 16 + swz / 64; C = (st & 1) * 32 + (swz % 64) / 2; }
__host__ __device__ __forceinline__ int perm32(int rho) { const int n = rho >> 4, i = rho & 15; return 8 * (i >> 2) + 4 * n + (i & 3); }

struct Unit { int pm, pn, z; };

template <bool F8_>
struct DenseOrderT {
    static constexpr bool GATHER = false, FP8 = F8_;
    __device__ __forceinline__ int scale_w() const { return 0x7a7a7a7a; }
    __device__ __forceinline__ int scale_x() const { return 0x7f7f7f7f; }
    int pn_off = 0;
    __device__ __forceinline__ int arow(const Unit&, int) const { return 0; }
    __device__ __forceinline__ int araw(const Unit&, int) const { return 0; }
    int imax = 1 << 30, single = -1;
    int nM, nN, nwg, G, c; bool skipctx; const char* A; const char* Bt; size_t tstep; int nctx = 0;
    __device__ void init(int nM_, int nN_, int G_, int c_, bool skip, const void* A_, const void* Bt_, int K) { nM = nM_; nN = nN_; nwg = nM * nN; G = G_; c = c_; skipctx = skip; A = (const char*)A_; Bt = (const char*)Bt_; tstep = (size_t)BM * K * (F8_ ? 1 : 2); }
    __device__ bool next(int i, Unit& u) const {
        long L = (long)i * G + c; if (single >= 0) { if (i > 0) return false; L = single; } else if (i >= imax) return false;
        if (L >= nwg + nctx) return false;
        if (L >= nwg) { const int idx = (int)L - nwg, q = idx / 7, t = idx - q * 7;
            u.pm = q * 17; u.pn = (t == 0) ? 1 : (t == 1) ? 2 : (t == 2) ? 4 : (t == 3) ? 7 : (t == 4) ? 8 : (t == 5) ? 9 : 11; u.z = 0; return true; }
        int wgid = (int)L; { const int q = nwg / NXCD, r = nwg % NXCD, xcd = wgid % NXCD, off = wgid / NXCD; wgid = (xcd < r ? xcd * (q + 1) : r * (q + 1) + (xcd - r) * q) + off; }
        const int nig = WGM * nN, gid = wgid / nig, fm = gid * WGM, gsz = (nM - fm) < WGM ? (nM - fm) : WGM;
        int pm = fm + ((wgid % nig) % gsz); u.pn = (wgid % nig) / gsz + pn_off; u.z = 0;
        if (skipctx) pm = (pm >> 4) * 17 + 1 + (pm & 15);
        u.pm = pm; return true;
    }
    __device__ __forceinline__ const char* abase(const Unit& u) const { return A + (size_t)u.pm * tstep; }
    __device__ __forceinline__ const char* bbase(const Unit& u) const { return Bt + (size_t)(u.pn - pn_off) * tstep; }
};
typedef DenseOrderT<false> DenseOrder;

template <class Epi, class Sched, bool ALIGN = true>
__device__ __forceinline__ void gemm_phase(LAS unsigned char* lds, const int tid, const int K, const Sched& S, const Epi& E) {
    const int wid = __builtin_amdgcn_readfirstlane(tid >> 6), lane = tid & 63, wr = wid >> 2, wc = wid & 3, fr = lane & 15, fq = lane >> 4;
    constexpr bool F8 = Sched::FP8;
    const int RB = F8 ? K : 2 * K;
    const int nt = RB / 128;
    unsigned voffA[2], voffB[2];
#pragma unroll
    for (int i = 0; i < 2; ++i) { int R, C; stage_rc(tid * 16 + i * 8192, R, C); const int Rb = (R & ~31) + perm32(R & 31);
        voffA[i] = (unsigned)(R * RB + C * 2); voffB[i] = (unsigned)(Rb * RB + C * 2); }
    const size_t kstep = (size_t)(BK * 2);
    const size_t hstep = (size_t)HALF * RB;
    int Rst[2], Cst[2];
#pragma unroll
    for (int i = 0; i < 2; ++i) stage_rc(tid * 16 + i * 8192, Rst[i], Cst[i]);
    unsigned gA[2][2], ngA[2][2];
    const unsigned ldsw = (unsigned)wid * 1024u;
    const int aoff = lds_byte(wr * 64 + fr, fq * 8), boff = lds_byte(wc * 32 + fr, fq * 8);
#define PG8_SA(b, h) (((b) * 2 + (h)) * HTB)
#define PG8_SB(b, h) ((4 + (b) * 2 + (h)) * HTB)
#define PG8_STAGE(bufoff, gbase, voff) do { _Pragma("unroll") for (int _i = 0; _i < 2; ++_i) \
        __builtin_amdgcn_global_load_lds((const unsigned*)((const char*)(gbase) + (voff)[_i]), (LAS unsigned*)(lds + (bufoff) + ldsw + _i * 8192), 16, 0, 0); } while (0)
#define PG8_GLOAD(dst, u_) do { if constexpr (Sched::GATHER) { _Pragma("unroll") for (int _h = 0; _h < 2; ++_h) _Pragma("unroll") for (int _i = 0; _i < 2; ++_i) \
        dst[_h][_i] = (unsigned)S.arow((u_), _h * HALF + Rst[_i]) * (unsigned)RB + (unsigned)(Cst[_i] * 2); } } while (0)
#define PG8_STAGE_A(bufoff, gbase, h_, nx_) do { if constexpr (Sched::GATHER) { _Pragma("unroll") for (int _i = 0; _i < 2; ++_i) \
        __builtin_amdgcn_global_load_lds((const unsigned*)((const char*)(gbase) + ((nx_) ? ngA[h_][_i] : gA[h_][_i])), (LAS unsigned*)(lds + (bufoff) + ldsw + _i * 8192), 16, 0, 0); } \
        else PG8_STAGE(bufoff, (gbase) + (h_) * hstep, voffA); } while (0)
#define PG8_LD32(p_) __builtin_shufflevector(*(const LAS v4i_t*)(p_), *(const LAS v4i_t*)((p_) + 1024), 0, 1, 2, 3, 4, 5, 6, 7)
#define PG8_LDA(dst, b, h) do { if constexpr (F8) { _Pragma("unroll") for (int m = 0; m < 4; ++m) dst##8[m] = PG8_LD32(lds + PG8_SA(b, h) + aoff + m * 2048); } \
        else { _Pragma("unroll") for (int m = 0; m < 4; ++m) _Pragma("unroll") for (int k = 0; k < 2; ++k) dst[m][k] = *(const LAS bf16x8*)(lds + PG8_SA(b, h) + aoff + m * 2048 + k * 1024); } } while (0)
#define PG8_LDB(dst, b, h) do { if constexpr (F8) { _Pragma("unroll") for (int n = 0; n < 2; ++n) dst##8[n] = PG8_LD32(lds + PG8_SB(b, h) + boff + n * 2048); } \
        else { _Pragma("unroll") for (int n = 0; n < 2; ++n) _Pragma("unroll") for (int k = 0; k < 2; ++k) dst[n][k] = *(const LAS bf16x8*)(lds + PG8_SB(b, h) + boff + n * 2048 + k * 1024); } } while (0)
#define PG8_MMA(ai, bj, At, Bt) do { __builtin_amdgcn_s_setprio(1); _Pragma("unroll") for (int m = 0; m < 4; ++m) _Pragma("unroll") for (int n = 0; n < 2; ++n) { \
        if constexpr (F8) asm volatile("v_mfma_scale_f32_16x16x128_f8f6f4 %0, %1, %2, %0, %3, %4 op_sel_hi:[0,0,0]" : "+v"(acc[ai][bj][m][n]) : "v"(Bt##8[n]), "v"(At##8[m]), "v"(sclw), "v"(sclx)); \
        else { _Pragma("unroll") for (int k = 0; k < 2; ++k) acc[ai][bj][m][n] = __builtin_amdgcn_mfma_f32_16x16x32_bf16(Bt[n][k], At[m][k], acc[ai][bj][m][n], 0, 0, 0); } } \
        __builtin_amdgcn_s_setprio(0); } while (0)
#define PG8_WAIT_V(n) asm volatile("s_waitcnt vmcnt(" #n ")" ::: "memory")
#define PG8_WAIT_L(n) asm volatile("s_waitcnt lgkmcnt(" #n ")" ::: "memory")
#define PG8_BAR __builtin_amdgcn_s_barrier()
#define PG8_SCHED __builtin_amdgcn_sched_barrier(0)
    Unit cur, nxt; int ui = 0;
    if (!S.next(0, cur)) return;
    f32x4 acc[2][2][4][2];
#pragma unroll
    for (int a = 0; a < 2; ++a)
#pragma unroll
        for (int b = 0; b < 2; ++b)
#pragma unroll
            for (int m = 0; m < 4; ++m)
#pragma unroll
                for (int n = 0; n < 2; ++n) acc[a][b][m][n] = (f32x4){0.f, 0.f, 0.f, 0.f};
    bf16x8 At[4][2], B0[2][2], B1[2][2];
    v8i_t At8[4], B08[2], B18[2];
    const int sclw = S.scale_w(), sclx = S.scale_x();
    const char* cA = S.abase(cur); const char* cB = S.bbase(cur);
    PG8_GLOAD(gA, cur);
    if constexpr (Sched::GATHER) { _Pragma("unroll") for (int _h = 0; _h < 2; ++_h) _Pragma("unroll") for (int _i = 0; _i < 2; ++_i) ngA[_h][_i] = gA[_h][_i]; asm volatile("s_waitcnt vmcnt(0)" ::: "memory"); }
    PG8_STAGE(PG8_SB(0, 0), cB, voffB); PG8_STAGE(PG8_SB(0, 1), cB + hstep, voffB); PG8_STAGE_A(PG8_SA(0, 0), cA, 0, false); PG8_STAGE_A(PG8_SA(0, 1), cA, 1, false);
    if (wr == 1) PG8_BAR;
    PG8_WAIT_V(2); PG8_BAR;
    PG8_STAGE(PG8_SB(1, 0), cB + kstep, voffB); PG8_STAGE_A(PG8_SA(1, 0), cA + kstep, 0, false); PG8_STAGE(PG8_SB(1, 1), cB + hstep + kstep, voffB);
    PG8_WAIT_V(6); PG8_BAR;
    for (;;) {
        const bool has_next = S.next(ui + 1, nxt);
        const char* nA = has_next ? S.abase(nxt) : cA; const char* nB = has_next ? S.bbase(nxt) : cB;
        int rawn[2][2];
        if constexpr (Sched::GATHER) { if (has_next) { _Pragma("unroll") for (int _h = 0; _h < 2; ++_h) _Pragma("unroll") for (int _i = 0; _i < 2; ++_i) rawn[_h][_i] = S.araw(nxt, _h * HALF + Rst[_i]); } }
#pragma unroll 1
        for (int t = 0; t < nt; t += 2) {
            const bool last = (t == nt - 2);
            const char* a1 = cA + (size_t)(t + 1) * kstep;
            const char* a2 = last ? nA : cA + (size_t)(t + 2) * kstep; const char* b2 = last ? nB : cB + (size_t)(t + 2) * kstep;
            const char* a3 = a2 + kstep; const char* b3 = b2 + kstep;
            if constexpr (Sched::GATHER) { if (last && has_next) { _Pragma("unroll") for (int _h = 0; _h < 2; ++_h) _Pragma("unroll") for (int _i = 0; _i < 2; ++_i)
                ngA[_h][_i] = (unsigned)(rawn[_h][_i] < 0 ? 0 : rawn[_h][_i] >> 2) * (unsigned)RB + (unsigned)(Cst[_i] * 2); } }
            PG8_LDB(B0, 0, 0); PG8_LDB(B1, 0, 1); PG8_SCHED; PG8_LDA(At, 0, 0); PG8_STAGE_A(PG8_SA(1, 1), a1, 1, false);
            PG8_WAIT_V(8); PG8_WAIT_L(0); PG8_BAR; PG8_MMA(0, 0, At, B0); PG8_MMA(0, 1, At, B1); PG8_BAR; PG8_SCHED;
            PG8_LDA(At, 0, 1); PG8_STAGE(PG8_SB(0, 0), b2, voffB); PG8_STAGE(PG8_SB(0, 1), b2 + hstep, voffB); PG8_STAGE_A(PG8_SA(0, 0), a2, 0, last);
            PG8_WAIT_V(8); PG8_WAIT_L(0); PG8_BAR; PG8_MMA(1, 0, At, B0); PG8_MMA(1, 1, At, B1); PG8_BAR; PG8_SCHED;
            PG8_LDB(B0, 1, 0); PG8_LDB(B1, 1, 1); PG8_SCHED; PG8_LDA(At, 1, 0); PG8_STAGE_A(PG8_SA(0, 1), a2, 1, last);
            PG8_WAIT_V(8); PG8_WAIT_L(0); PG8_BAR; PG8_MMA(0, 0, At, B0); PG8_MMA(0, 1, At, B1); PG8_BAR; PG8_SCHED;
            PG8_LDA(At, 1, 1); PG8_STAGE(PG8_SB(1, 0), b3, voffB); PG8_STAGE(PG8_SB(1, 1), b3 + hstep, voffB); PG8_STAGE_A(PG8_SA(1, 0), a3, 0, last);
            PG8_WAIT_V(8); PG8_WAIT_L(0); PG8_BAR; PG8_MMA(1, 0, At, B0); PG8_MMA(1, 1, At, B1); PG8_BAR; PG8_SCHED;
        }
        if (ALIGN) { if (wr == 0) PG8_BAR; }
        bool keep = false;
        if constexpr (F8) asm volatile("s_nop 15\n\ts_nop 15" ::: "memory");
        { int tz = tid; asm volatile("" : "+v"(tz)); const int wid2 = __builtin_amdgcn_readfirstlane(tz >> 6), lane2 = tz & 63;
          if constexpr (Epi::CHAIN) keep = E(acc, cur, wid2 >> 2, wid2 & 3, lane2 & 15, lane2 >> 4); else { E(acc, cur, wid2 >> 2, wid2 & 3, lane2 & 15, lane2 >> 4); if constexpr (Epi::TWICE) { asm volatile("" ::: "memory"); E(acc, cur, wid2 >> 2, wid2 & 3, lane2 & 15, lane2 >> 4); } } }
        if (!has_next) break;
        if (!keep)
#pragma unroll
        for (int a = 0; a < 2; ++a)
#pragma unroll
            for (int b = 0; b < 2; ++b)
#pragma unroll
                for (int m = 0; m < 4; ++m)
#pragma unroll
                    for (int n = 0; n < 2; ++n) acc[a][b][m][n] = (f32x4){0.f, 0.f, 0.f, 0.f};
        cur = nxt; cA = nA; cB = nB; ++ui;
        if constexpr (Sched::GATHER) { _Pragma("unroll") for (int _h = 0; _h < 2; ++_h) _Pragma("unroll") for (int _i = 0; _i < 2; ++_i) gA[_h][_i] = ngA[_h][_i]; }
        if (ALIGN) { if (wr == 1) PG8_BAR; }
    }
    PG8_WAIT_V(0);
    if (!ALIGN) { if (wr == 0) PG8_BAR; }
    PG8_BAR;
#undef PG8_SA
#undef PG8_SB
#undef PG8_STAGE
#undef PG8_STAGE_A
#undef PG8_GLOAD
#undef PG8_LDA
#undef PG8_LDB
#undef PG8_MMA
#undef PG8_LD32
#undef PG8_WAIT_V
#undef PG8_WAIT_L
#undef PG8_BAR
#undef PG8_SCHED
}
}
using pg8::Unit;
typedef f32x4 AccT[2][2][4][2];

__device__ __forceinline__ u32x4 pack8(const f32x4 v0, const f32x4 v1) { u32x4 w; w.x = cvt_pk(v0[0], v0[1]); w.y = cvt_pk(v0[2], v0[3]); w.z = cvt_pk(v1[0], v1[1]); w.w = cvt_pk(v1[2], v1[3]); return w; }
constexpr float YSCL = 16.f;
__device__ __forceinline__ u32x2 pack8f8(const f32x4 v0, const f32x4 v1) { int w0 = 0, w1 = 0;
    w0 = __builtin_amdgcn_cvt_pk_fp8_f32(v0[0], v0[1], w0, false); w0 = __builtin_amdgcn_cvt_pk_fp8_f32(v0[2], v0[3], w0, true);
    w1 = __builtin_amdgcn_cvt_pk_fp8_f32(v1[0], v1[1], w1, false); w1 = __builtin_amdgcn_cvt_pk_fp8_f32(v1[2], v1[3], w1, true); return (u32x2){(unsigned)w0, (unsigned)w1}; }
__device__ __forceinline__ void unpack8f8(const u32x2 w, f32x4& v0, f32x4& v1) {
    const f32x2 a = __builtin_amdgcn_cvt_pk_f32_fp8((int)w.x, false), b = __builtin_amdgcn_cvt_pk_f32_fp8((int)w.x, true), c = __builtin_amdgcn_cvt_pk_f32_fp8((int)w.y, false), d = __builtin_amdgcn_cvt_pk_f32_fp8((int)w.y, true);
    v0 = (f32x4){a[0], a[1], b[0], b[1]}; v1 = (f32x4){c[0], c[1], d[0], d[1]}; }
__device__ __forceinline__ void unpack8(const u32x4 w, f32x4& v0, f32x4& v1) { v0 = (f32x4){bf_lo(w.x), bf_hi(w.x), bf_lo(w.y), bf_hi(w.y)}; v1 = (f32x4){bf_lo(w.z), bf_hi(w.z), bf_lo(w.w), bf_hi(w.w)}; }

struct EpiTiles {
    static constexpr bool CHAIN = false, TWICE = (PROBE_REP & 1024) != 0;
    bf16_t* P; const float* bgate;
    __device__ __forceinline__ void operator()(const AccT& acc, const Unit& u, int wr, int wc, int fr, int fq) const {
        bf16_t* base = P + (size_t)u.pn * ((size_t)NR * 256) + (size_t)(u.pm * 256 + wr * 64 + fr) * 256 + wc * 32 + 8 * fq;
        if (u.pn < T_GATE) {
#pragma unroll
            for (int ai = 0; ai < 2; ++ai)
#pragma unroll
                for (int m = 0; m < 4; ++m)
#pragma unroll
                    for (int bj = 0; bj < 2; ++bj)
                        *(u32x4*)(base + (size_t)(ai * 128 + m * 16) * 256 + bj * 128) = pack8(acc[ai][bj][m][0], acc[ai][bj][m][1]);
        } else {
            unsigned char* gb = (unsigned char*)(P + (size_t)u.pn * ((size_t)NR * 256)) + (size_t)u.pm * 65536 + (((wr * 4 + wc) * 64 + fq * 16 + fr) * 16);
            const float* bg = bgate + ((u.pn - T_GATE) >> 2) * 1024 + ((u.pn - T_GATE) & 3) * 256 + wc * 32 + 8 * fq;
#pragma unroll
            for (int bj = 0; bj < 2; ++bj) {
                const f32x4 b0 = *(const f32x4*)(bg + bj * 128) * -LOG2E, b1 = *(const f32x4*)(bg + bj * 128 + 4) * -LOG2E;
#define GATE255(a_, b_) __builtin_amdgcn_rcpf(__builtin_fmaf(__builtin_amdgcn_exp2f(__builtin_fmaf((a_), -LOG2E, (b_))), 1.f / 255.f, 1.f / 255.f))
#pragma unroll
                for (int ai = 0; ai < 2; ++ai)
#pragma unroll
                    for (int mp = 0; mp < 2; ++mp) {
                        u32x4 o = (u32x4){0u, 0u, 0u, 0u};
#pragma unroll
                        for (int j = 0; j < 4; ++j) {
                            o.x = __builtin_amdgcn_cvt_pk_u8_f32(GATE255(acc[ai][bj][2 * mp][0][j], b0[j]), j, o.x); o.y = __builtin_amdgcn_cvt_pk_u8_f32(GATE255(acc[ai][bj][2 * mp][1][j], b1[j]), j, o.y);
                            o.z = __builtin_amdgcn_cvt_pk_u8_f32(GATE255(acc[ai][bj][2 * mp + 1][0][j], b0[j]), j, o.z); o.w = __builtin_amdgcn_cvt_pk_u8_f32(GATE255(acc[ai][bj][2 * mp + 1][1][j], b1[j]), j, o.w); }
#undef GATE255
                        o.x |= 0x01010101u; o.y |= 0x01010101u; o.z |= 0x01010101u; o.w |= 0x01010101u;
                        *(u32x4*)(gb + ((bj * 2 + ai) * 2 + mp) * 8192) = o;
                    }
            }
        }
    }
};

struct MergeOrder {
    static constexpr bool GATHER = false, FP8 = false;
    __device__ __forceinline__ int scale_w() const { return 0; }
    __device__ __forceinline__ int scale_x() const { return 0; }
    __device__ __forceinline__ int arow(const Unit&, int) const { return 0; }
    __device__ __forceinline__ int araw(const Unit&, int) const { return 0; }
    int G, c, ntile; bool skipctx; const char* P; const char* Wbr;
    __device__ bool next(int i, Unit& u) const {
        const int w = (i >> 2) * (G >> 3) + (c >> 3); if (w >= (ntile >> 3)) return false;
        int pm = (c & 7) + 8 * (w >> 2); u.pn = w & 3; u.z = i & 3;
        if (skipctx) pm = (pm >> 4) * 17 + 1 + (pm & 15);
        u.pm = pm; return true;
    }
    __device__ __forceinline__ const char* abase(const Unit& u) const { const int tz = (u.z == 0) ? T_AQ : (u.z == 1) ? T_GQ : (u.z == 2) ? T_MU : T_DG; return P + (size_t)tz * PT_BYTES + (size_t)u.pm * (256 * 256 * 2); }
    __device__ __forceinline__ const char* bbase(const Unit& u) const { return Wbr + (size_t)u.z * (1024 * 256 * 2) + (size_t)u.pn * (256 * 256 * 2); }
};
struct EpiMerge {
    static constexpr bool CHAIN = true, TWICE = false;
    const bf16_t* P; bf16_t* merged;
    __device__ __forceinline__ bool operator()(AccT& acc, const Unit& u, int wr, int wc, int fr, int fq) const {
        const int row0 = u.pm * 256 + wr * 64 + fr, colt = wc * 32 + 8 * fq;
        const unsigned char* g0p = (const unsigned char*)(P + (size_t)(T_GATE + 4 * u.z + u.pn) * ((size_t)NR * 256)) + (size_t)u.pm * 65536 + (((wr * 4 + wc) * 64 + fq * 16 + fr) * 16);
        if (u.z < 3) {
            const unsigned char* g1p = g0p + (size_t)4 * PT_BYTES;
            u32x4 ga[2][2], gb[2][2];
#pragma unroll
            for (int q = 0; q < 2; ++q)
#pragma unroll
                for (int h = 0; h < 2; ++h) { ga[q][h] = *(const u32x4*)(g0p + (2 * q + h) * 8192); gb[q][h] = *(const u32x4*)(g1p + (2 * q + h) * 8192); }
#pragma unroll
            for (int q = 0; q < 4; ++q) {
                const int bj = q >> 1, ai = q & 1;
#pragma unroll
                for (int m = 0; m < 4; ++m) {
                    const u32x4 A = ga[q & 1][m >> 1], B = gb[q & 1][m >> 1];
                    const unsigned a0 = (m & 1) ? A.z : A.x, a1 = (m & 1) ? A.w : A.y, b0 = (m & 1) ? B.z : B.x, b1 = (m & 1) ? B.w : B.y;
#pragma unroll
                    for (int j = 0; j < 4; ++j) {
                        acc[ai][bj][m][0][j] *= (float)((a0 >> (8 * j)) & 0xffu) * __builtin_amdgcn_rcpf((float)((b0 >> (8 * j)) & 0xffu));
                        acc[ai][bj][m][1][j] *= (float)((a1 >> (8 * j)) & 0xffu) * __builtin_amdgcn_rcpf((float)((b1 >> (8 * j)) & 0xffu));
                    }
                }
                if (q < 2) {
#pragma unroll
                    for (int h = 0; h < 2; ++h) { ga[q & 1][h] = *(const u32x4*)(g0p + (2 * (q + 2) + h) * 8192); gb[q & 1][h] = *(const u32x4*)(g1p + (2 * (q + 2) + h) * 8192); }
                }
            }
            return true;
        }
        u32x4 ga[8];
#pragma unroll
        for (int i = 0; i < 8; ++i) ga[i] = *(const u32x4*)(g0p + i * 8192);
        bf16_t* mp = merged + (size_t)row0 * 1024 + u.pn * 256 + colt;
#pragma unroll
        for (int bj = 0; bj < 2; ++bj)
#pragma unroll
            for (int ai = 0; ai < 2; ++ai)
#pragma unroll
                for (int m = 0; m < 4; ++m) {
                    const int i = (bj * 2 + ai) * 2 + (m >> 1);
                    const unsigned a0 = (m & 1) ? ga[i].z : ga[i].x, a1 = (m & 1) ? ga[i].w : ga[i].y;
                    f32x4 o0, o1;
#pragma unroll
                    for (int j = 0; j < 4; ++j) { o0[j] = acc[ai][bj][m][0][j] * ((float)((a0 >> (8 * j)) & 0xffu) * (1.f / 255.f)); o1[j] = acc[ai][bj][m][1][j] * ((float)((a1 >> (8 * j)) & 0xffu) * (1.f / 255.f)); }
                    *(u32x4*)(mp + (size_t)(ai * 128 + m * 16) * 1024 + bj * 128) = pack8(o0, o1);
                }
        return false;
    }
};

struct EpiWo {
    static constexpr bool CHAIN = false, TWICE = false;
    const float* xin_lat; const float* xin_ctx; bf16_t* xb; const float* mod_l;
    int which;
    __device__ __forceinline__ void operator()(const AccT& acc, const Unit& u, int wr, int wc, int fr, int fq) const {
        const int b = u.pm / 17, j = u.pm - b * 17; const bool isctx = (j == 0);
        const float* gv = mod_l + (size_t)(isctx ? 16 : b) * 6144 + which * 1024 + u.pn * 256 + wc * 32 + 8 * fq;
        const int r0 = wr * 64 + fr; const int c0 = u.pn * 256 + wc * 32 + 8 * fq;
        bf16_t* xo = xb + (size_t)u.pm * 256 * 1024;
        if (xin_lat != nullptr) {
            const float* xin = isctx ? xin_ctx + (size_t)b * 256 * 1024 : xin_lat + ((size_t)b * 4096 + (size_t)(j - 1) * 256) * 1024;
#pragma unroll
            for (int bj = 0; bj < 2; ++bj) {
                const f32x4 g0 = *(const f32x4*)(gv + bj * 128), g1 = *(const f32x4*)(gv + bj * 128 + 4);
#pragma unroll
                for (int ai = 0; ai < 2; ++ai)
#pragma unroll
                    for (int m = 0; m < 4; ++m) {
                        const size_t off = (size_t)(r0 + ai * 128 + m * 16) * 1024 + c0 + bj * 128;
                        const f32x4 x0 = *(const f32x4*)(xin + off), x1 = *(const f32x4*)(xin + off + 4);
                        *(u32x4*)(xo + off) = pack8(x0 + g0 * acc[ai][bj][m][0], x1 + g1 * acc[ai][bj][m][1]);
                    }
            }
        } else {
#pragma unroll
            for (int bj = 0; bj < 2; ++bj) {
                const f32x4 g0 = *(const f32x4*)(gv + bj * 128), g1 = *(const f32x4*)(gv + bj * 128 + 4);
#pragma unroll
                for (int ai = 0; ai < 2; ++ai)
#pragma unroll
                    for (int m = 0; m < 4; ++m) {
                        const size_t off = (size_t)(r0 + ai * 128 + m * 16) * 1024 + c0 + bj * 128;
                        f32x4 x0, x1; unpack8(*(const u32x4*)(xo + off), x0, x1);
                        *(u32x4*)(xo + off) = pack8(x0 + g0 * acc[ai][bj][m][0], x1 + g1 * acc[ai][bj][m][1]);
                    }
            }
        }
    }
};

template <int NPN, bool GATH>
struct MoeOrder {
    static constexpr bool GATHER = GATH, FP8 = true;
    __device__ __forceinline__ int scale_w() const { return 0x7a7a7a7a; }
    __device__ __forceinline__ int scale_x() const { return 0x7f7f7f7f; }
    int G, c, nunits; const LAS int* texp; const char* A; const char* W; size_t wstride; const int* rowmap;
    __device__ __forceinline__ int arow(const Unit& u, int r) const { const int rm = rowmap[u.pm * 256 + r]; return rm < 0 ? 0 : rm >> 2; }
    __device__ __forceinline__ int araw(const Unit& u, int r) const { return rowmap[u.pm * 256 + r]; }
    __device__ bool next(int i, Unit& u) const {
        constexpr int RT = 32 / NPN;
        const int xcd = c & 7, idx = c >> 3, rt = idx / NPN;
        const int pm = (i * RT + rt) * 8 + xcd; if (pm * NPN >= nunits) return false;
        u.pm = pm; u.pn = idx % NPN; u.z = texp[pm]; return true;
    }
    __device__ __forceinline__ const char* abase(const Unit& u) const { return GATH ? A : A + (size_t)u.pm * (256 * 1024); }
    __device__ __forceinline__ const char* bbase(const Unit& u) const { return W + (size_t)u.z * wstride + (size_t)u.pn * (256 * 1024); }
};
struct EpiUp {
    static constexpr bool CHAIN = false, TWICE = false;
    const float* bup; unsigned char* act;
    __device__ __forceinline__ void operator()(const AccT& acc, const Unit& u, int wr, int wc, int fr, int fq) const {
        const int colt = u.pn * 128 + wc * 32 + 8 * fq;
        const float* bb = bup + (size_t)u.z * 2048 + colt;
        const f32x4 bg0 = *(const f32x4*)(bb), bg1 = *(const f32x4*)(bb + 4), bl0 = *(const f32x4*)(bb + 1024) + 1.f, bl1 = *(const f32x4*)(bb + 1028) + 1.f;
        unsigned char* base = act + (size_t)(u.pm * 256 + wr * 64 + fr) * 1024 + colt;
#pragma unroll
        for (int ai = 0; ai < 2; ++ai)
#pragma unroll
            for (int m = 0; m < 4; ++m) {
                f32x4 o0, o1;
#pragma unroll
                for (int j = 0; j < 4; ++j) {
                    float g = fminf(acc[ai][0][m][0][j] + bg0[j], 7.f), li = fminf(fmaxf(acc[ai][1][m][0][j] + bl0[j], -6.f), 8.f);
                    o0[j] = g * sigmoidf_(1.702f * g) * li;
                    g = fminf(acc[ai][0][m][1][j] + bg1[j], 7.f); li = fminf(fmaxf(acc[ai][1][m][1][j] + bl1[j], -6.f), 8.f);
                    o1[j] = g * sigmoidf_(1.702f * g) * li;
                }
                int w0 = 0, w1 = 0;
                w0 = __builtin_amdgcn_cvt_pk_fp8_f32(o0[0], o0[1], w0, false); w0 = __builtin_amdgcn_cvt_pk_fp8_f32(o0[2], o0[3], w0, true);
                w1 = __builtin_amdgcn_cvt_pk_fp8_f32(o1[0], o1[1], w1, false); w1 = __builtin_amdgcn_cvt_pk_fp8_f32(o1[2], o1[3], w1, true);
                *(u32x2*)(base + (size_t)(ai * 128 + m * 16) * 1024) = (u32x2){(unsigned)w0, (unsigned)w1};
            }
    }
};
struct EpiDown {
    static constexpr bool CHAIN = false, TWICE = false;
    const float* bdn; const float* gslot; unsigned char* ybuf;
    __device__ __forceinline__ void operator()(const AccT& acc, const Unit& u, int wr, int wc, int fr, int fq) const {
        const int colt = u.pn * 256 + wc * 32 + 8 * fq;
        const float* bb = bdn + (size_t)u.z * 1024 + colt;
        const f32x4 b00 = *(const f32x4*)(bb), b01 = *(const f32x4*)(bb + 4), b10 = *(const f32x4*)(bb + 128), b11 = *(const f32x4*)(bb + 132);
        const int row0 = u.pm * 256 + wr * 64 + fr;
        float gtv[2][4];
#pragma unroll
        for (int ai = 0; ai < 2; ++ai)
#pragma unroll
            for (int m = 0; m < 4; ++m) gtv[ai][m] = gslot[row0 + ai * 128 + m * 16];
#pragma unroll
        for (int ai = 0; ai < 2; ++ai)
#pragma unroll
            for (int m = 0; m < 4; ++m) {
                const float gt = gtv[ai][m] * YSCL;
                unsigned char* yp = ybuf + (size_t)(row0 + ai * 128 + m * 16) * 1024 + colt;
                *(u32x2*)(yp) = pack8f8((acc[ai][0][m][0] + b00) * gt, (acc[ai][0][m][1] + b01) * gt);
                *(u32x2*)(yp + 128) = pack8f8((acc[ai][1][m][0] + b10) * gt, (acc[ai][1][m][1] + b11) * gt);
            }
    }
};
__device__ __forceinline__ void xpose_tile(const float* __restrict__ src, int ld, int valid, bf16_t* __restrict__ dst, int Kd, LAS float* scr, int lane) {
    const int c4 = (lane & 15) * 4, kr = lane >> 4;
    f32x4 v[16];
#pragma unroll
    for (int i = 0; i < 16; ++i) v[i] = (c4 < valid) ? *(const f32x4*)(src + (size_t)(i * 4 + kr) * ld + c4) : (f32x4){0.f, 0.f, 0.f, 0.f};
#pragma unroll
    for (int i = 0; i < 16; ++i) { LAS float* s = scr + (i * 4 + kr) * 65 + c4; s[0] = v[i][0]; s[1] = v[i][1]; s[2] = v[i][2]; s[3] = v[i][3]; }
    LDS_WAIT(); asm volatile("" ::: "memory");
    const int c = lane & 7;
#pragma unroll
    for (int j = 0; j < 8; ++j) { const int n = (lane >> 3) + 8 * j; const LAS float* s = scr + (8 * c) * 65 + n;
        u32x4 o; o.x = cvt_pk(s[0 * 65], s[1 * 65]); o.y = cvt_pk(s[2 * 65], s[3 * 65]); o.z = cvt_pk(s[4 * 65], s[5 * 65]); o.w = cvt_pk(s[6 * 65], s[7 * 65]);
        *(u32x4*)(dst + (size_t)n * Kd + 8 * c) = o; }
    LDS_WAIT(); asm volatile("" ::: "memory");
}

__device__ __forceinline__ void xpose_tile8(const float* __restrict__ src, int ld, unsigned char* __restrict__ dst, int Kd, LAS float* scr, int lane) {
    const int c4 = (lane & 7) * 4, kr = lane >> 3;
    const float* sp = src + (size_t)kr * ld + c4; const size_t rstep = (size_t)8 * ld;
    f32x4 v[16];
#pragma unroll
    for (int i = 0; i < 16; ++i) v[i] = *(const f32x4*)(sp + i * rstep);
    LAS float* sw = scr + kr * 33 + c4;
#pragma unroll
    for (int i = 0; i < 16; ++i) { LAS float* s = sw + i * (8 * 33); s[0] = v[i][0]; s[1] = v[i][1]; s[2] = v[i][2]; s[3] = v[i][3]; }
    LDS_WAIT(); asm volatile("" ::: "memory");
    const int c = lane & 7;
#pragma unroll
    for (int j = 0; j < 4; ++j) { const int n = (lane >> 3) + 8 * j; const LAS float* s = scr + (16 * c) * 33 + n;
#define F8W(q_) __builtin_amdgcn_cvt_pk_fp8_f32(s[(4 * (q_) + 2) * 33] * 32.f, s[(4 * (q_) + 3) * 33] * 32.f, __builtin_amdgcn_cvt_pk_fp8_f32(s[(4 * (q_)) * 33] * 32.f, s[(4 * (q_) + 1) * 33] * 32.f, 0, false), true)
        const int w0 = F8W(0), w1 = F8W(1), w2 = F8W(2), w3 = F8W(3);
#undef F8W
        *(u32x4*)(dst + (size_t)n * Kd + 16 * c) = (u32x4){(unsigned)w0, (unsigned)w1, (unsigned)w2, (unsigned)w3}; }
    LDS_WAIT(); asm volatile("" ::: "memory");
}

__device__ __forceinline__ void p_prologue(const Frame& F, const Args& a) {
    LAS float* scr = (LAS float*)(F.lds + F.wave * 16896);
    const int gw = F.blk * 8 + F.wave, NGW = GRID * 8;
    constexpr int N_IN = 16 * 112, N_BR = 4 * 4 * 16, N_O = 256, N_UP = 32 * 16 * 32, N_DN = 32 * 16 * 16, N_L = N_IN + N_BR + N_O + N_UP + N_DN;
    for (int it = gw; it < 2 * N_L; it += NGW) {
        const int l = it / N_L; int r = it - l * N_L;
        if (r < N_IN) {
            const int kt = r / 112, ntile = r - kt * 112, n0 = ntile * 64;
            int src0, valid;
            if (n0 < 2816) { src0 = n0; valid = 64; } else if (n0 == 2816) { src0 = 2816; valid = 16; } else if (n0 < 3072) { src0 = 0; valid = 0; } else { src0 = n0 - 240; valid = 64; }
            if (n0 < 3072) xpose_tile(F.in[I_WIN] + (size_t)l * 1024 * 6928 + (size_t)(kt * 64) * 6928 + src0, 6928, valid,
                       (bf16_t*)(F.ws + WS_WIN) + (size_t)l * 7168 * 1024 + (size_t)n0 * 1024 + kt * 64, 1024, scr, F.lane);
            else { const int k8 = (kt >> 1) * 128, ns = (kt & 1) * 32;
                xpose_tile8(F.in[I_WIN] + (size_t)l * 1024 * 6928 + (size_t)k8 * 6928 + src0 + ns, 6928,
                       (unsigned char*)(F.ws + WS_WG8) + (size_t)l * 4096 * 1024 + (size_t)(n0 - 3072 + ns) * 1024 + k8, 1024, scr, F.lane); }
            continue; }
        r -= N_IN;
        if (r < N_BR) {
            const int n = r >> 6, rr = r & 63, kt = rr >> 4, ntile = rr & 15;
            xpose_tile(F.in[I_WBR] + ((size_t)(l * 4 + n) * 256 + kt * 64) * 1024 + ntile * 64, 1024, 64,
                       (bf16_t*)(F.ws + WS_WBR) + (size_t)(l * 4 + n) * 1024 * 256 + (size_t)(ntile * 64) * 256 + kt * 64, 256, scr, F.lane);
            continue; }
        r -= N_BR;
        if (r < N_O) {
            const int kt = r >> 4, ntile = r & 15;
            xpose_tile(F.in[I_WO] + ((size_t)l * 1024 + kt * 64) * 1024 + ntile * 64, 1024, 64,
                       (bf16_t*)(F.ws + WS_WO) + (size_t)l * 1024 * 1024 + (size_t)(ntile * 64) * 1024 + kt * 64, 1024, scr, F.lane);
            continue; }
        r -= N_O;
        if (r < N_UP) {
            const int e = r >> 9, rr = r & 511, kt = rr >> 5, ntile = rr & 31, k8 = (kt >> 1) * 128, n0 = ntile * 64 + (kt & 1) * 32;
            const int j = n0 >> 8, w = n0 & 255, src0 = (w < 128) ? (128 * j + w) : (1024 + 128 * j + (w - 128));
            xpose_tile8(F.in[I_WUP] + ((size_t)(l * 32 + e) * 1024 + k8) * 2048 + src0, 2048,
                        (unsigned char*)(F.ws + WS_WUP) + (size_t)(l * 32 + e) * 2048 * 1024 + (size_t)n0 * 1024 + k8, 1024, scr, F.lane);
            continue; }
        r -= N_UP;
        {
            const int e = r >> 8, rr = r & 255, kt = rr >> 4, ntile = rr & 15, k8 = (kt >> 1) * 128, n0 = ntile * 64 + (kt & 1) * 32;
            xpose_tile8(F.in[I_WDN] + ((size_t)(l * 32 + e) * 1024 + k8) * 1024 + n0, 1024,
                        (unsigned char*)(F.ws + WS_WDN) + (size_t)(l * 32 + e) * 1024 * 1024 + (size_t)n0 * 1024 + k8, 1024, scr, F.lane);
        }
    }
    { const int gt = F.blk * 512 + F.tid, NT = GRID * 512; const float* s = F.in[I_GMWS]; bf16_t* d = (bf16_t*)(F.ws + WS_GMWS);
      for (int i = gt; i < 2 * 4 * 128 * 128 / 4; i += NT) { const f32x4 v = *(const f32x4*)(s + (size_t)i * 4); u32x2 o; o.x = cvt_pk(v[0], v[1]); o.y = cvt_pk(v[2], v[3]); *(u32x2*)(d + (size_t)i * 4) = o; } }
    { const int gt = F.blk * 512 + F.tid;
      if (gt < 1536) {
          const int sel = gt >= 512, idx = sel ? gt - 512 : gt, Q = sel ? 16 : 8, pos = idx / Q, i = idx - pos * Q;
          const float inv = sel ? a.inv64[i] : a.inv32[i];
          const float af = (float)pos * inv;
          double x = (double)af; const double twopi = 6.283185307179586476925287;
          x -= twopi * rint(x / twopi);
          const double x2 = x * x;
          double sn = 1.0, cs = 1.0;
#pragma unroll
          for (int k = 13; k >= 1; --k) { sn = 1.0 - sn * x2 / (double)((2 * k) * (2 * k + 1)); cs = 1.0 - cs * x2 / (double)((2 * k - 1) * (2 * k)); }
          sn *= x;
          f32x2* T = (f32x2*)(F.ws + WS_ROPE);
          T[gt] = (f32x2){(float)cs, (float)sn};
      } }
    __syncthreads();
    if (F.blk < 192) {
        LAS float* s = (LAS float*)F.lds;
        LAS float* red = s + 17 * 1024;
        for (int idx = F.tid; idx < 17 * 1024; idx += 512) { const int i = idx >> 10, k = idx & 1023; const float c = (i < 16) ? F.in[I_C][i * 1024 + k] : F.in[I_CCTX][k]; s[idx] = siluf_(c); }
        __syncthreads();
        float* mod = (float*)(F.ws + WS_MOD);
        for (int item = F.blk; item < 192; item += GRID) {
            const int l = item / 96, j0 = (item - l * 96) * 64, jj = F.tid & 63, kp = F.tid >> 6;
            float acc[17];
#pragma unroll
            for (int i = 0; i < 17; ++i) acc[i] = 0.f;
            const float* w = F.in[I_WMOD] + (size_t)l * 1024 * 6144 + (size_t)(kp * 128) * 6144 + j0 + jj;
            const LAS float* sk = s + kp * 128;
#pragma unroll 2
            for (int k = 0; k < 128; k += 4) {
                const float w0 = w[(size_t)k * 6144], w1 = w[(size_t)(k + 1) * 6144], w2 = w[(size_t)(k + 2) * 6144], w3 = w[(size_t)(k + 3) * 6144];
#pragma unroll
                for (int i = 0; i < 17; ++i) { const f32x4 sv = *(const LAS f32x4*)(sk + i * 1024 + k); acc[i] += (sv[0] * w0 + sv[1] * w1) + (sv[2] * w2 + sv[3] * w3); } }
#pragma unroll
            for (int i = 0; i < 17; ++i) red[(kp * 17 + i) * 64 + jj] = acc[i];
            __syncthreads();
            for (int idx = F.tid; idx < 17 * 64; idx += 512) { const int i = idx >> 6, j = idx & 63;
                float t = F.in[I_BMOD][l * 6144 + j0 + j];
#pragma unroll
                for (int p8 = 0; p8 < 8; ++p8) t += red[(p8 * 17 + i) * 64 + j];
                mod[(size_t)(l * 17 + i) * 6144 + j0 + j] = t; }
            __syncthreads();
        }
    }
}
template <int MODE>
__device__ __forceinline__ void p_rowpass(const Frame& F, int l) {
    const int gw = F.blk * 8 + F.wave, NGW = GRID * 8;
    const unsigned char* ybuf = F.ar + A_YBUF; const unsigned* seli = (const unsigned*)(F.ws + WS_SELI);
    bf16_t* H = (bf16_t*)(F.ar + A_H); unsigned char* H8 = F.ar + A_H8;
    bf16_t* XB = (bf16_t*)(F.ws + WS_XB);
    constexpr int NQ = 2;
    const int lc = F.lane * 8;
    static_assert(NR % (GRID * 8 * NQ) == 0, "rows per wave");
    constexpr int RPW = NR / (GRID * 8);
    const int Rw0 = gw * RPW;
    int mcur = -1; f32x4 A1[4], B1[4], G2[4];
    u32x4 slv[NQ];
    if (MODE >= 1) {
#pragma unroll
        for (int q = 0; q < NQ; ++q) slv[q] = *(const u32x4*)(seli + (size_t)(Rw0 + q) * 4);
    }
    for (int R0 = Rw0; R0 < Rw0 + RPW; R0 += NQ) {
        f32x4 v[NQ][4]; u32x4 xw[NQ][2]; u32x2 yv[NQ][2][4]; int mir[NQ]; bool act[NQ];
        u32x4 sln[NQ];
        if (MODE >= 1) { const int Rn = (R0 + NQ < Rw0 + RPW) ? R0 + NQ : R0;
#pragma unroll
            for (int q = 0; q < NQ; ++q) sln[q] = *(const u32x4*)(seli + (size_t)(Rn + q) * 4); }
#pragma unroll
        for (int q = 0; q < NQ; ++q) {
            const int R = R0 + q;
            const int b = R / TPB, p = R - b * TPB; const bool isctx = p < CTXL; mir[q] = isctx ? 16 : b;
            act[q] = !(MODE == 2 && isctx);
            if (MODE == 0) {
                const float* xin = isctx ? F.in[I_CTX] + ((size_t)b * 256 + p) * 1024 : F.in[I_X] + ((size_t)b * 4096 + (p - 256)) * 1024;
#pragma unroll
                for (int c = 0; c < 2; ++c) { v[q][2 * c] = *(const f32x4*)(xin + lc + 512 * c); v[q][2 * c + 1] = *(const f32x4*)(xin + lc + 512 * c + 4); }
            } else if (act[q]) {
#pragma unroll
                for (int c = 0; c < 2; ++c) xw[q][c] = *(const u32x4*)(XB + (size_t)R * 1024 + lc + 512 * c);
                const u32x4 sl = slv[q];
#pragma unroll
                for (int c = 0; c < 2; ++c) {
                    yv[q][c][0] = *(const u32x2*)(ybuf + (size_t)sl.x * 1024 + lc + 512 * c); yv[q][c][1] = *(const u32x2*)(ybuf + (size_t)sl.y * 1024 + lc + 512 * c);
                    yv[q][c][2] = *(const u32x2*)(ybuf + (size_t)sl.z * 1024 + lc + 512 * c); yv[q][c][3] = *(const u32x2*)(ybuf + (size_t)sl.w * 1024 + lc + 512 * c); }
            }
        }
#pragma unroll
        for (int q = 0; q < NQ; ++q) {
            if (!act[q]) continue;
            const int R = R0 + q;
            if (mir[q] != mcur) {
                mcur = mir[q];
                if (MODE >= 1) { const float* g2 = modv(F, l - 1, mcur, 5);
#pragma unroll
                    for (int c = 0; c < 2; ++c) { G2[2 * c] = *(const f32x4*)(g2 + lc + 512 * c) * (1.f / YSCL); G2[2 * c + 1] = *(const f32x4*)(g2 + lc + 512 * c + 4) * (1.f / YSCL); } }
                if (MODE <= 1) { const float* gn = F.in[I_N1G] + l * 1024; const float* sh = modv(F, l, mcur, 0); const float* sc = modv(F, l, mcur, 1);
#pragma unroll
                    for (int c = 0; c < 2; ++c) { const int cc = lc + 512 * c;
                        A1[2 * c] = *(const f32x4*)(gn + cc) * (*(const f32x4*)(sc + cc) + 1.f); A1[2 * c + 1] = *(const f32x4*)(gn + cc + 4) * (*(const f32x4*)(sc + cc + 4) + 1.f);
                        B1[2 * c] = *(const f32x4*)(sh + cc); B1[2 * c + 1] = *(const f32x4*)(sh + cc + 4); } }
            }
            if (MODE >= 1) {
#pragma unroll
                for (int c = 0; c < 2; ++c) {
                    f32x4 s0 = (f32x4){0.f, 0.f, 0.f, 0.f}, s1 = s0;
#pragma unroll
                    for (int k = 0; k < 4; ++k) { f32x4 a0, a1; unpack8f8(yv[q][c][k], a0, a1); s0 += a0; s1 += a1; }
                    f32x4 x0, x1; unpack8(xw[q][c], x0, x1);
                    v[q][2 * c] = x0 + G2[2 * c] * s0; v[q][2 * c + 1] = x1 + G2[2 * c + 1] * s1;
                    if (MODE == 1) *(u32x4*)(XB + (size_t)R * 1024 + lc + 512 * c) = pack8(v[q][2 * c], v[q][2 * c + 1]);
                    else { const int b = R / TPB, p = R - b * TPB; float* xo = F.out + ((size_t)b * 4096 + (p - 256)) * 1024 + lc + 512 * c;
                        *(f32x4*)xo = v[q][2 * c]; *(f32x4*)(xo + 4) = v[q][2 * c + 1]; }
                }
            }
            if (MODE <= 1) {
                float ss = 0.f;
#pragma unroll
                for (int j = 0; j < 4; ++j) ss += (v[q][j][0] * v[q][j][0] + v[q][j][1] * v[q][j][1]) + (v[q][j][2] * v[q][j][2] + v[q][j][3] * v[q][j][3]);
                const float rstd = rsqrtf(wave_sum(ss) * (1.f / 1024.f) + EPS);
#pragma unroll
                for (int c = 0; c < 2; ++c) { const int cc = lc + 512 * c;
                    const f32x4 h0 = (v[q][2 * c] * rstd) * A1[2 * c] + B1[2 * c];
                    const f32x4 h1 = (v[q][2 * c + 1] * rstd) * A1[2 * c + 1] + B1[2 * c + 1];
                    *(u32x4*)(H + (size_t)R * 1024 + cc) = pack8(h0, h1);
                    int w0 = 0, w1 = 0; w0 = __builtin_amdgcn_cvt_pk_fp8_f32(h0[0], h0[1], w0, false); w0 = __builtin_amdgcn_cvt_pk_fp8_f32(h0[2], h0[3], w0, true);
                    w1 = __builtin_amdgcn_cvt_pk_fp8_f32(h1[0], h1[1], w1, false); w1 = __builtin_amdgcn_cvt_pk_fp8_f32(h1[2], h1[3], w1, true);
                    *(u32x2*)(H8 + (size_t)R * 1024 + cc) = (u32x2){(unsigned)w0, (unsigned)w1}; }
            }
        }
        if (MODE >= 1) {
#pragma unroll
            for (int q = 0; q < NQ; ++q) slv[q] = sln[q]; }
    }
}

template <int HD>
__device__ __forceinline__ void qk_norm_rope(bf16_t* p, const float* gain, float post, int pos, const f32x2* rt, bf16_t* po = nullptr) {
    if (!po) po = p;
    float x[HD];
#pragma unroll
    for (int i = 0; i < HD / 8; ++i) { const u32x4 w = *(const u32x4*)(p + 8 * i); x[8 * i] = bf_lo(w.x); x[8 * i + 1] = bf_hi(w.x); x[8 * i + 2] = bf_lo(w.y); x[8 * i + 3] = bf_hi(w.y);
        x[8 * i + 4] = bf_lo(w.z); x[8 * i + 5] = bf_hi(w.z); x[8 * i + 6] = bf_lo(w.w); x[8 * i + 7] = bf_hi(w.w); }
    float ss = 0.f;
#pragma unroll
    for (int i = 0; i < HD; ++i) ss += x[i] * x[i];
    const float r = rsqrtf(ss * (1.f / HD) + EPS);
#pragma unroll
    for (int i = 0; i < HD; ++i) x[i] = x[i] * r * gain[i];
    if (pos >= 0) {
        constexpr int Q = HD / 4; const int row = pos >> 6, col = pos & 63;
#pragma unroll
        for (int i = 0; i < Q; ++i) {
            const f32x2 cr = rt[row * Q + i], cc = rt[col * Q + i];
            const float a = x[i], b = x[i + Q]; x[i] = a * cr[0] - b * cr[1]; x[i + Q] = b * cr[0] + a * cr[1];
            const float c = x[2 * Q + i], d = x[3 * Q + i]; x[2 * Q + i] = c * cc[0] - d * cc[1]; x[3 * Q + i] = d * cc[0] + c * cc[1];
        }
    }
#pragma unroll
    for (int i = 0; i < HD / 8; ++i) { u32x4 w; w.x = cvt_pk(x[8 * i] * post, x[8 * i + 1] * post); w.y = cvt_pk(x[8 * i + 2] * post, x[8 * i + 3] * post);
        w.z = cvt_pk(x[8 * i + 4] * post, x[8 * i + 5] * post); w.w = cvt_pk(x[8 * i + 6] * post, x[8 * i + 7] * post); *(u32x4*)(po + 8 * i) = w; }
}

template <bool gdn_only = false, bool dry = false>
__device__ __forceinline__ void p_prep(const Frame& F, int l) {
    bf16_t* dummy = (bf16_t*)(F.ar + A_CH);
    const int gt = F.blk * 512 + F.tid, NT = GRID * 512;
    const f32x2* rope = (const f32x2*)(F.ws + WS_ROPE);
    if (!gdn_only) for (int idx = gt; idx < NR * 8; idx += NT) {
        const int R = idx >> 3, grp = idx & 7, p = R % TPB; const int pos = (p < CTXL) ? -1 : p - CTXL;
        qk_norm_rope<32>(ptile(F, T_AK) + (size_t)R * 256 + grp * 32, F.in[I_DAKG] + l * 32, 1.f, pos, rope, dry ? dummy + (size_t)R * 256 + grp * 32 : nullptr);
    }
    if (!gdn_only) for (int idx = gt; idx < NR * 2; idx += NT) {
        const int R = idx >> 1, grp = idx & 1, p = R % TPB; const int pos = (p < CTXL) ? -1 : p - CTXL;
        qk_norm_rope<64>(ptile(F, T_GKV) + (size_t)R * 256 + grp * 64, F.in[I_GAKG] + l * 64, 1.f, pos, rope + 512, dry ? dummy + (size_t)R * 256 + grp * 64 : nullptr);
    }
    if (dry) return;
    const int gw = F.blk * 8 + F.wave, NGW = GRID * 8;
    bf16_t* Gq = (bf16_t*)(F.ar + A_H); bf16_t* Gk = Gq + (size_t)NR * 256; bf16_t* Gv = Gk + (size_t)NR * 256;
    float* GB = (float*)(F.ws + WS_GB);
    const float* cw = F.in[I_CONVW] + (size_t)l * 5 * 768;
    const int c = F.lane * 4;
    f32x4 cwv[5][3];
#pragma unroll
    for (int j = 0; j < 5; ++j)
#pragma unroll
        for (int part = 0; part < 3; ++part) cwv[j][part] = *(const f32x4*)(cw + j * 768 + part * 256 + c);
    const f32x4 vg = *(const f32x4*)(F.in[I_GMVG] + l * 256 + c);
    for (int G4 = gw; G4 < NR / 4; G4 += NGW) {
        const int R0 = G4 * 4, p0 = R0 % TPB, Rb = R0 - p0;
        const int lo = (p0 < CTXL) ? 0 : CTXL, hi = (p0 < CTXL) ? CTXL : TPB;
        u32x2 win[8][3];
#pragma unroll
        for (int w = 0; w < 8; ++w) { const int pp = p0 - 2 + w; const int pc = pp < lo ? lo : (pp >= hi ? hi - 1 : pp);
#pragma unroll
            for (int part = 0; part < 3; ++part) win[w][part] = *(const u32x2*)(ptile(F, T_DQ + part) + (size_t)(Rb + pc) * 256 + c); }
        u32x2 vw[4];
        if (!gdn_only) {
#pragma unroll
            for (int r = 0; r < 4; ++r) vw[r] = *(const u32x2*)(ptile(F, T_MV) + (size_t)(R0 + r) * 256 + c);
        }
        float ab; { const int rr = F.lane >> 4, cc = F.lane & 15; ab = bf2f(ptile(F, T_DAB)[(size_t)(R0 + rr) * 256 + cc]); }
#pragma unroll
        for (int w = 0; w < 8; ++w) { const int pp = p0 - 2 + w; if (pp < lo || pp >= hi) {
#pragma unroll
            for (int part = 0; part < 3; ++part) win[w][part] = (u32x2){0u, 0u}; } }
        if (!gdn_only) {
#pragma unroll
            for (int r = 0; r < 4; ++r) {
                const float v0 = gelu_erf(bf_lo(vw[r].x)), v1 = gelu_erf(bf_hi(vw[r].x)), v2 = gelu_erf(bf_lo(vw[r].y)), v3 = gelu_erf(bf_hi(vw[r].y));
                const float rs = rsqrtf(wave_sum((v0 * v0 + v1 * v1) + (v2 * v2 + v3 * v3)) * (1.f / 256.f) + EPS);
                u32x2 o; o.x = cvt_pk(v0 * rs * vg[0], v1 * rs * vg[1]); o.y = cvt_pk(v2 * rs * vg[2], v3 * rs * vg[3]); *(u32x2*)(ptile(F, T_MV) + (size_t)(R0 + r) * 256 + c) = o;
            }
        }
#pragma unroll
        for (int r = 0; r < 4; ++r) {
            float y[3][4];
#pragma unroll
            for (int part = 0; part < 3; ++part) {
                f32x4 a = (f32x4){0.f, 0.f, 0.f, 0.f};
#pragma unroll
                for (int j = 0; j < 5; ++j) { const u32x2 w = win[r + j][part]; a += (f32x4){bf_lo(w.x), bf_hi(w.x), bf_lo(w.y), bf_hi(w.y)} * cwv[j][part]; }
#pragma unroll
                for (int i = 0; i < 4; ++i) y[part][i] = siluf_(a[i]);
            }
            float sq = (y[0][0] * y[0][0] + y[0][1] * y[0][1]) + (y[0][2] * y[0][2] + y[0][3] * y[0][3]);
            float sk = (y[1][0] * y[1][0] + y[1][1] * y[1][1]) + (y[1][2] * y[1][2] + y[1][3] * y[1][3]);
            sq = sum16(sq); sk = sum16(sk);
            const float rq = rsqrtf(sq + EPS) * 0.125f, rk = rsqrtf(sk + EPS);
            const size_t off = (size_t)(R0 + r) * 256 + c;
            u32x2 o; o.x = cvt_pk(y[0][0] * rq, y[0][1] * rq); o.y = cvt_pk(y[0][2] * rq, y[0][3] * rq); *(u32x2*)(Gq + off) = o;
            o.x = cvt_pk(y[1][0] * rk, y[1][1] * rk); o.y = cvt_pk(y[1][2] * rk, y[1][3] * rk); *(u32x2*)(Gk + off) = o;
            o.x = cvt_pk(y[2][0], y[2][1]); o.y = cvt_pk(y[2][2], y[2][3]); *(u32x2*)(Gv + off) = o;
        }
        {
            const int rr = F.lane >> 4, cc = F.lane & 15;
            float r;
            if (cc < 8) { const float xx = ab + F.in[I_DTB][l * 8 + cc]; const float ex = __expf(fminf(xx, 20.f)); const float sp = (xx > 20.f) ? xx : ((xx < -4.f) ? ex * (1.f - ex * (0.5f - ex * (1.f / 3.f))) : __logf(1.f + ex)); r = -__expf(F.in[I_ALOG][l * 8 + cc]) * sp; }
            else r = sigmoidf_(ab);
            GB[(size_t)(R0 + rr) * 16 + cc] = r;
        }
    }
}
__device__ __forceinline__ s16x4 tr_read(const LAS unsigned char* p) { return __builtin_bit_cast(s16x4, __builtin_amdgcn_ds_read_tr16_b64_v4i16((LAS v4i16_t*)p)); }
__device__ __forceinline__ bf16x8 cat8(const s16x4 lo, const s16x4 hi) { return (bf16x8){lo[0], lo[1], lo[2], lo[3], hi[0], hi[1], hi[2], hi[3]}; }
#define MFMA32(a, b, c) __builtin_amdgcn_mfma_f32_32x32x16_bf16((a), (b), (c), 0, 0, 0)
#define MFMA16(a, b, c) __builtin_amdgcn_mfma_f32_16x16x32_bf16((a), (b), (c), 0, 0, 0)
constexpr int KP = 144, VP = 192;
constexpr int ATT_KT = 64;
constexpr int ATT_K_OFF = 0, ATT_V_OFF = ATT_KT * KP;

template <int HD>
__device__ __forceinline__ void q_prep(bf16x8 (&qf)[HD / 16], const bf16_t* qrow, const float* gain, float post, int pos, const f32x2* rt, int h2) {
    constexpr int NKS = HD / 16, Q = HD / 4;
    float x[NKS][8];
#pragma unroll
    for (int ks = 0; ks < NKS; ++ks) { const u32x4 w = *(const u32x4*)(qrow + 16 * ks + 8 * h2);
        x[ks][0] = bf_lo(w.x); x[ks][1] = bf_hi(w.x); x[ks][2] = bf_lo(w.y); x[ks][3] = bf_hi(w.y); x[ks][4] = bf_lo(w.z); x[ks][5] = bf_hi(w.z); x[ks][6] = bf_lo(w.w); x[ks][7] = bf_hi(w.w); }
    float ss = 0.f;
#pragma unroll
    for (int ks = 0; ks < NKS; ++ks)
#pragma unroll
        for (int j = 0; j < 8; ++j) ss += x[ks][j] * x[ks][j];
    const float rr = rsqrtf(add_xor32(ss) * (1.f / HD) + EPS);
#pragma unroll
    for (int ks = 0; ks < NKS; ++ks) { const f32x4 g0 = *(const f32x4*)(gain + 16 * ks + 8 * h2), g1 = *(const f32x4*)(gain + 16 * ks + 8 * h2 + 4);
#pragma unroll
        for (int j = 0; j < 4; ++j) { x[ks][j] *= rr * g0[j]; x[ks][4 + j] *= rr * g1[j]; } }
    if (pos >= 0) {
        const int row = pos >> 6, col = pos & 63;
        if (HD == 64) {
#pragma unroll
            for (int j = 0; j < 8; ++j) {
                const f32x2 cr = rt[row * Q + 8 * h2 + j], cc = rt[col * Q + 8 * h2 + j];
                const float a = x[0][j], b = x[1][j]; x[0][j] = a * cr[0] - b * cr[1]; x[1][j] = b * cr[0] + a * cr[1];
                const float c = x[NKS - 2][j], d = x[NKS - 1][j]; x[NKS - 2][j] = c * cc[0] - d * cc[1]; x[NKS - 1][j] = d * cc[0] + c * cc[1];
            }
        } else {
#pragma unroll
            for (int j = 0; j < 8; ++j) {
                const f32x2 cr = rt[row * Q + j], cc = rt[col * Q + j];
                const auto s0 = __builtin_amdgcn_permlane32_swap(__float_as_uint(x[0][j]), __float_as_uint(x[0][j]), false, false);
                const auto s1 = __builtin_amdgcn_permlane32_swap(__float_as_uint(x[1][j]), __float_as_uint(x[1][j]), false, false);
                const float pa = __uint_as_float(h2 ? s0[0] : s0[1]), pc = __uint_as_float(h2 ? s1[0] : s1[1]);
                x[0][j] = h2 ? (x[0][j] * cr[0] + pa * cr[1]) : (x[0][j] * cr[0] - pa * cr[1]);
                x[1][j] = h2 ? (x[1][j] * cc[0] + pc * cc[1]) : (x[1][j] * cc[0] - pc * cc[1]);
            }
        }
    }
#pragma unroll
    for (int ks = 0; ks < NKS; ++ks) { u32x4 w; w.x = cvt_pk(x[ks][0] * post, x[ks][1] * post); w.y = cvt_pk(x[ks][2] * post, x[ks][3] * post); w.z = cvt_pk(x[ks][4] * post, x[ks][5] * post); w.w = cvt_pk(x[ks][6] * post, x[ks][7] * post);
        qf[ks] = __builtin_bit_cast(bf16x8, w); }
}

template <int HD, int NMAP, bool DIFF>
__device__ __forceinline__ void attn_unit(const Frame& F, const bf16_t* Qb, int qcol, const bf16_t* Kb, int kcol, const bf16_t* Vb, int vcol, bf16_t* Ob, int ocol,
                                          int b, int qt, float lam, float fin_scale, const float* subg, const float* qgain, float qpost, const f32x2* qrt) {
    const int lane = F.lane, r = lane & 31, h2 = lane >> 5, x = lane & 15, g1 = (lane >> 4) & 1;
    const size_t R0 = (size_t)b * TPB + (size_t)qt * 256 + F.wave * 32;
    const int nkt = (qt == 0) ? 256 / ATT_KT : 4352 / ATT_KT;
    constexpr int NKS = HD / 16;
    bf16x8 qf[NMAP][NKS];
    { const int qpos = (qt == 0) ? -1 : (qt - 1) * 256 + F.wave * 32 + r;
#pragma unroll
      for (int m = 0; m < NMAP; ++m) q_prep<HD>(qf[m], Qb + (R0 + r) * 256 + qcol + m * HD, qgain, qpost, qpos, qrt, h2); }
    f32x16 O[NMAP][2]; f32x4 lacc[NMAP];
    bf16x8 onesA; { const int mrow = lane & 15, kg = lane >> 4; const unsigned o = ((mrow == 0 && (kg & 1) == 0) || (mrow == 1 && (kg & 1) == 1)) ? 0x3f803f80u : 0u; onesA = __builtin_bit_cast(bf16x8, (u32x4){o, o, o, o}); }
#pragma unroll
    for (int m = 0; m < NMAP; ++m) { lacc[m] = (f32x4){0.f, 0.f, 0.f, 0.f};
#pragma unroll
        for (int d = 0; d < 2; ++d)
#pragma unroll
            for (int i = 0; i < 16; ++i) O[m][d][i] = 0.f; }
    constexpr int ATT_BUF = ATT_KT * KP + ATT_KT * VP;
    constexpr int NST = ATT_KT / 64;
    const int skey = F.tid >> 3, sseg = F.tid & 7;
    const bf16_t* kg = Kb + ((size_t)b * TPB + skey) * 256 + kcol + sseg * 8;
    const bf16_t* vg = Vb + ((size_t)b * TPB + skey) * 256 + vcol + sseg * 8;
    u32x4 kreg[NST], vreg[NST];
#pragma unroll
    for (int i = 0; i < NST; ++i) { kreg[i] = *(const u32x4*)(kg + (size_t)(64 * i) * 256); vreg[i] = *(const u32x4*)(vg + (size_t)(64 * i) * 256); }
    __syncthreads();
#pragma unroll
    for (int i = 0; i < NST; ++i) { *(LAS u32x4*)(F.lds + ATT_K_OFF + (skey + 64 * i) * KP + sseg * 16) = kreg[i]; *(LAS u32x4*)(F.lds + ATT_V_OFF + (skey + 64 * i) * VP + sseg * 16) = vreg[i]; }
    __syncthreads();
    if (F.wave >= 4) __builtin_amdgcn_s_setprio(1);
    for (int kt = 0; kt < nkt; ++kt) {
        LAS unsigned char* Ks = F.lds + (kt & 1) * ATT_BUF + ATT_K_OFF; LAS unsigned char* Vs = F.lds + (kt & 1) * ATT_BUF + ATT_V_OFF;
        if (kt + 1 < nkt) {
#pragma unroll
            for (int i = 0; i < NST; ++i) { kreg[i] = *(const u32x4*)(kg + (size_t)((kt + 1) * ATT_KT + 64 * i) * 256); vreg[i] = *(const u32x4*)(vg + (size_t)((kt + 1) * ATT_KT + 64 * i) * 256); } }
#pragma unroll
        for (int grp = 0; grp < ATT_KT / 32; ++grp) {
            f32x16 S[2];
            constexpr int NKF = (NMAP == 2 && !DIFF) ? 1 : 2;
            bf16x8 kfr[NKF][NKS];
#pragma unroll
            for (int t = 0; t < NKF; ++t) {
                const int kb = (NMAP == 2) ? grp : t, m = (NMAP == 2) ? t : 0;
#pragma unroll
                for (int ks = 0; ks < NKS; ++ks) kfr[t][ks] = *(const LAS bf16x8*)(Ks + (kb * 32 + r) * KP + ((DIFF ? m * HD : 0) + 16 * ks + 8 * h2) * 2);
            }
#pragma unroll
            for (int t = 0; t < NKF; ++t)
#pragma unroll
                for (int ks = 0; ks < NKS; ++ks) { asm volatile("" : "+v"(kfr[t][ks])); }
#pragma unroll
            for (int t = 0; t < 2; ++t) {
                const int m = (NMAP == 2) ? t : 0;
                const f32x16 half16 = {0.5f, 0.5f, 0.5f, 0.5f, 0.5f, 0.5f, 0.5f, 0.5f, 0.5f, 0.5f, 0.5f, 0.5f, 0.5f, 0.5f, 0.5f, 0.5f};
                S[t] = MFMA32(kfr[t % NKF][0], qf[m][0], half16);
#pragma unroll
                for (int ks = 1; ks < NKS; ++ks) S[t] = MFMA32(kfr[t % NKF][ks], qf[m][ks], S[t]);
            }
            bf16x8 vf[(NMAP == 2) ? 1 : 2][2][2];
#pragma unroll
            for (int t = 0; t < ((NMAP == 2) ? 1 : 2); ++t) {
                const int kb = (NMAP == 2) ? grp : t;
#pragma unroll
                for (int d = 0; d < 2; ++d)
#pragma unroll
                    for (int s2 = 0; s2 < 2; ++s2) {
                        const LAS unsigned char* vp = Vs + (kb * 32 + 16 * s2 + 4 * h2 + (x >> 2)) * VP + (32 * d + 16 * g1 + 4 * (x & 3)) * 2;
                        vf[t][d][s2] = cat8(tr_read(vp), tr_read(vp + 8 * VP));
                    }
            }
#pragma unroll
            for (int t = 0; t < 2; ++t) {
                const int m = (NMAP == 2) ? t : 0, vt = (NMAP == 2) ? 0 : t;
                bf16x8 pb[2];
#pragma unroll
                for (int s2 = 0; s2 < 2; ++s2) {
                    unsigned w[4];
#pragma unroll
                    for (int j = 0; j < 4; ++j) w[j] = __builtin_bit_cast(unsigned, __builtin_amdgcn_cvt_pknorm_i16(S[t][8 * s2 + 2 * j], S[t][8 * s2 + 2 * j + 1]));
                    pb[s2] = __builtin_bit_cast(bf16x8, (u32x4){w[0], w[1], w[2], w[3]});
                    lacc[m] = MFMA16(onesA, pb[s2], lacc[m]);
                }
#pragma unroll
                for (int d = 0; d < 2; ++d)
#pragma unroll
                    for (int s2 = 0; s2 < 2; ++s2) O[m][d] = MFMA32(vf[vt][d][s2], pb[s2], O[m][d]);
            }
        }
        if (kt + 1 < nkt) { LAS unsigned char* nb = F.lds + ((kt + 1) & 1) * ATT_BUF;
#pragma unroll
            for (int i = 0; i < NST; ++i) { *(LAS u32x4*)(nb + ATT_K_OFF + (skey + 64 * i) * KP + sseg * 16) = kreg[i]; *(LAS u32x4*)(nb + ATT_V_OFF + (skey + 64 * i) * VP + sseg * 16) = vreg[i]; } }
        __syncthreads();
    }
    __builtin_amdgcn_s_setprio(0);
    float inv[NMAP];
#pragma unroll
    for (int m = 0; m < NMAP; ++m) {
        const float s0 = __int_as_float(__builtin_amdgcn_ds_bpermute((lane & 15) << 2, __float_as_int(lacc[m][0]))), s1 = __int_as_float(__builtin_amdgcn_ds_bpermute((lane & 15) << 2, __float_as_int(lacc[m][1])));
        inv[m] = 1.f / ((r < 16) ? s0 : s1); }
    bf16_t* op = Ob + (R0 + r) * 256 + ocol;
    if (DIFF) {
        float ss = 0.f;
#pragma unroll
        for (int d = 0; d < 2; ++d)
#pragma unroll
            for (int i = 0; i < 16; ++i) { const float v = O[0][d][i] * inv[0] - lam * (O[NMAP - 1][d][i] * inv[NMAP - 1]); O[0][d][i] = v; ss += v * v; }
        ss = add_xor32(ss);
        const float rr = rsqrtf(ss * (1.f / 64.f) + EPS) * fin_scale;
#pragma unroll
        for (int d = 0; d < 2; ++d)
#pragma unroll
            for (int g4 = 0; g4 < 4; ++g4) { const int dv0 = 32 * d + 8 * g4 + 4 * h2; const f32x4 sg = *(const f32x4*)(subg + dv0);
                u32x2 o; o.x = cvt_pk(O[0][d][4 * g4] * rr * sg[0], O[0][d][4 * g4 + 1] * rr * sg[1]); o.y = cvt_pk(O[0][d][4 * g4 + 2] * rr * sg[2], O[0][d][4 * g4 + 3] * rr * sg[3]);
                *(u32x2*)(op + dv0) = o; }
    } else {
#pragma unroll
        for (int m = 0; m < NMAP; ++m)
#pragma unroll
            for (int d = 0; d < 2; ++d)
#pragma unroll
                for (int g4 = 0; g4 < 4; ++g4) { const int dv0 = 32 * d + 8 * g4 + 4 * h2;
                    u32x2 o; o.x = cvt_pk(O[m][d][4 * g4] * inv[m], O[m][d][4 * g4 + 1] * inv[m]); o.y = cvt_pk(O[m][d][4 * g4 + 2] * inv[m], O[m][d][4 * g4 + 3] * inv[m]);
                    *(u32x2*)(op + m * HD + dv0) = o; }
    }
}

__device__ __forceinline__ void gmlp_unit(const Frame& F, int l, int b, int chunk, int g, bf16_t* dry = nullptr) {
    const int lane = F.lane, r = lane & 31, h2 = lane >> 5, x = lane & 15, g1 = (lane >> 4) & 1;
    const size_t R0 = (size_t)b * TPB + (size_t)chunk * 128;
    LAS unsigned char* Vs = F.lds;
    const bf16_t* vsrc = ptile(F, T_MV) + R0 * 256 + g * 64;
    __syncthreads();
#pragma unroll
    for (int i = 0; i < 2; ++i) { const int pc = F.tid + i * 512, q = pc >> 3, seg = pc & 7; *(LAS u32x4*)(Vs + q * VP + seg * 16) = *(const u32x4*)(vsrc + (size_t)q * 256 + seg * 8); }
    __syncthreads();
    const int cb = F.wave & 1, pb = F.wave >> 1;
    const bf16_t* ws = (const bf16_t*)(F.ws + WS_GMWS) + ((size_t)(l * 4 + g) * 128 + pb * 32 + r) * 128 + 8 * h2;
    f32x16 acc;
#pragma unroll
    for (int i = 0; i < 16; ++i) acc[i] = 0.f;
#pragma unroll
    for (int ks = 0; ks < 8; ++ks) {
        const LAS unsigned char* vp = Vs + (16 * ks + 8 * h2 + (x >> 2)) * VP + (32 * cb + 16 * g1 + 4 * (x & 3)) * 2;
        const bf16x8 af = cat8(tr_read(vp), tr_read(vp + 4 * VP));
        const bf16x8 bfr = *(const bf16x8*)(ws + 16 * ks);
        acc = MFMA32(af, bfr, acc);
    }
    const int pp = pb * 32 + r; const float bs = F.in[I_GMBS][(l * 4 + g) * 128 + pp];
    bf16_t* up = ptile(F, T_MU) + (R0 + pp) * 256 + g * 64 + cb * 32;
#pragma unroll
    for (int g4 = 0; g4 < 4; ++g4) { const int c0 = 8 * g4 + 4 * h2; const u32x2 uw = *(const u32x2*)(up + c0);
        u32x2 o; o.x = cvt_pk(gelu_erf(bf_lo(uw.x)) * (acc[4 * g4] + bs), gelu_erf(bf_hi(uw.x)) * (acc[4 * g4 + 1] + bs)); o.y = cvt_pk(gelu_erf(bf_lo(uw.y)) * (acc[4 * g4 + 2] + bs), gelu_erf(bf_hi(uw.y)) * (acc[4 * g4 + 3] + bs));
        *(u32x2*)((dry ? dry + (R0 + pp) * 256 + g * 64 + cb * 32 : up) + c0) = o; }
}
__device__ __forceinline__ int chunk_p(int dir, int n, int i) { const int f = 64 * n + i; return dir == 0 ? f : (n < 4 ? 255 - f : 4351 + 256 - f); }
__device__ __forceinline__ int crow16(int i, int h2) { return (i & 3) + 8 * (i >> 2) + 4 * h2; }
__device__ __forceinline__ int img_idx(int row, int k) { const int kk = k & 31; return (((row >> 4) * 2 + (k >> 5)) * 64 + ((kk >> 2) & 3) * 16 + (row & 15)) * 8 + 4 * (kk >> 4) + (kk & 3); }
constexpr int CH_NW = 0, CH_QD = 8192, CH_QK = 16384, CH_KDT = 24576, CH_U = 32768;

constexpr int CHS_BYTES = 33792;
__device__ __forceinline__ void gdn_chunk_phase(const Frame& F) {
    const int slot = F.wave >> 1, ws2 = F.wave & 1;
    LAS float* Am = (LAS float*)(F.lds + slot * CHS_BYTES); LAS float* gcv = Am + 4096; LAS float* btv = gcv + 64; LAS float* egv = btv + 64; LAS float* dkv = egv + 64;
    LAS bf16_t* kvt = (LAS bf16_t*)(F.lds + slot * CHS_BYTES + 17408);
    const bf16_t* Gq = (const bf16_t*)(F.ar + A_H); const bf16_t* Gk = Gq + (size_t)NR * 256; const bf16_t* Gv = Gk + (size_t)NR * 256;
    const float* GB = (const float*)(F.ws + WS_GB);
    float* CHG = (float*)(F.ws + WS_CHG);
    for (int it0 = F.blk * 4; it0 < 8704; it0 += GRID * 4) {
        int tq = F.tid; asm volatile("" : "+v"(tq));
        const int t2 = tq & 127, lane = tq & 63, r = lane & 31, h2 = lane >> 5;
        const int idx = it0 + slot, dir = idx & 1, rest = idx >> 1, m = rest % 68, h = (rest / 68) & 3, b = rest / 272;
        const int n = dir ? ((m < 4) ? 3 - m : 71 - m) : m; const int item = dir * 4352 + b * 272 + h * 68 + n;
        unsigned char* chp = F.ar + A_CH + (size_t)item * CH_ITEM;
        const size_t Rb = (size_t)b * TPB;
        __syncthreads();
        u32x4 stg[8];
#pragma unroll
        for (int j = 0; j < 8; ++j) { const int pc = t2 + 128 * j, i = pc >> 4, seg = pc & 15;
            stg[j] = *(const u32x4*)(((seg < 8) ? Gk : Gv) + (Rb + chunk_p(dir, n, i)) * 256 + 64 * h + (seg & 7) * 8); }
        bf16x8 qfr[2][4];
#pragma unroll
        for (int tI = 0; tI < 2; ++tI)
#pragma unroll
            for (int ks = 0; ks < 4; ++ks) qfr[tI][ks] = *(const bf16x8*)(Gq + (Rb + chunk_p(dir, n, 32 * tI + r)) * 256 + 64 * h + 8 * h2 + 16 * ks);
#pragma unroll
        for (int j = 0; j < 8; ++j) { const int pc = t2 + 128 * j, i = pc >> 4, seg = pc & 15; *(LAS u32x4*)(kvt + i * 128 + seg * 8) = stg[j]; }
        if (ws2 == 0) {
            const size_t R = Rb + chunk_p(dir, n, lane);
            float g = GB[R * 16 + dir * 4 + h]; const float bt = GB[R * 16 + 8 + dir * 4 + h];
#pragma unroll
            for (int o = 1; o < 64; o <<= 1) { const float t = __int_as_float(__builtin_amdgcn_ds_bpermute(((lane - o) & 63) << 2, __float_as_int(g))); if (lane >= o) g += t; }
            const float gl = __int_as_float(__builtin_amdgcn_readlane(__float_as_int(g), 63));
            gcv[lane] = g; btv[lane] = bt; egv[lane] = __expf(g); dkv[lane] = __expf(gl - g);
            if (lane == 0) CHG[item] = __expf(gl);
        }
        __syncthreads();
        u32x2 qpa[4], qpb[4];
#pragma unroll
        for (int t = 0; t < 4; ++t) { const int pidx = t2 + 128 * t, lp = pidx & 63, q4 = lp >> 4, row = lp & 15, rs = pidx >> 6, rb = rs >> 1, s2 = rs & 1;
            const bf16_t* qp = Gq + (Rb + chunk_p(dir, n, 16 * rb + row)) * 256 + 64 * h + 32 * s2 + 4 * q4;
            qpa[t] = *(const u32x2*)qp; qpb[t] = *(const u32x2*)(qp + 16); }
        if (ws2 == 0) {
#pragma unroll
            for (int tI = 0; tI < 2; ++tI)
#pragma unroll
                for (int tJ = 0; tJ <= tI; ++tJ) {
                    f32x16 acc;
#pragma unroll
                    for (int i = 0; i < 16; ++i) acc[i] = 0.f;
#pragma unroll
                    for (int ks = 0; ks < 4; ++ks) {
                        const bf16x8 af = *(const LAS bf16x8*)(kvt + (32 * tI + r) * 128 + 16 * ks + 8 * h2);
                        const bf16x8 bf = *(const LAS bf16x8*)(kvt + (32 * tJ + r) * 128 + 16 * ks + 8 * h2);
                        acc = MFMA32(af, bf, acc);
                    }
                    const int j = 32 * tJ + r; const float gj = gcv[j];
                    LAS float* ab = Am + (4 * h2) * 64 + j; const LAS float* gb = gcv + 4 * h2; const int dj = 4 * h2 - j;
#pragma unroll
                    for (int i = 0; i < 16; ++i) { const int io = 32 * tI + (i & 3) + 8 * (i >> 2);
                        const float val = gb[64 + io] * acc[i] * __expf(fminf(gb[io] - gj, 0.f));
                        ab[io * 64] = (io + dj > 0) ? val : 0.f; }
                }
        } else {
#pragma unroll
            for (int tJ = 0; tJ < 2; ++tJ)
#pragma unroll
                for (int tI = 0; tI < 2; ++tI) {
                    f32x16 acc;
#pragma unroll
                    for (int i = 0; i < 16; ++i) acc[i] = 0.f;
                    if (tJ <= tI) {
#pragma unroll
                        for (int ks = 0; ks < 4; ++ks) {
                            const bf16x8 af = *(const LAS bf16x8*)(kvt + (32 * tJ + r) * 128 + 16 * ks + 8 * h2);
                            acc = MFMA32(af, qfr[tI][ks], acc);
                        }
                    }
                    const int i = 32 * tI + r; const float gi = gcv[i];
                    const LAS float* gb = gcv + 4 * h2; const int di = i - 4 * h2;
                    unsigned char* qkp = chp + CH_QK + 2 * img_idx(i, 4 * h2);
#pragma unroll
                    for (int g4 = 0; g4 < 4; ++g4) {
                        float v[4];
#pragma unroll
                        for (int e = 0; e < 4; ++e) { const int jo = 32 * tJ + 8 * g4 + e; const float val = acc[4 * g4 + e] * __expf(fminf(gi - gb[jo], 0.f)); v[e] = (di >= jo) ? val : 0.f; }
                        u32x2 o; o.x = cvt_pk(v[0], v[1]); o.y = cvt_pk(v[2], v[3]);
                        *(u32x2*)(qkp + (tJ * 64 + ((2 * g4) & 3) * 16) * 16 + 8 * (g4 >> 1)) = o;
                    }
                }
        }
        __syncthreads();
        {
#pragma unroll
            for (int t = 0; t < 4; ++t) {
                const int pidx = t2 + 128 * t, lp = pidx & 63, q4 = lp >> 4, row = lp & 15, rs = pidx >> 6, rb = rs >> 1, s2 = rs & 1;
                const int i = 16 * rb + row, kdA = 32 * s2 + 4 * q4;
                const u32x2 qa = qpa[t], qb = qpb[t];
                const float eg = egv[i];
                u32x4 o; o.x = cvt_pk(bf_lo(qa.x) * eg, bf_hi(qa.x) * eg); o.y = cvt_pk(bf_lo(qa.y) * eg, bf_hi(qa.y) * eg); o.z = cvt_pk(bf_lo(qb.x) * eg, bf_hi(qb.x) * eg); o.w = cvt_pk(bf_lo(qb.y) * eg, bf_hi(qb.y) * eg);
                *(u32x4*)(chp + CH_QD + pidx * 16) = o;
                const int kd = i, cA = kdA;
                float kv[8];
#pragma unroll
                for (int e = 0; e < 8; ++e) { const int cc = cA + 16 * (e >> 2) + (e & 3); kv[e] = bf2f(kvt[cc * 128 + kd]) * dkv[cc]; }
                o.x = cvt_pk(kv[0], kv[1]); o.y = cvt_pk(kv[2], kv[3]); o.z = cvt_pk(kv[4], kv[5]); o.w = cvt_pk(kv[6], kv[7]);
                *(u32x4*)(chp + CH_KDT + pidx * 16) = o;
            }
        }
        {
            const int c = t2; const bool isw = c < 64;
            float X[64];
#pragma unroll
            for (int i = 0; i < 64; ++i) { const float val = bf2f(kvt[i * 128 + c]); X[i] = val * btv[i] * (isw ? egv[i] : 1.f); }
            __syncthreads();
            f32x4 ra[2][16];
#pragma unroll
            for (int q = 0; q < 1; ++q) ra[1][q] = *(const LAS f32x4*)(Am + 1 * 64 + 4 * q);
#pragma unroll
            for (int i = 1; i < 64; ++i) {
                if (i + 1 < 64) {
#pragma unroll
                    for (int q = 0; q < (i + 4) / 4; ++q) ra[(i + 1) & 1][q] = *(const LAS f32x4*)(Am + (i + 1) * 64 + 4 * q);
                }
#pragma unroll
                for (int q = 0; q < (i + 3) / 4; ++q) asm volatile("" : "+v"(ra[i & 1][q]));
                float s0 = X[i], s1 = 0.f;
#pragma unroll
                for (int j = 0; j < i; ++j) { if (j & 1) s1 -= ra[i & 1][j >> 2][j & 3] * X[j]; else s0 -= ra[i & 1][j >> 2][j & 3] * X[j]; }
                X[i] = s0 + s1;
            }
#pragma unroll
            for (int i = 0; i < 64; ++i) kvt[i * 128 + c] = f2bf(X[i]);
        }
        __syncthreads();
        {
#pragma unroll
            for (int t = 0; t < 4; ++t) {
                const int pidx = t2 + 128 * t, lp = pidx & 63, q4 = lp >> 4, row = lp & 15, rs = pidx >> 6, rb = rs >> 1, s2 = rs & 1;
                const int i = 16 * rb + row, kdA = 32 * s2 + 4 * q4;
                const u32x2 wa = *(const LAS u32x2*)(kvt + i * 128 + kdA), wb = *(const LAS u32x2*)(kvt + i * 128 + kdA + 16);
                u32x4 o; o.x = wa.x ^ 0x80008000u; o.y = wa.y ^ 0x80008000u; o.z = wb.x ^ 0x80008000u; o.w = wb.y ^ 0x80008000u;
                *(u32x4*)(chp + CH_NW + pidx * 16) = o;
            }
#pragma unroll
            for (int t = 0; t < 2; ++t) {
                const int pidx = t2 + 128 * t, sl = pidx >> 6, lp = pidx & 63, q4 = lp >> 4, vcol = 64 + 16 * sl + (lp & 15);
                unsigned w[8];
#pragma unroll
                for (int e = 0; e < 8; ++e) { const int i0 = 16 * (e >> 1) + 4 * q4 + 2 * (e & 1); w[e] = (unsigned)kvt[i0 * 128 + vcol] | ((unsigned)kvt[(i0 + 1) * 128 + vcol] << 16); }
                *(u32x4*)(chp + CH_U + pidx * 32) = (u32x4){w[0], w[1], w[2], w[3]}; *(u32x4*)(chp + CH_U + pidx * 32 + 16) = (u32x4){w[4], w[5], w[6], w[7]};
            }
        }
    }
}

__device__ __forceinline__ void gdn_scan_phase(const Frame& F, int l) {
    constexpr bool do_finish = true;
    const int lane = F.lane, q = lane >> 4, dir = F.wave >> 2, sl = F.wave & 3;
    const float* CHG = (const float*)(F.ws + WS_CHG);
    bf16_t* Ob0 = ptile(F, T_DQ); bf16_t* Ob1 = ptile(F, T_DK);
    for (int bh = F.blk; bh < 64; bh += GRID) {
        const int b = bh >> 2, h = bh & 3;
        const int item0d0 = ((0 * 16 + b) * 4 + h) * 68, item0d1 = ((1 * 16 + b) * 4 + h) * 68;
        const int item0 = dir ? item0d1 : item0d0;
        f32x4 S[4];
#pragma unroll
        for (int kb = 0; kb < 4; ++kb) S[kb] = (f32x4){0.f, 0.f, 0.f, 0.f};
        __syncthreads();
#define GDN_ISSUE(n_) do { _Pragma("unroll") for (int i_ = 0; i_ < 8; ++i_) { const int pc_ = F.wave * 8 + i_, d_ = pc_ >> 5, off_ = (pc_ & 31) * 1024; \
                const unsigned char* src_ = F.ar + A_CH + (size_t)((d_ ? item0d1 : item0d0) + (n_)) * CH_ITEM + off_ + lane * 16; \
                __builtin_amdgcn_global_load_lds((const unsigned*)src_, (LAS unsigned*)(F.lds + ((n_) & 1) * 65536 + d_ * 32768 + off_), 16, 0, 0); } } while (0)
        GDN_ISSUE(0);
        bf16_t* Ob = dir ? Ob1 : Ob0;
        for (int n = 0; n < 68; ++n) {
            const unsigned char* chp = F.ar + A_CH + (size_t)(item0 + n) * CH_ITEM;
            const u32x4 u0 = *(const u32x4*)(chp + CH_U + (sl * 64 + lane) * 32), u1 = *(const u32x4*)(chp + CH_U + (sl * 64 + lane) * 32 + 16);
            const float gl = CHG[item0 + n];
            VM_WAIT();
            __syncthreads();
            if (n + 1 < 68) GDN_ISSUE(n + 1);
            const LAS unsigned char* base = F.lds + (n & 1) * 65536 + dir * 32768 + lane * 16;
#define FRAG(mat, rb, s) (*(const LAS bf16x8*)(base + (mat) + ((rb) * 2 + (s)) * 1024))
            bf16x8 bS[2], bV[2];
#pragma unroll
            for (int s = 0; s < 2; ++s) { u32x4 w; w.x = cvt_pk(S[2 * s][0], S[2 * s][1]); w.y = cvt_pk(S[2 * s][2], S[2 * s][3]); w.z = cvt_pk(S[2 * s + 1][0], S[2 * s + 1][1]); w.w = cvt_pk(S[2 * s + 1][2], S[2 * s + 1][3]); bS[s] = __builtin_bit_cast(bf16x8, w); }
            f32x4 vn[4];
            vn[0] = (f32x4){bf_lo(u0.x), bf_hi(u0.x), bf_lo(u0.y), bf_hi(u0.y)}; vn[1] = (f32x4){bf_lo(u0.z), bf_hi(u0.z), bf_lo(u0.w), bf_hi(u0.w)};
            vn[2] = (f32x4){bf_lo(u1.x), bf_hi(u1.x), bf_lo(u1.y), bf_hi(u1.y)}; vn[3] = (f32x4){bf_lo(u1.z), bf_hi(u1.z), bf_lo(u1.w), bf_hi(u1.w)};
#pragma unroll
            for (int rb = 0; rb < 4; ++rb)
#pragma unroll
                for (int s = 0; s < 2; ++s) vn[rb] = MFMA16(FRAG(CH_NW, rb, s), bS[s], vn[rb]);
#pragma unroll
            for (int s = 0; s < 2; ++s) { u32x4 w; w.x = cvt_pk(vn[2 * s][0], vn[2 * s][1]); w.y = cvt_pk(vn[2 * s][2], vn[2 * s][3]); w.z = cvt_pk(vn[2 * s + 1][0], vn[2 * s + 1][1]); w.w = cvt_pk(vn[2 * s + 1][2], vn[2 * s + 1][3]); bV[s] = __builtin_bit_cast(bf16x8, w); }
            f32x4 o[4];
#pragma unroll
            for (int rb = 0; rb < 4; ++rb) { o[rb] = (f32x4){0.f, 0.f, 0.f, 0.f};
#pragma unroll
                for (int s = 0; s < 2; ++s) { o[rb] = MFMA16(FRAG(CH_QD, rb, s), bS[s], o[rb]); o[rb] = MFMA16(FRAG(CH_QK, rb, s), bV[s], o[rb]); } }
#pragma unroll
            for (int kb = 0; kb < 4; ++kb) { S[kb] = S[kb] * gl;
#pragma unroll
                for (int s = 0; s < 2; ++s) S[kb] = MFMA16(FRAG(CH_KDT, kb, s), bV[s], S[kb]); }
#undef FRAG
#pragma unroll
            for (int rb = 0; rb < 4; ++rb)
#pragma unroll
                for (int e = 0; e < 4; ++e) { const int i = 16 * rb + 4 * q + e;
                    Ob[((size_t)b * TPB + chunk_p(dir, n, i)) * 256 + 64 * h + 16 * sl + (lane & 15)] = f2bf(o[rb][e]); }
        }
        VM_WAIT();
        __syncthreads();
        if (do_finish) {
            const int sub = F.tid >> 4, c = (F.tid & 15) * 4;
            const f32x4 og = *(const f32x4*)(F.in[I_GDOUTG] + l * 64 + c);
            for (int p0 = sub; p0 < TPB; p0 += 128) {
                u32x2 a0[4], a1[4], gw[4];
#pragma unroll
                for (int t = 0; t < 4; ++t) { const size_t off = ((size_t)b * TPB + p0 + 32 * t) * 256 + 64 * h + c;
                    a0[t] = *(const u32x2*)(Ob0 + off); a1[t] = *(const u32x2*)(Ob1 + off); gw[t] = *(const u32x2*)(ptile(F, T_DG) + off); }
#pragma unroll
                for (int t = 0; t < 4; ++t) { const size_t off = ((size_t)b * TPB + p0 + 32 * t) * 256 + 64 * h + c;
                    const float o0 = bf_lo(a0[t].x) + bf_lo(a1[t].x), o1 = bf_hi(a0[t].x) + bf_hi(a1[t].x), o2 = bf_lo(a0[t].y) + bf_lo(a1[t].y), o3 = bf_hi(a0[t].y) + bf_hi(a1[t].y);
                    const float ss = sum16((o0 * o0 + o1 * o1) + (o2 * o2 + o3 * o3));
                    const float rr = rsqrtf(ss * (1.f / 64.f) + EPS);
                    u32x2 w; w.x = cvt_pk(o0 * rr * og[0] * siluf_(bf_lo(gw[t].x)), o1 * rr * og[1] * siluf_(bf_hi(gw[t].x))); w.y = cvt_pk(o2 * rr * og[2] * siluf_(bf_lo(gw[t].y)), o3 * rr * og[3] * siluf_(bf_hi(gw[t].y)));
                    *(u32x2*)(ptile(F, T_DG) + off) = w; }
            }
        }
    }
}
constexpr int WRP = 1032;
constexpr int RT_WLO_OFF = 32 * WRP * 2;
constexpr int RT_REC_OFF = 2 * RT_WLO_OFF;
constexpr int RT_CNT_OFF = RT_REC_OFF + 288 * 4 * 4;
static_assert(RT_CNT_OFF + 256 <= MISC_OFF, "router LDS");

__device__ __forceinline__ void p_route1(const Frame& F, int l, int cl) {
    LAS bf16_t* whi = (LAS bf16_t*)F.lds; LAS bf16_t* wlo = (LAS bf16_t*)(F.lds + RT_WLO_OFF);
    LAS int* rec = (LAS int*)(F.lds + RT_REC_OFF); LAS int* lcnt = (LAS int*)(F.lds + RT_CNT_OFF); LAS int* lbase = lcnt + 32;
    __syncthreads();
    { const float* wr = F.in[I_WR] + (size_t)l * 1024 * 32;
      f32x4 t[16];
#pragma unroll
      for (int i = 0; i < 16; ++i) t[i] = *(const f32x4*)(wr + (size_t)(F.tid + 512 * i) * 4);
#pragma unroll
      for (int i = 0; i < 16; ++i) { const int i4 = F.tid + 512 * i, k = i4 >> 3, e0 = (i4 & 7) * 4;
#pragma unroll
          for (int j = 0; j < 4; ++j) { const bf16_t h = f2bf(t[i][j]); whi[(e0 + j) * WRP + k] = h; wlo[(e0 + j) * WRP + k] = f2bf(t[i][j] - bf2f(h)); } } }
    if (F.tid < 32) lcnt[F.tid] = 0;
    __syncthreads();
    const int g0 = (l == 0) ? (F.blk * 2176) >> 8 : F.blk * 8, g1 = (l == 0) ? ((F.blk + 1) * 2176) >> 8 : F.blk * 8 + 8, ngrp = g1 - g0;
    bf16_t* H2 = (bf16_t*)(F.ar + A_H2); unsigned char* H2f8 = F.ar + A_H2F8;
    const bf16_t* XB = (const bf16_t*)(F.ws + WS_XB);
    int* rowmap = (int*)(F.ws + WS_ROWMAP); float* selg = (float*)(F.ws + WS_SELG);
    for (int i = F.blk * 512 + F.tid; i < MAXROWS; i += GRID * 512) rowmap[i] = -1;
    const int lane = F.lane;
    const float* gn = F.in[I_N2G] + l * 1024;
    int mcur = -1; f32x4 A2[4], B2[4];
    for (int rl0 = F.wave * 4; rl0 < ngrp * 32; rl0 += 32) {
        u32x4 xv[4][2]; float ss[4]; int Rr[4], mir[4];
#pragma unroll
        for (int q = 0; q < 4; ++q) {
            const int gr = g0 * 32 + rl0 + q;
            const int R = (l == 0) ? gr : (gr >> 12) * TPB + CTXL + (gr & 4095);
            const int b = R / TPB, p = R - b * TPB; const bool isctx = p < CTXL; Rr[q] = R; mir[q] = isctx ? 16 : b;
#pragma unroll
            for (int c = 0; c < 2; ++c) xv[q][c] = *(const u32x4*)(XB + (size_t)R * 1024 + lane * 8 + 512 * c);
        }
#pragma unroll
        for (int q = 0; q < 4; ++q) { ss[q] = 0.f;
#pragma unroll
            for (int c = 0; c < 2; ++c) { f32x4 a0, a1; unpack8(xv[q][c], a0, a1); ss[q] += ((a0[0] * a0[0] + a0[1] * a0[1]) + (a0[2] * a0[2] + a0[3] * a0[3])) + ((a1[0] * a1[0] + a1[1] * a1[1]) + (a1[2] * a1[2] + a1[3] * a1[3])); } }
#pragma unroll
        for (int q = 0; q < 4; ++q) {
            const float rstd = rsqrtf(wave_sum(ss[q]) * (1.f / 1024.f) + EPS);
            const int R = Rr[q];
            if (mir[q] != mcur) { mcur = mir[q]; const float* sh = modv(F, l, mcur, 3); const float* sc = modv(F, l, mcur, 4);
#pragma unroll
                for (int c = 0; c < 2; ++c) { const int cc = lane * 8 + 512 * c;
                    A2[2 * c] = *(const f32x4*)(gn + cc) * (*(const f32x4*)(sc + cc) + 1.f); A2[2 * c + 1] = *(const f32x4*)(gn + cc + 4) * (*(const f32x4*)(sc + cc + 4) + 1.f);
                    B2[2 * c] = *(const f32x4*)(sh + cc); B2[2 * c + 1] = *(const f32x4*)(sh + cc + 4); } }
#pragma unroll
            for (int c = 0; c < 2; ++c) { const int cc = lane * 8 + 512 * c;
                f32x4 a0, a1; unpack8(xv[q][c], a0, a1);
                const f32x4 h0 = (a0 * rstd) * A2[2 * c] + B2[2 * c];
                const f32x4 h1 = (a1 * rstd) * A2[2 * c + 1] + B2[2 * c + 1];
                *(u32x4*)(H2 + (size_t)R * 1024 + cc) = pack8(h0, h1);
                int w0 = 0, w1 = 0; w0 = __builtin_amdgcn_cvt_pk_fp8_f32(h0[0], h0[1], w0, false); w0 = __builtin_amdgcn_cvt_pk_fp8_f32(h0[2], h0[3], w0, true);
                w1 = __builtin_amdgcn_cvt_pk_fp8_f32(h1[0], h1[1], w1, false); w1 = __builtin_amdgcn_cvt_pk_fp8_f32(h1[2], h1[3], w1, true);
                *(u32x2*)(H2f8 + (size_t)R * 1024 + cc) = (u32x2){(unsigned)w0, (unsigned)w1}; }
        }
    }
    VM_WAIT();
    __syncthreads();
    const int r = lane & 31, h2 = lane >> 5;
    for (int grp = F.wave; grp < ngrp; grp += 8) {
        const int gr = (g0 + grp) * 32 + r;
        const int R = (l == 0) ? gr : (gr >> 12) * TPB + CTXL + (gr & 4095);
        const bf16_t* bh = H2 + (size_t)R * 1024 + 8 * h2;
        const LAS bf16_t* ah = whi + r * WRP + 8 * h2; const LAS bf16_t* al = wlo + r * WRP + 8 * h2;
        f32x16 acc;
#pragma unroll
        for (int i = 0; i < 16; ++i) acc[i] = 0.f;
        bf16x8 xh[2][8];
#pragma unroll
        for (int j = 0; j < 8; ++j) { xh[0][j] = *(const bf16x8*)(bh + 16 * j); }
#pragma unroll
        for (int kc = 0; kc < 8; ++kc) {
            if (kc + 1 < 8) {
#pragma unroll
                for (int j = 0; j < 8; ++j) { xh[(kc + 1) & 1][j] = *(const bf16x8*)(bh + 16 * (8 * (kc + 1) + j)); }
            }
#pragma unroll
            for (int j = 0; j < 8; ++j) { asm volatile("" : "+v"(xh[kc & 1][j])); }
#pragma unroll
            for (int j = 0; j < 8; ++j) { const int ks = 8 * kc + j;
                const bf16x8 wh = *(const LAS bf16x8*)(ah + 16 * ks), wl = *(const LAS bf16x8*)(al + 16 * ks);
                acc = MFMA32(wh, xh[kc & 1][j], acc); acc = MFMA32(wl, xh[kc & 1][j], acc); }
        }
        float lg[32];
#pragma unroll
        for (int i = 0; i < 16; ++i) { const auto rr = __builtin_amdgcn_permlane32_swap(__float_as_uint(acc[i]), __float_as_uint(acc[i]), false, false);
            const int e = (i & 3) + 8 * (i >> 2); lg[e] = __uint_as_float(rr[0]) + F.in[I_BR][l * 32 + e]; lg[e + 4] = __uint_as_float(rr[1]) + F.in[I_BR][l * 32 + e + 4]; }
        if (lane < 32) {
            const int rl = grp * 32 + r;
            unsigned used = 0u; int se[4]; float sv[4];
#pragma unroll
            for (int k = 0; k < 4; ++k) {
                float best = -INFINITY; int bi = 0;
#pragma unroll
                for (int e = 0; e < 32; ++e) { const bool ok = !((used >> e) & 1u) && lg[e] > best; best = ok ? lg[e] : best; bi = ok ? e : bi; }
                used |= 1u << bi; se[k] = bi; sv[k] = best;
            }
            const float e1 = __expf(sv[1] - sv[0]), e2 = __expf(sv[2] - sv[0]), e3 = __expf(sv[3] - sv[0]); const float den = 1.f / (1.f + e1 + e2 + e3);
            *(f32x4*)(selg + (size_t)R * 4) = (f32x4){den, e1 * den, e2 * den, e3 * den};
#pragma unroll
            for (int k = 0; k < 4; ++k) { const int pos = __hip_atomic_fetch_add(lcnt + se[k], 1, __ATOMIC_RELAXED, __HIP_MEMORY_SCOPE_WORKGROUP); rec[rl * 4 + k] = (pos << 5) | se[k]; }
        }
    }
    __syncthreads();
    if (F.tid < 32) lbase[F.tid] = (int)atomicAdd((unsigned*)(F.ws + WS_CTL) + CW_GCNT + cl * 32 + F.tid, (unsigned)lcnt[F.tid]);
    __syncthreads();
    int* seli = (int*)(F.ws + WS_SELI);
    for (int idx = F.tid; idx < ngrp * 32 * 4; idx += 512) {
        const int rl = idx >> 2, k = idx & 3;
        const int gr = g0 * 32 + rl;
        const int R = (l == 0) ? gr : (gr >> 12) * TPB + CTXL + (gr & 4095);
        const int e = rec[idx] & 31, pos = rec[idx] >> 5;
        seli[(size_t)R * 4 + k] = ((lbase[e] + pos) << 5) | e;
    }
}

__device__ __forceinline__ int moe_tables(const Frame& F, int l) {
    LAS int* off = (LAS int*)(F.lds + MISC_OFF + 64); LAS int* texp = (LAS int*)(F.lds + MISC_OFF + 256);
    __syncthreads();
    if (F.tid == 0) { const unsigned* gc = (const unsigned*)(F.ws + WS_CTL) + CW_GCNT + l * 32; int o = 0;
        for (int e = 0; e < 32; ++e) { off[e] = o; o += (int)((__hip_atomic_load(gc + e, __ATOMIC_RELAXED, __HIP_MEMORY_SCOPE_AGENT) + 255u) & ~255u); } off[32] = o; }
    __syncthreads();
    const int nt = off[32] >> 8;
    for (int pm = F.tid; pm < nt; pm += 512) { int e = 0;
#pragma unroll
        for (int k = 1; k < 32; ++k) e += (off[k] <= pm * 256) ? 1 : 0;
        texp[pm] = e; }
    __syncthreads();
    return nt;
}

__device__ __forceinline__ void p_route2(const Frame& F, int l) {
    (void)moe_tables(F, l);
    const LAS int* off = (const LAS int*)(F.lds + MISC_OFF + 64);
    int* seli = (int*)(F.ws + WS_SELI); const float* selg = (const float*)(F.ws + WS_SELG);
    int* rowmap = (int*)(F.ws + WS_ROWMAP); float* gslot = (float*)(F.ws + WS_GSLOT);
    for (int idx = F.blk * 512 + F.tid; idx < NR * 4; idx += GRID * 512) {
        const int R = idx >> 2;
        if (l == 1 && (R % TPB) < CTXL) continue;
        const int s = seli[idx]; const int e = s & 31, dst = off[e] + (s >> 5);
        rowmap[dst] = idx; gslot[dst] = selg[idx]; seli[idx] = dst;
    }
}
constexpr int NPH = 24;

__global__ void __launch_bounds__(512, 2) mega(Args args) {
    extern __shared__ __attribute__((aligned(16))) unsigned char lds_raw[];
    Frame F;
    F.lds = (LAS unsigned char*)lds_raw;
    F.in = args.in; F.out = args.out; F.ws = args.ws; F.ar = args.ws + WS_ARENA;
    F.tid = threadIdx.x; F.lane = F.tid & 63; F.wave = __builtin_amdgcn_readfirstlane(F.tid >> 6); F.blk = blockIdx.x;
    if (F.tid < 64) ((LAS unsigned*)(F.lds + MISC_OFF))[F.tid] = 0u;
    __syncthreads();
    const int lo = args.ph_lo, hi = args.ph_hi;
    XcdBarrier bar; bar.bar = (unsigned*)(F.ws + WS_CTL) + CW_BAR; bar.x = 0; bar.st = (volatile LAS unsigned*)(F.lds + MISC_OFF);
    if (hi - lo > 1) bar = xcd_barrier_post((unsigned*)(F.ws + WS_CTL) + CW_BAR, (volatile LAS unsigned*)(F.lds + MISC_OFF));
#ifndef PH_MASK
#define PH_MASK 0x1fff
#endif
#define KON(kind) (((PH_MASK) >> (kind)) & 1)
#define IN(k) (lo <= (k) && (k) < hi)
#define SEAM(k) do { if (IN(k) && IN((k) + 1)) xcd_barrier(bar); } while (0)
#define FRESH(FF) Frame FF = F; { int ln_; asm volatile("v_mbcnt_lo_u32_b32 %0, -1, 0\n\tv_mbcnt_hi_u32_b32 %0, -1, %0" : "=v"(ln_)); int wv_ = F.wave, bk_ = F.blk; asm volatile("" : "+s"(wv_), "+s"(bk_)); FF.lane = ln_; FF.wave = wv_; FF.blk = bk_; FF.tid = wv_ * 64 + ln_; }

    if (KON(0) && IN(0)) { FRESH(FF); p_prologue(FF, args); }
    SEAM(0);
    for (int l = 0; l < 2; ++l) {
        const int pb = 1 + 11 * l;
        if (KON(1) && IN(pb + 0)) { FRESH(FF); if (l == 0) p_rowpass<0>(FF, 0); else p_rowpass<1>(FF, 1); }
        SEAM(pb + 0);
        if (KON(2) && IN(pb + 1)) { FRESH(FF);
            EpiTiles E{ptile(FF, 0), FF.in[I_BGATE] + l * 4096};
            {
                pg8::DenseOrder S;
                if (l == 0) S.init(NRT, T_GATE, GRID, FF.blk, false, FF.ar + A_H, (const bf16_t*)(FF.ws + WS_WIN) + (size_t)l * 7168 * 1024, 1024);
                else { S.init(256, T_GATE, GRID, FF.blk, true, FF.ar + A_H, (const bf16_t*)(FF.ws + WS_WIN) + (size_t)l * 7168 * 1024, 1024); S.nctx = 16 * 7; }
#if PROBE_REP & 512
                if ((FF.blk >> 3) & 1) { __builtin_amdgcn_s_sleep(127); __builtin_amdgcn_s_sleep(127); __builtin_amdgcn_s_sleep(127); }
#endif
                pg8::gemm_phase<EpiTiles, pg8::DenseOrder>(FF.lds, FF.tid, 1024, S, E);
#if PROBE_REP & 1
                pg8::gemm_phase<EpiTiles, pg8::DenseOrder>(FF.lds, FF.tid, 1024, S, E);
#endif
            }
        }
        SEAM(pb + 1);
        if (KON(3) && IN(pb + 2)) { FRESH(FF);
#if PROBE_REP & 64
            p_prep<false, true>(FF, l);
#endif
#if PROBE_REP & 128
            p_prep<true, false>(FF, l);
#endif
            p_prep(FF, l); }
        SEAM(pb + 2);
        if (KON(4) && IN(pb + 3)) { FRESH(FF);
#if PROBE_REP & 32
            for (int u = FF.blk; u < 16 * 34 * 4; u += GRID) { const int g = u & 3, bc = u >> 2, b = bc / 34, chunk = bc - b * 34; gmlp_unit(FF, l, b, chunk, g, (bf16_t*)(FF.ar + A_H + 3 * PT_BYTES)); }
#endif
            for (int u = FF.blk; u < 16 * 34 * 4; u += GRID) { const int g = u & 3, bc = u >> 2, b = bc / 34, chunk = bc - b * 34; gmlp_unit(FF, l, b, chunk, g); }
            gdn_chunk_phase(FF);
#if PROBE_REP & 16
            gdn_chunk_phase(FF);
#endif
        }
        SEAM(pb + 3);
        if (KON(5) && IN(pb + 4)) { FRESH(FF);
            gdn_scan_phase(FF, l);
            float lam; { float d1 = 0.f, d2 = 0.f; for (int i = 0; i < 32; ++i) { d1 += FF.in[I_LQ1][l * 32 + i] * FF.in[I_LK1][l * 32 + i]; d2 += FF.in[I_LQ2][l * 32 + i] * FF.in[I_LK2][l * 32 + i]; } lam = expf(d1) - expf(d2) + args.lam_init[l]; }
            const int nq = (l == 0) ? 17 : 16, nda = 8 * nq, nga = 4 * nq, xq = FF.blk & 7;
            volatile LAS int* qslot = (volatile LAS int*)(FF.lds + MISC_OFF + 32);
            unsigned* qctr = (unsigned*)(FF.ws + WS_CTL) + CW_AQ + (l * 8 + xq) * 64;
            bf16_t* oda = ptile(FF, T_AQ); bf16_t* oga = ptile(FF, T_GQ);
            for (;;) {
                __syncthreads();
                if (FF.tid == 0) *qslot = (int)__hip_atomic_fetch_add(qctr, 1u, __ATOMIC_RELAXED, __HIP_MEMORY_SCOPE_AGENT);
                __syncthreads();
                int u = *qslot;
                if (u >= nda + nga) break;
                if (u < nda) {
                    const int g = u / nq, qi = u - g * nq, bh = xq * 8 + g, b = bh >> 2, h = bh & 3, qt = (qi < 16) ? qi + 1 : 0;
                    attn_unit<32, 2, true>(FF, ptile(FF, T_AQ), 64 * h, ptile(FF, T_AK), 64 * h, ptile(FF, T_AV), 64 * h, oda, 64 * h, b, qt, lam, 1.f - args.lam_init[l], FF.in[I_DASUBG] + l * 64, FF.in[I_DAQG] + l * 32, 0.17677669529663687f * LOG2E * QSC, (const f32x2*)(FF.ws + WS_ROPE));
                } else {
                    u -= nda; const int g = u / nq, qi = u - g * nq, bk = xq * 4 + g, b = bk >> 1, kv = bk & 1, qt = (qi < 16) ? qi + 1 : 0;
                    attn_unit<64, 2, false>(FF, ptile(FF, T_GQ), 128 * kv, ptile(FF, T_GKV), 64 * kv, ptile(FF, T_GKV), 128 + 64 * kv, oga, 128 * kv, b, qt, 0.f, 1.f, nullptr, FF.in[I_GAQG] + l * 64, 0.125f * LOG2E * QSC, (const f32x2*)(FF.ws + WS_ROPE) + 512);
                }
            }
            __syncthreads();
            {
                EpiTiles E{ptile(FF, 0), FF.in[I_BGATE] + l * 4096};
                pg8::DenseOrderT<true> S; S.init((l == 0) ? NRT : 256, 16, GRID, FF.blk, l == 1, FF.ar + A_H8, FF.ws + WS_WG8 + (size_t)l * 4096 * 1024, 1024); S.pn_off = T_GATE;
                constexpr int NDYN = 2;
                const int rounds = S.nwg / GRID; S.imax = rounds - NDYN;
                unsigned* gq = (unsigned*)(FF.ws + WS_CTL) + CW_GQ + (l * 8 + (FF.blk & 7)) * 64;
                if (FF.tid == 0) *qslot = (int)__hip_atomic_fetch_add(gq, 1u, __ATOMIC_RELAXED, __HIP_MEMORY_SCOPE_AGENT);
                for (int it = 0;; ++it) {
                    pg8::gemm_phase<EpiTiles, pg8::DenseOrderT<true>>(FF.lds, FF.tid, 1024, S, E);
                    __syncthreads();
                    const int v = *qslot;
                    if (v >= NDYN * (GRID / 8)) break;
                    S.single = (rounds - NDYN) * GRID + 8 * v + (FF.blk & 7);
                    __syncthreads();
                    if (FF.tid == 0) *qslot = (int)__hip_atomic_fetch_add(gq, 1u, __ATOMIC_RELAXED, __HIP_MEMORY_SCOPE_AGENT);
                }
#if PROBE_REP & 2
                pg8::gemm_phase<EpiTiles, pg8::DenseOrderT<true>>(FF.lds, FF.tid, 1024, S, E);
#endif
            }
        }
        SEAM(pb + 4);
        if (KON(6) && IN(pb + 5)) { FRESH(FF);
            MergeOrder S; S.G = GRID; S.c = FF.blk; S.skipctx = (l == 1); S.ntile = (l == 1) ? 1024 : 1088; S.P = (const char*)(FF.ar + A_P); S.Wbr = (const char*)((const bf16_t*)(FF.ws + WS_WBR) + (size_t)l * 4 * 1024 * 256);
            EpiMerge E{ptile(FF, 0), (bf16_t*)(FF.ar + A_MERGED)};
            pg8::gemm_phase<EpiMerge, MergeOrder>(FF.lds, FF.tid, 256, S, E);
        }
        SEAM(pb + 5);
        if (KON(7) && IN(pb + 6)) { FRESH(FF);
            pg8::DenseOrder S; S.init((l == 1) ? 256 : NRT, 4, GRID, FF.blk, l == 1, FF.ar + A_MERGED, (const bf16_t*)(FF.ws + WS_WO) + (size_t)l * 1024 * 1024, 1024);
            EpiWo E{(l == 0) ? FF.in[I_X] : nullptr, FF.in[I_CTX], (bf16_t*)(FF.ws + WS_XB), (const float*)(FF.ws + WS_MOD) + (size_t)l * 17 * 6144, 2};
            pg8::gemm_phase<EpiWo, pg8::DenseOrder>(FF.lds, FF.tid, 1024, S, E);
        }
        SEAM(pb + 6);
#if PROBE_REP & 256
        if (KON(8) && IN(pb + 7)) { FRESH(FF); p_route1(FF, l, l + 2); }
#endif
        if (KON(8) && IN(pb + 7)) { FRESH(FF); p_route1(FF, l, l); }
        SEAM(pb + 7);
        if (KON(9) && IN(pb + 8)) { FRESH(FF); p_route2(FF, l); }
        SEAM(pb + 8);
        if (KON(10) && IN(pb + 9)) { FRESH(FF);
            const int nt = moe_tables(FF, l);
            MoeOrder<8, true> S; S.G = GRID; S.c = FF.blk; S.nunits = nt * 8; S.texp = (const LAS int*)(FF.lds + MISC_OFF + 256); S.A = (const char*)(FF.ar + A_H2F8); S.rowmap = (const int*)(FF.ws + WS_ROWMAP);
            S.W = (const char*)(FF.ws + WS_WUP) + (size_t)l * 32 * 2048 * 1024; S.wstride = (size_t)2048 * 1024;
            EpiUp E{FF.in[I_BUP] + (size_t)l * 32 * 2048, (unsigned char*)(FF.ar + A_ACT)};
            pg8::gemm_phase<EpiUp, MoeOrder<8, true>>(FF.lds, FF.tid, 1024, S, E);
#if PROBE_REP & 4
            pg8::gemm_phase<EpiUp, MoeOrder<8, true>>(FF.lds, FF.tid, 1024, S, E);
#endif
        }
        SEAM(pb + 9);
        if (KON(11) && IN(pb + 10)) { FRESH(FF);
            const int nt = moe_tables(FF, l);
            MoeOrder<4, false> S; S.G = GRID; S.c = FF.blk; S.nunits = nt * 4; S.texp = (const LAS int*)(FF.lds + MISC_OFF + 256); S.A = (const char*)(FF.ar + A_ACT); S.rowmap = nullptr;
            S.W = (const char*)(FF.ws + WS_WDN) + (size_t)l * 32 * 1024 * 1024; S.wstride = (size_t)1024 * 1024;
            EpiDown E{FF.in[I_BDN] + (size_t)l * 32 * 1024, (const float*)(FF.ws + WS_GSLOT), FF.ar + A_YBUF};
            pg8::gemm_phase<EpiDown, MoeOrder<4, false>>(FF.lds, FF.tid, 1024, S, E);
#if PROBE_REP & 8
            pg8::gemm_phase<EpiDown, MoeOrder<4, false>>(FF.lds, FF.tid, 1024, S, E);
#endif
        }
        SEAM(pb + 10);
    }
    if (KON(12) && IN(23)) { FRESH(FF); p_rowpass<2>(FF, 2); }
#undef IN
#undef SEAM
}

extern "C" void kernel_launch(void* const* d_in, const int* in_sizes, int n_in, void* d_out, int out_size, void* d_ws, size_t ws_size, hipStream_t stream) {
    static int grid = 0;
    if (grid == 0) {
        if (n_in != 34 || out_size != NB * SEQ * D || ws_size < WS_NEED) { fprintf(stderr, "kernel_launch: unexpected shapes (n_in %d out %d ws %zu need %zu)\n", n_in, out_size, ws_size, (size_t)WS_NEED); grid = -1; return; }
        int dev = 0, cus = 0;
        if (hipGetDevice(&dev) != hipSuccess || hipDeviceGetAttribute(&cus, hipDeviceAttributeMultiprocessorCount, dev) != hipSuccess) { grid = -1; return; }
        if (hipFuncSetAttribute((const void*)mega, hipFuncAttributeMaxDynamicSharedMemorySize, LDS_BYTES) != hipSuccess) { fprintf(stderr, "kernel_launch: hipFuncSetAttribute failed\n"); grid = -1; return; }
        int per_cu = 0;
        (void)hipOccupancyMaxActiveBlocksPerMultiprocessor(&per_cu, (const void*)mega, 512, LDS_BYTES);
        (void)hipGetLastError();
        if (cus != 256 || per_cu < 1) { fprintf(stderr, "kernel_launch: needs 256 CUs with one resident workgroup each (cus %d, per_cu %d)\n", cus, per_cu); grid = -1; return; }
        grid = GRID;
    }
    if (grid < 0) return;
    (void)hipMemsetAsync((char*)d_ws + WS_CTL, 0, CTL_BYTES, stream);
    Args a;
    memset(&a, 0, sizeof(a));
    for (int i = 0; i < 34; ++i) a.in[i] = (const float*)d_in[i];
    a.out = (float*)d_out; a.ws = (unsigned char*)d_ws;
    for (int i = 0; i < 8; ++i) a.inv32[i] = (float)pow(10000.0, -(double)i / 8.0);
    for (int i = 0; i < 16; ++i) a.inv64[i] = (float)pow(10000.0, -(double)i / 16.0);
    for (int l = 0; l < 2; ++l) a.lam_init[l] = (float)(0.8 - 0.6 * exp(-0.3 * (double)l));
    a.ph_lo = 0; a.ph_hi = NPH;
    hipLaunchKernelGGL(mega, dim3(grid), dim3(512), LDS_BYTES, stream, a);
}
```

```cpp
#include <hip/hip_runtime.h>
#include <stdint.h>
#include <stdio.h>
#include <math.h>
#include <string.h>

#define LAS __attribute__((address_space(3)))
typedef unsigned short bf16_t;
typedef short bf16x8 __attribute__((ext_vector_type(8)));
typedef short s16x4 __attribute__((ext_vector_type(4)));
typedef short v4i16_t __attribute__((ext_vector_type(4)));
typedef float f32x2 __attribute__((ext_vector_type(2)));
typedef float f32x4 __attribute__((ext_vector_type(4)));
typedef float f32x16 __attribute__((ext_vector_type(16)));
typedef unsigned u32x2 __attribute__((ext_vector_type(2)));
typedef unsigned u32x4 __attribute__((ext_vector_type(4)));

constexpr int D = 1024, NB = 16, SEQ = 4096, CTXL = 256, TPB = SEQ + CTXL;
constexpr int NR = NB * TPB;
constexpr int NRT = NR / 256;
constexpr int NPT = 28;
constexpr int NE = 32;
constexpr int GRID = 256;
constexpr int MAXT = 1120, MAXROWS = MAXT * 256;
#ifndef PROBE_REP
#define PROBE_REP 0
#endif
constexpr float EPS = 1e-6f;
constexpr float LOG2E = 1.4426950408889634f;
constexpr float QSC = 128.f / 32767.f;
constexpr int T_AQ = 0, T_AK = 1, T_AV = 2, T_GQ = 3, T_GKV = 4, T_MU = 5, T_MV = 6, T_DQ = 7, T_DK = 8, T_DV = 9, T_DG = 10, T_DAB = 11, T_GATE = 12;

constexpr size_t WS_CTL = 0;
constexpr size_t CTL_BYTES = 65536;
constexpr int CW_BAR = 0;
constexpr int CW_GCNT = 4096;
constexpr int CW_QUEUE = 4352;
constexpr int CW_AQ = 6144;
constexpr int CW_GQ = 4608;
constexpr size_t WS_MOD = 65536;
constexpr size_t WS_ROPE = WS_MOD + 2ull * 17 * 6144 * 4;
constexpr size_t WS_WIN = 1048576;
constexpr size_t WS_WBR = WS_WIN + 2ull * 7168 * 1024 * 2;
constexpr size_t WS_WO = WS_WBR + 2ull * 4 * 1024 * 256 * 2;
constexpr size_t WS_WUP = WS_WO + 2ull * 1024 * 1024 * 2;
constexpr size_t WS_WG8 = WS_WUP + 2ull * 32 * 2048 * 1024;
constexpr size_t WS_WDN = WS_WG8 + 2ull * 4096 * 1024;
constexpr size_t WS_GMWS = WS_WDN + 2ull * 32 * 1024 * 1024;
constexpr size_t WS_XB = WS_GMWS + 2ull * 4 * 128 * 128 * 2;
constexpr size_t WS_SELI = WS_XB + (size_t)NR * 1024 * 2;
constexpr size_t WS_SELG = WS_SELI + (size_t)NR * 4 * 4;
constexpr size_t WS_GB = WS_SELG + (size_t)NR * 4 * 4;
constexpr size_t WS_ROWMAP = WS_GB + (size_t)NR * 16 * 4;
constexpr size_t WS_GSLOT = WS_ROWMAP + (size_t)MAXROWS * 4;
constexpr size_t WS_CHG = WS_GSLOT + (size_t)MAXROWS * 4;
constexpr size_t WS_ARENA = (WS_CHG + 8704 * 4 + 4095) & ~(size_t)4095;
constexpr size_t PT_BYTES = (size_t)NR * 256 * 2;
constexpr size_t A_H = 0;
constexpr size_t A_P = (size_t)NR * 1024 * 2;
constexpr size_t A_CH = A_P + NPT * PT_BYTES;
constexpr size_t CH_ITEM = 40960;
constexpr size_t A_END = A_CH + 8704ull * CH_ITEM;
constexpr size_t A_MERGED = A_CH;
constexpr size_t A_H2 = 0;
constexpr size_t A_XS = A_P;
constexpr size_t A_ACT = A_XS + (size_t)MAXROWS * 1024 * 2;
constexpr size_t A_H2F8 = A_XS + (size_t)NR * 1024 * 2;
constexpr size_t A_YBUF = A_XS;
static_assert(A_ACT + (size_t)MAXROWS * 1024 * 2 <= A_END, "arena");
static_assert((size_t)NR * 4 * 1024 * 2 <= (size_t)MAXROWS * 1024 * 2, "ybuf fits xs");
constexpr size_t A_H8 = A_END;
constexpr size_t WS_NEED = WS_ARENA + A_END + (size_t)NR * 1024;

constexpr int RING_BYTES = 131072;
constexpr int MISC_OFF = 140544;
constexpr int LDS_BYTES = 147456;

typedef __bf16 bf16x2_t __attribute__((ext_vector_type(2)));
__device__ __forceinline__ unsigned cvt_pk(float lo, float hi) { const f32x2 v = {lo, hi}; const bf16x2_t b = __builtin_convertvector(v, bf16x2_t); return __builtin_bit_cast(unsigned, b); }
__device__ __forceinline__ float bf_lo(unsigned u) { return __uint_as_float(u << 16); }
__device__ __forceinline__ float bf_hi(unsigned u) { return __uint_as_float(u & 0xffff0000u); }
__device__ __forceinline__ float bf2f(bf16_t h) { return __uint_as_float(((unsigned)h) << 16); }
__device__ __forceinline__ bf16_t f2bf(float f) { return (bf16_t)(cvt_pk(f, 0.f) & 0xffffu); }
template <int O> __device__ __forceinline__ float xor_f(float v) { return __int_as_float(__builtin_amdgcn_ds_swizzle(__float_as_int(v), (O << 10) | 0x1f)); }
__device__ __forceinline__ float add_xor32(float v) { const auto rr = __builtin_amdgcn_permlane32_swap(__float_as_uint(v), __float_as_uint(v), false, false); return __uint_as_float(rr[0]) + __uint_as_float(rr[1]); }
__device__ __forceinline__ float sum16(float v) { v += xor_f<1>(v); v += xor_f<2>(v); v += xor_f<4>(v); v += xor_f<8>(v); return v; }
__device__ __forceinline__ float wave_sum(float v) { v = sum16(v); v += xor_f<16>(v); return add_xor32(v); }
__device__ __forceinline__ float sigmoidf_(float x) { return __builtin_amdgcn_rcpf(1.f + __builtin_amdgcn_exp2f(x * -LOG2E)); }
__device__ __forceinline__ float siluf_(float x) { return x * __builtin_amdgcn_rcpf(1.f + __builtin_amdgcn_exp2f(x * -LOG2E)); }
__device__ __forceinline__ float gelu_erf(float v) {
    const float av = fabsf(v), t = __builtin_amdgcn_rcpf(av * 0.2316418882f + 1.0f);
    float q = t * 0.5307027145f + (-0.7265760135f); q = q * t + 0.7107068705f; q = q * t + (-0.142248368f); q = q * t + 0.127414796f; q = q * t;
    const float e = __builtin_amdgcn_exp2f((v * v) * (-0.72134752044f));
    const float m = v * (q * e);
    return v < 0.f ? m : v - m;
}
#define VM_WAIT() asm volatile("s_waitcnt vmcnt(0)" ::: "memory")
#define LDS_WAIT() asm volatile("s_waitcnt lgkmcnt(0)" ::: "memory")

#define XB_TMO      128
#define XB_XCNT(j)  (256  + 64 * (j))
#define XB_XSUB(j)  (1280 + 64 * (j))
#define XB_XGEN(j)  (2304 + 64 * (j))
#define XB_TOP      3328
#define XB_TOPGEN   3392
#define XCD_BAR_WORDS 3456
#define XB_SPIN_CAP (1u << 18)
__device__ __forceinline__ unsigned xb_ld(unsigned* p)              { return __hip_atomic_load(p, __ATOMIC_RELAXED, __HIP_MEMORY_SCOPE_AGENT); }
__device__ __forceinline__ unsigned xb_add(unsigned* p, unsigned v) { return __hip_atomic_fetch_add(p, v, __ATOMIC_RELAXED, __HIP_MEMORY_SCOPE_AGENT); }
__device__ __forceinline__ unsigned xb_xcc_id() { return (unsigned)__builtin_amdgcn_s_getreg((3 << 11) | 20) & 0xFu; }
#define XB_SPIN(cond, bar) do { unsigned _sp = 0; while (cond) { __builtin_amdgcn_s_sleep(1); \
    if ((++_sp & 255u) == 0u) { if (xb_ld(&(bar)[XB_TMO])) break; if (_sp > XB_SPIN_CAP) { atomicAdd(&(bar)[XB_TMO], 1u); break; } } } } while (0)
struct XcdBarrier { unsigned* bar; unsigned x; volatile LAS unsigned* st; };
__device__ __forceinline__ XcdBarrier xcd_barrier_post(unsigned* bar, volatile LAS unsigned* st) {
    XcdBarrier b; b.bar = bar; b.x = xb_xcc_id(); b.st = st;
    if (threadIdx.x == 0) (void)xb_add(&bar[XB_XCNT(b.x)], 1u);
    return b;
}
__device__ __forceinline__ void xcd_barrier_complete(unsigned* bar, unsigned x, unsigned& nloc, unsigned& nx) {
    const unsigned G = gridDim.x * gridDim.y * gridDim.z;
    unsigned sum, cnt, mine, sp = 0u;
    for (;;) {
        sum = 0u; cnt = 0u; mine = 0u;
#pragma unroll
        for (unsigned j = 0; j < 16; ++j) { const unsigned c = xb_ld(&bar[XB_XCNT(j)]); sum += c; cnt += (c > 0u) ? 1u : 0u; mine = (j == x) ? c : mine; }
        if (sum == G) break;
        __builtin_amdgcn_s_sleep(1);
        if ((++sp & 255u) == 0u) { if (xb_ld(&bar[XB_TMO])) break; if (sp > XB_SPIN_CAP) { atomicAdd(&bar[XB_TMO], 1u); break; } }
    }
    nloc = mine > 0u ? mine : 1u; nx = cnt > 0u ? cnt : 1u;
}
__device__ __forceinline__ void xcd_barrier(const XcdBarrier& b) {
    asm volatile("s_waitcnt vmcnt(0)" ::: "memory");
    __syncthreads();
    if (threadIdx.x == 0) {
        unsigned* bar = b.bar;
        __builtin_amdgcn_s_waitcnt(0);
        unsigned nloc = b.st[0], nx = b.st[1];
        if (nloc == 0u) { xcd_barrier_complete(bar, b.x, nloc, nx); b.st[0] = nloc; b.st[1] = nx; }
        const unsigned old = xb_add(&bar[XB_XSUB(b.x)], 1u);
        const unsigned gen = old / nloc;
        if (old + 1u == (gen + 1u) * nloc) {
            __builtin_amdgcn_fence(__ATOMIC_RELEASE, "agent");
            asm volatile("s_waitcnt vmcnt(0)" ::: "memory");
            const unsigned og = xb_add(&bar[XB_TOP], 1u);
            const unsigned tg = og / nx;
            if (og + 1u == (tg + 1u) * nx) xb_add(&bar[XB_TOPGEN], 1u);
            else XB_SPIN(xb_ld(&bar[XB_TOPGEN]) == tg, bar);
            __builtin_amdgcn_fence(__ATOMIC_ACQUIRE, "agent");
            xb_add(&bar[XB_XGEN(b.x)], 1u);
            asm volatile("s_waitcnt vmcnt(0)" ::: "memory");
        } else {
            XB_SPIN(xb_ld(&bar[XB_XGEN(b.x)]) == gen, bar);
            __builtin_amdgcn_fence(__ATOMIC_ACQUIRE, "agent");
            asm volatile("s_waitcnt vmcnt(0)" ::: "memory");
        }
    }
    __syncthreads();
}

struct Args { const float* in[34]; float* out; unsigned char* ws; float inv32[8]; float inv64[16]; float lam_init[2]; int ph_lo, ph_hi; };
struct Frame {
    LAS unsigned char* lds;
    const float* const* in;
    float* out; unsigned char* ws; unsigned char* ar;
    int tid, lane, wave, blk;
};
enum InIdx { I_X = 0, I_C, I_CTX, I_CCTX, I_WMOD, I_BMOD, I_N1G, I_N2G, I_WIN, I_BGATE, I_DAQG, I_DAKG, I_LQ1, I_LK1, I_LQ2, I_LK2, I_DASUBG, I_GAQG, I_GAKG, I_GMVG, I_GMWS, I_GMBS,
             I_CONVW, I_ALOG, I_DTB, I_GDOUTG, I_WBR, I_WO, I_WR, I_BR, I_WUP, I_BUP, I_WDN, I_BDN };
__device__ __forceinline__ bf16_t* ptile(const Frame& F, int t) { return (bf16_t*)(F.ar + A_P + (size_t)t * PT_BYTES); }
__device__ __forceinline__ const float* modv(const Frame& F, int l, int mi, int which) { return (const float*)(F.ws + WS_MOD) + ((size_t)(l * 17 + mi) * 6144 + which * 1024); }
namespace pg8 {
typedef int v4i_t __attribute__((ext_vector_type(4)));
typedef int v8i_t __attribute__((ext_vector_type(8)));
constexpr int BM = 256, BK = 64, HALF = 128, HTB = HALF * BK * 2, STAGE_BYTES = 8 * HTB, NXCD = 8, WGM = 8;
__host__ __device__ __forceinline__ int lds_byte(int r, int c) { const int st = (r >> 4) * 2 + (c >> 5), rr = r & 15, cc = c & 31, ob = rr * 64 + cc * 2; return st * 1024 + (ob ^ (((ob >> 9) & 1) << 5)); }
__host__ __device__ __forceinline__ void stage_rc(int b, int& R, int& C) { const int st = b / 1024, sb = b % 1024, swz = sb ^ (((sb >> 9) & 1) << 5); R = (st >> 1) * 16 + swz / 64; C = (st & 1) * 32 + (swz % 64) / 2; }
__host__ __device__ __forceinline__ int perm32(int rho) { const int n = rho >> 4, i = rho & 15; return 8 * (i >> 2) + 4 * n + (i & 3); }

struct Unit { int pm, pn, z; };

template <bool F8_>
struct DenseOrderT {
    static constexpr bool GATHER = false, FP8 = F8_;
    __device__ __forceinline__ int scale_w() const { return 0x7a7a7a7a; }
    __device__ __forceinline__ int scale_x() const { return 0x7f7f7f7f; }
    int pn_off = 0;
    __device__ __forceinline__ int arow(const Unit&, int) const { return 0; }
    __device__ __forceinline__ int araw(const Unit&, int) const { return 0; }
    int imax = 1 << 30, single = -1;
    int nM, nN, nwg, G, c; bool skipctx; const char* A; const char* Bt; size_t tstep; int nctx = 0;
    __device__ void init(int nM_, int nN_, int G_, int c_, bool skip, const void* A_, const void* Bt_, int K) { nM = nM_; nN = nN_; nwg = nM * nN; G = G_; c = c_; skipctx = skip; A = (const char*)A_; Bt = (const char*)Bt_; tstep = (size_t)BM * K * (F8_ ? 1 : 2); }
    __device__ bool next(int i, Unit& u) const {
        long L = (long)i * G + c; if (single >= 0) { if (i > 0) return false; L = single; } else if (i >= imax) return false;
        if (L >= nwg + nctx) return false;
        if (L >= nwg) { const int idx = (int)L - nwg, q = idx / 7, t = idx - q * 7;
            u.pm = q * 17; u.pn = (t == 0) ? 1 : (t == 1) ? 2 : (t == 2) ? 4 : (t == 3) ? 7 : (t == 4) ? 8 : (t == 5) ? 9 : 11; u.z = 0; return true; }
        int wgid = (int)L; { const int q = nwg / NXCD, r = nwg % NXCD, xcd = wgid % NXCD, off = wgid / NXCD; wgid = (xcd < r ? xcd * (q + 1) : r * (q + 1) + (xcd - r) * q) + off; }
        const int nig = WGM * nN, gid = wgid / nig, fm = gid * WGM, gsz = (nM - fm) < WGM ? (nM - fm) : WGM;
        int pm = fm + ((wgid % nig) % gsz); u.pn = (wgid % nig) / gsz + pn_off; u.z = 0;
        if (skipctx) pm = (pm >> 4) * 17 + 1 + (pm & 15);
        u.pm = pm; return true;
    }
    __device__ __forceinline__ const char* abase(const Unit& u) const { return A + (size_t)u.pm * tstep; }
    __device__ __forceinline__ const char* bbase(const Unit& u) const { return Bt + (size_t)(u.pn - pn_off) * tstep; }
};
typedef DenseOrderT<false> DenseOrder;

template <class Epi, class Sched, bool ALIGN = true>
__device__ __forceinline__ void gemm_phase(LAS unsigned char* lds, const int tid, const int K, const Sched& S, const Epi& E) {
    const int wid = __builtin_amdgcn_readfirstlane(tid >> 6), lane = tid & 63, wr = wid >> 2, wc = wid & 3, fr = lane & 15, fq = lane >> 4;
    constexpr bool F8 = Sched::FP8;
    const int RB = F8 ? K : 2 * K;
    const int nt = RB / 128;
    unsigned voffA[2], voffB[2];
#pragma unroll
    for (int i = 0; i < 2; ++i) { int R, C; stage_rc(tid * 16 + i * 8192, R, C); const int Rb = (R & ~31) + perm32(R & 31);
        voffA[i] = (unsigned)(R * RB + C * 2); voffB[i] = (unsigned)(Rb * RB + C * 2); }
    const size_t kstep = (size_t)(BK * 2);
    const size_t hstep = (size_t)HALF * RB;
    int Rst[2], Cst[2];
#pragma unroll
    for (int i = 0; i < 2; ++i) stage_rc(tid * 16 + i * 8192, Rst[i], Cst[i]);
    unsigned gA[2][2], ngA[2][2];
    const unsigned ldsw = (unsigned)wid * 1024u;
    const int aoff = lds_byte(wr * 64 + fr, fq * 8), boff = lds_byte(wc * 32 + fr, fq * 8);
#define PG8_SA(b, h) (((b) * 2 + (h)) * HTB)
#define PG8_SB(b, h) ((4 + (b) * 2 + (h)) * HTB)
#define PG8_STAGE(bufoff, gbase, voff) do { _Pragma("unroll") for (int _i = 0; _i < 2; ++_i) \
        __builtin_amdgcn_global_load_lds((const unsigned*)((const char*)(gbase) + (voff)[_i]), (LAS unsigned*)(lds + (bufoff) + ldsw + _i * 8192), 16, 0, 0); } while (0)
#define PG8_GLOAD(dst, u_) do { if constexpr (Sched::GATHER) { _Pragma("unroll") for (int _h = 0; _h < 2; ++_h) _Pragma("unroll") for (int _i = 0; _i < 2; ++_i) \
        dst[_h][_i] = (unsigned)S.arow((u_), _h * HALF + Rst[_i]) * (unsigned)RB + (unsigned)(Cst[_i] * 2); } } while (0)
#define PG8_STAGE_A(bufoff, gbase, h_, nx_) do { if constexpr (Sched::GATHER) { _Pragma("unroll") for (int _i = 0; _i < 2; ++_i) \
        __builtin_amdgcn_global_load_lds((const unsigned*)((const char*)(gbase) + ((nx_) ? ngA[h_][_i] : gA[h_][_i])), (LAS unsigned*)(lds + (bufoff) + ldsw + _i * 8192), 16, 0, 0); } \
        else PG8_STAGE(bufoff, (gbase) + (h_) * hstep, voffA); } while (0)
#define PG8_LD32(p_) __builtin_shufflevector(*(const LAS v4i_t*)(p_), *(const LAS v4i_t*)((p_) + 1024), 0, 1, 2, 3, 4, 5, 6, 7)
#define PG8_LDA(dst, b, h) do { if constexpr (F8) { _Pragma("unroll") for (int m = 0; m < 4; ++m) dst##8[m] = PG8_LD32(lds + PG8_SA(b, h) + aoff + m * 2048); } \
        else { _Pragma("unroll") for (int m = 0; m < 4; ++m) _Pragma("unroll") for (int k = 0; k < 2; ++k) dst[m][k] = *(const LAS bf16x8*)(lds + PG8_SA(b, h) + aoff + m * 2048 + k * 1024); } } while (0)
#define PG8_LDB(dst, b, h) do { if constexpr (F8) { _Pragma("unroll") for (int n = 0; n < 2; ++n) dst##8[n] = PG8_LD32(lds + PG8_SB(b, h) + boff + n * 2048); } \
        else { _Pragma("unroll") for (int n = 0; n < 2; ++n) _Pragma("unroll") for (int k = 0; k < 2; ++k) dst[n][k] = *(const LAS bf16x8*)(lds + PG8_SB(b, h) + boff + n * 2048 + k * 1024); } } while (0)
#define PG8_MMA(ai, bj, At, Bt) do { __builtin_amdgcn_s_setprio(1); _Pragma("unroll") for (int m = 0; m < 4; ++m) _Pragma("unroll") for (int n = 0; n < 2; ++n) { \
        if constexpr (F8) asm volatile("v_mfma_scale_f32_16x16x128_f8f6f4 %0, %1, %2, %0, %3, %4 op_sel_hi:[0,0,0]" : "+v"(acc[ai][bj][m][n]) : "v"(Bt##8[n]), "v"(At##8[m]), "v"(sclw), "v"(sclx)); \
        else { _Pragma("unroll") for (int k = 0; k < 2; ++k) acc[ai][bj][m][n] = __builtin_amdgcn_mfma_f32_16x16x32_bf16(Bt[n][k], At[m][k], acc[ai][bj][m][n], 0, 0, 0); } } \
        __builtin_amdgcn_s_setprio(0); } while (0)
#define PG8_WAIT_V(n) asm volatile("s_waitcnt vmcnt(" #n ")" ::: "memory")
#define PG8_WAIT_L(n) asm volatile("s_waitcnt lgkmcnt(" #n ")" ::: "memory")
#define PG8_BAR __builtin_amdgcn_s_barrier()
#define PG8_SCHED __builtin_amdgcn_sched_barrier(0)
    Unit cur, nxt; int ui = 0;
    if (!S.next(0, cur)) return;
    f32x4 acc[2][2][4][2];
#pragma unroll
    for (int a = 0; a < 2; ++a)
#pragma unroll
        for (int b = 0; b < 2; ++b)
#pragma unroll
            for (int m = 0; m < 4; ++m)
#pragma unroll
                for (int n = 0; n < 2; ++n) acc[a][b][m][n] = (f32x4){0.f, 0.f, 0.f, 0.f};
    bf16x8 At[4][2], B0[2][2], B1[2][2];
    v8i_t At8[4], B08[2], B18[2];
    const int sclw = S.scale_w(), sclx = S.scale_x();
    const char* cA = S.abase(cur); const char* cB = S.bbase(cur);
    PG8_GLOAD(gA, cur);
    if constexpr (Sched::GATHER) { _Pragma("unroll") for (int _h = 0; _h < 2; ++_h) _Pragma("unroll") for (int _i = 0; _i < 2; ++_i) ngA[_h][_i] = gA[_h][_i]; asm volatile("s_waitcnt vmcnt(0)" ::: "memory"); }
    PG8_STAGE(PG8_SB(0, 0), cB, voffB); PG8_STAGE(PG8_SB(0, 1), cB + hstep, voffB); PG8_STAGE_A(PG8_SA(0, 0), cA, 0, false); PG8_STAGE_A(PG8_SA(0, 1), cA, 1, false);
    if (wr == 1) PG8_BAR;
    PG8_WAIT_V(2); PG8_BAR;
    PG8_STAGE(PG8_SB(1, 0), cB + kstep, voffB); PG8_STAGE_A(PG8_SA(1, 0), cA + kstep, 0, false); PG8_STAGE(PG8_SB(1, 1), cB + hstep + kstep, voffB);
    PG8_WAIT_V(6); PG8_BAR;
    for (;;) {
        const bool has_next = S.next(ui + 1, nxt);
        const char* nA = has_next ? S.abase(nxt) : cA; const char* nB = has_next ? S.bbase(nxt) : cB;
        int rawn[2][2];
        if constexpr (Sched::GATHER) { if (has_next) { _Pragma("unroll") for (int _h = 0; _h < 2; ++_h) _Pragma("unroll") for (int _i = 0; _i < 2; ++_i) rawn[_h][_i] = S.araw(nxt, _h * HALF + Rst[_i]); } }
#pragma unroll 1
        for (int t = 0; t < nt; t += 2) {
            const bool last = (t == nt - 2);
            const char* a1 = cA + (size_t)(t + 1) * kstep;
            const char* a2 = last ? nA : cA + (size_t)(t + 2) * kstep; const char* b2 = last ? nB : cB + (size_t)(t + 2) * kstep;
            const char* a3 = a2 + kstep; const char* b3 = b2 + kstep;
            if constexpr (Sched::GATHER) { if (last && has_next) { _Pragma("unroll") for (int _h = 0; _h < 2; ++_h) _Pragma("unroll") for (int _i = 0; _i < 2; ++_i)
                ngA[_h][_i] = (unsigned)(rawn[_h][_i] < 0 ? 0 : rawn[_h][_i] >> 2) * (unsigned)RB + (unsigned)(Cst[_i] * 2); } }
            PG8_LDB(B0, 0, 0); PG8_LDB(B1, 0, 1); PG8_SCHED; PG8_LDA(At, 0, 0); PG8_STAGE_A(PG8_SA(1, 1), a1, 1, false);
            PG8_WAIT_V(8); PG8_WAIT_L(0); PG8_BAR; PG8_MMA(0, 0, At, B0); PG8_MMA(0, 1, At, B1); PG8_BAR; PG8_SCHED;
            PG8_LDA(At, 0, 1); PG8_STAGE(PG8_SB(0, 0), b2, voffB); PG8_STAGE(PG8_SB(0, 1), b2 + hstep, voffB); PG8_STAGE_A(PG8_SA(0, 0), a2, 0, last);
            PG8_WAIT_V(8); PG8_WAIT_L(0); PG8_BAR; PG8_MMA(1, 0, At, B0); PG8_MMA(1, 1, At, B1); PG8_BAR; PG8_SCHED;
            PG8_LDB(B0, 1, 0); PG8_LDB(B1, 1, 1); PG8_SCHED; PG8_LDA(At, 1, 0); PG8_STAGE_A(PG8_SA(0, 1), a2, 1, last);
            PG8_WAIT_V(8); PG8_WAIT_L(0); PG8_BAR; PG8_MMA(0, 0, At, B0); PG8_MMA(0, 1, At, B1); PG8_BAR; PG8_SCHED;
            PG8_LDA(At, 1, 1); PG8_STAGE(PG8_SB(1, 0), b3, voffB); PG8_STAGE(PG8_SB(1, 1), b3 + hstep, voffB); PG8_STAGE_A(PG8_SA(1, 0), a3, 0, last);
            PG8_WAIT_V(8); PG8_WAIT_L(0); PG8_BAR; PG8_MMA(1, 0, At, B0); PG8_MMA(1, 1, At, B1); PG8_BAR; PG8_SCHED;
        }
        if (ALIGN) { if (wr == 0) PG8_BAR; }
        bool keep = false;
        if constexpr (F8) asm volatile("s_nop 15\n\ts_nop 15" ::: "memory");
        { int tz = tid; asm volatile("" : "+v"(tz)); const int wid2 = __builtin_amdgcn_readfirstlane(tz >> 6), lane2 = tz & 63;
          if constexpr (Epi::CHAIN) keep = E(acc, cur, wid2 >> 2, wid2 & 3, lane2 & 15, lane2 >> 4); else { E(acc, cur, wid2 >> 2, wid2 & 3, lane2 & 15, lane2 >> 4); if constexpr (Epi::TWICE) { asm volatile("" ::: "memory"); E(acc, cur, wid2 >> 2, wid2 & 3, lane2 & 15, lane2 >> 4); } } }
        if (!has_next) break;
        if (!keep)
#pragma unroll
        for (int a = 0; a < 2; ++a)
#pragma unroll
            for (int b = 0; b < 2; ++b)
#pragma unroll
                for (int m = 0; m < 4; ++m)
#pragma unroll
                    for (int n = 0; n < 2; ++n) acc[a][b][m][n] = (f32x4){0.f, 0.f, 0.f, 0.f};
        cur = nxt; cA = nA; cB = nB; ++ui;
        if constexpr (Sched::GATHER) { _Pragma("unroll") for (int _h = 0; _h < 2; ++_h) _Pragma("unroll") for (int _i = 0; _i < 2; ++_i) gA[_h][_i] = ngA[_h][_i]; }
        if (ALIGN) { if (wr == 1) PG8_BAR; }
    }
    PG8_WAIT_V(0);
    if (!ALIGN) { if (wr == 0) PG8_BAR; }
    PG8_BAR;
#undef PG8_SA
#undef PG8_SB
#undef PG8_STAGE
#undef PG8_STAGE_A
#undef PG8_GLOAD
#undef PG8_LDA
#undef PG8_LDB
#undef PG8_MMA
#undef PG8_LD32
#undef PG8_WAIT_V
#undef PG8_WAIT_L
#undef PG8_BAR
#undef PG8_SCHED
}
}
using pg8::Unit;
typedef f32x4 AccT[2][2][4][2];

__device__ __forceinline__ u32x4 pack8(const f32x4 v0, const f32x4 v1) { u32x4 w; w.x = cvt_pk(v0[0], v0[1]); w.y = cvt_pk(v0[2], v0[3]); w.z = cvt_pk(v1[0], v1[1]); w.w = cvt_pk(v1[2], v1[3]); return w; }
constexpr float YSCL = 16.f;
__device__ __forceinline__ u32x2 pack8f8(const f32x4 v0, const f32x4 v1) { int w0 = 0, w1 = 0;
    w0 = __builtin_amdgcn_cvt_pk_fp8_f32(v0[0], v0[1], w0, false); w0 = __builtin_amdgcn_cvt_pk_fp8_f32(v0[2], v0[3], w0, true);
    w1 = __builtin_amdgcn_cvt_pk_fp8_f32(v1[0], v1[1], w1, false); w1 = __builtin_amdgcn_cvt_pk_fp8_f32(v1[2], v1[3], w1, true); return (u32x2){(unsigned)w0, (unsigned)w1}; }
__device__ __forceinline__ void unpack8f8(const u32x2 w, f32x4& v0, f32x4& v1) {
    const f32x2 a = __builtin_amdgcn_cvt_pk_f32_fp8((int)w.x, false), b = __builtin_amdgcn_cvt_pk_f32_fp8((int)w.x, true), c = __builtin_amdgcn_cvt_pk_f32_fp8((int)w.y, false), d = __builtin_amdgcn_cvt_pk_f32_fp8((int)w.y, true);
    v0 = (f32x4){a[0], a[1], b[0], b[1]}; v1 = (f32x4){c[0], c[1], d[0], d[1]}; }
__device__ __forceinline__ void unpack8(const u32x4 w, f32x4& v0, f32x4& v1) { v0 = (f32x4){bf_lo(w.x), bf_hi(w.x), bf_lo(w.y), bf_hi(w.y)}; v1 = (f32x4){bf_lo(w.z), bf_hi(w.z), bf_lo(w.w), bf_hi(w.w)}; }

struct EpiTiles {
    static constexpr bool CHAIN = false, TWICE = (PROBE_REP & 1024) != 0;
    bf16_t* P; const float* bgate;
    __device__ __forceinline__ void operator()(const AccT& acc, const Unit& u, int wr, int wc, int fr, int fq) const {
        bf16_t* base = P + (size_t)u.pn * ((size_t)NR * 256) + (size_t)(u.pm * 256 + wr * 64 + fr) * 256 + wc * 32 + 8 * fq;
        if (u.pn < T_GATE) {
#pragma unroll
            for (int ai = 0; ai < 2; ++ai)
#pragma unroll
                for (int m = 0; m < 4; ++m)
#pragma unroll
                    for (int bj = 0; bj < 2; ++bj)
                        *(u32x4*)(base + (size_t)(ai * 128 + m * 16) * 256 + bj * 128) = pack8(acc[ai][bj][m][0], acc[ai][bj][m][1]);
        } else {
            unsigned char* gb = (unsigned char*)(P + (size_t)u.pn * ((size_t)NR * 256)) + (size_t)u.pm * 65536 + (((wr * 4 + wc) * 64 + fq * 16 + fr) * 16);
            const float* bg = bgate + ((u.pn - T_GATE) >> 2) * 1024 + ((u.pn - T_GATE) & 3) * 256 + wc * 32 + 8 * fq;
#pragma unroll
            for (int bj = 0; bj < 2; ++bj) {
                const f32x4 b0 = *(const f32x4*)(bg + bj * 128) * -LOG2E, b1 = *(const f32x4*)(bg + bj * 128 + 4) * -LOG2E;
#define GATE255(a_, b_) __builtin_amdgcn_rcpf(__builtin_fmaf(__builtin_amdgcn_exp2f(__builtin_fmaf((a_), -LOG2E, (b_))), 1.f / 255.f, 1.f / 255.f))
#pragma unroll
                for (int ai = 0; ai < 2; ++ai)
#pragma unroll
                    for (int mp = 0; mp < 2; ++mp) {
                        u32x4 o = (u32x4){0u, 0u, 0u, 0u};
#pragma unroll
                        for (int j = 0; j < 4; ++j) {
                            o.x = __builtin_amdgcn_cvt_pk_u8_f32(GATE255(acc[ai][bj][2 * mp][0][j], b0[j]), j, o.x); o.y = __builtin_amdgcn_cvt_pk_u8_f32(GATE255(acc[ai][bj][2 * mp][1][j], b1[j]), j, o.y);
                            o.z = __builtin_amdgcn_cvt_pk_u8_f32(GATE255(acc[ai][bj][2 * mp + 1][0][j], b0[j]), j, o.z); o.w = __builtin_amdgcn_cvt_pk_u8_f32(GATE255(acc[ai][bj][2 * mp + 1][1][j], b1[j]), j, o.w); }
#undef GATE255
                        o.x |= 0x01010101u; o.y |= 0x01010101u; o.z |= 0x01010101u; o.w |= 0x01010101u;
                        *(u32x4*)(gb + ((bj * 2 + ai) * 2 + mp) * 8192) = o;
                    }
            }
        }
    }
};

struct MergeOrder {
    static constexpr bool GATHER = false, FP8 = false;
    __device__ __forceinline__ int scale_w() const { return 0; }
    __device__ __forceinline__ int scale_x() const { return 0; }
    __device__ __forceinline__ int arow(const Unit&, int) const { return 0; }
    __device__ __forceinline__ int araw(const Unit&, int) const { return 0; }
    int G, c, ntile; bool skipctx; const char* P; const char* Wbr;
    __device__ bool next(int i, Unit& u) const {
        const int w = (i >> 2) * (G >> 3) + (c >> 3); if (w >= (ntile >> 3)) return false;
        int pm = (c & 7) + 8 * (w >> 2); u.pn = w & 3; u.z = i & 3;
        if (skipctx) pm = (pm >> 4) * 17 + 1 + (pm & 15);
        u.pm = pm; return true;
    }
    __device__ __forceinline__ const char* abase(const Unit& u) const { const int tz = (u.z == 0) ? T_AQ : (u.z == 1) ? T_GQ : (u.z == 2) ? T_MU : T_DG; return P + (size_t)tz * PT_BYTES + (size_t)u.pm * (256 * 256 * 2); }
    __device__ __forceinline__ const char* bbase(const Unit& u) const { return Wbr + (size_t)u.z * (1024 * 256 * 2) + (size_t)u.pn * (256 * 256 * 2); }
};
struct EpiMerge {
    static constexpr bool CHAIN = true, TWICE = false;
    const bf16_t* P; bf16_t* merged;
    __device__ __forceinline__ bool operator()(AccT& acc, const Unit& u, int wr, int wc, int fr, int fq) const {
        const int row0 = u.pm * 256 + wr * 64 + fr, colt = wc * 32 + 8 * fq;
        const unsigned char* g0p = (const unsigned char*)(P + (size_t)(T_GATE + 4 * u.z + u.pn) * ((size_t)NR * 256)) + (size_t)u.pm * 65536 + (((wr * 4 + wc) * 64 + fq * 16 + fr) * 16);
        if (u.z < 3) {
            const unsigned char* g1p = g0p + (size_t)4 * PT_BYTES;
            u32x4 ga[2][2], gb[2][2];
#pragma unroll
            for (int q = 0; q < 2; ++q)
#pragma unroll
                for (int h = 0; h < 2; ++h) { ga[q][h] = *(const u32x4*)(g0p + (2 * q + h) * 8192); gb[q][h] = *(const u32x4*)(g1p + (2 * q + h) * 8192); }
#pragma unroll
            for (int q = 0; q < 4; ++q) {
                const int bj = q >> 1, ai = q & 1;
#pragma unroll
                for (int m = 0; m < 4; ++m) {
                    const u32x4 A = ga[q & 1][m >> 1], B = gb[q & 1][m >> 1];
                    const unsigned a0 = (m & 1) ? A.z : A.x, a1 = (m & 1) ? A.w : A.y, b0 = (m & 1) ? B.z : B.x, b1 = (m & 1) ? B.w : B.y;
#pragma unroll
                    for (int j = 0; j < 4; ++j) {
                        acc[ai][bj][m][0][j] *= (float)((a0 >> (8 * j)) & 0xffu) * __builtin_amdgcn_rcpf((float)((b0 >> (8 * j)) & 0xffu));
                        acc[ai][bj][m][1][j] *= (float)((a1 >> (8 * j)) & 0xffu) * __builtin_amdgcn_rcpf((float)((b1 >> (8 * j)) & 0xffu));
                    }
                }
                if (q < 2) {
#pragma unroll
                    for (int h = 0; h < 2; ++h) { ga[q & 1][h] = *(const u32x4*)(g0p + (2 * (q + 2) + h) * 8192); gb[q & 1][h] = *(const u32x4*)(g1p + (2 * (q + 2) + h) * 8192); }
                }
            }
            return true;
        }
        u32x4 ga[8];
#pragma unroll
        for (int i = 0; i < 8; ++i) ga[i] = *(const u32x4*)(g0p + i * 8192);
        bf16_t* mp = merged + (size_t)row0 * 1024 + u.pn * 256 + colt;
#pragma unroll
        for (int bj = 0; bj < 2; ++bj)
#pragma unroll
            for (int ai = 0; ai < 2; ++ai)
#pragma unroll
                for (int m = 0; m < 4; ++m) {
                    const int i = (bj * 2 + ai) * 2 + (m >> 1);
                    const unsigned a0 = (m & 1) ? ga[i].z : ga[i].x, a1 = (m & 1) ? ga[i].w : ga[i].y;
                    f32x4 o0, o1;
#pragma unroll
                    for (int j = 0; j < 4; ++j) { o0[j] = acc[ai][bj][m][0][j] * ((float)((a0 >> (8 * j)) & 0xffu) * (1.f / 255.f)); o1[j] = acc[ai][bj][m][1][j] * ((float)((a1 >> (8 * j)) & 0xffu) * (1.f / 255.f)); }
                    *(u32x4*)(mp + (size_t)(ai * 128 + m * 16) * 1024 + bj * 128) = pack8(o0, o1);
                }
        return false;
    }
};

struct EpiWo {
    static constexpr bool CHAIN = false, TWICE = false;
    const float* xin_lat; const float* xin_ctx; bf16_t* xb; const float* mod_l;
    int which;
    __device__ __forceinline__ void operator()(const AccT& acc, const Unit& u, int wr, int wc, int fr, int fq) const {
        const int b = u.pm / 17, j = u.pm - b * 17; const bool isctx = (j == 0);
        const float* gv = mod_l + (size_t)(isctx ? 16 : b) * 6144 + which * 1024 + u.pn * 256 + wc * 32 + 8 * fq;
        const int r0 = wr * 64 + fr; const int c0 = u.pn * 256 + wc * 32 + 8 * fq;
        bf16_t* xo = xb + (size_t)u.pm * 256 * 1024;
        if (xin_lat != nullptr) {
            const float* xin = isctx ? xin_ctx + (size_t)b * 256 * 1024 : xin_lat + ((size_t)b * 4096 + (size_t)(j - 1) * 256) * 1024;
#pragma unroll
            for (int bj = 0; bj < 2; ++bj) {
                const f32x4 g0 = *(const f32x4*)(gv + bj * 128), g1 = *(const f32x4*)(gv + bj * 128 + 4);
#pragma unroll
                for (int ai = 0; ai < 2; ++ai)
#pragma unroll
                    for (int m = 0; m < 4; ++m) {
                        const size_t off = (size_t)(r0 + ai * 128 + m * 16) * 1024 + c0 + bj * 128;
                        const f32x4 x0 = *(const f32x4*)(xin + off), x1 = *(const f32x4*)(xin + off + 4);
                        *(u32x4*)(xo + off) = pack8(x0 + g0 * acc[ai][bj][m][0], x1 + g1 * acc[ai][bj][m][1]);
                    }
            }
        } else {
#pragma unroll
            for (int bj = 0; bj < 2; ++bj) {
                const f32x4 g0 = *(const f32x4*)(gv + bj * 128), g1 = *(const f32x4*)(gv + bj * 128 + 4);
#pragma unroll
                for (int ai = 0; ai < 2; ++ai)
#pragma unroll
                    for (int m = 0; m < 4; ++m) {
                        const size_t off = (size_t)(r0 + ai * 128 + m * 16) * 1024 + c0 + bj * 128;
                        f32x4 x0, x1; unpack8(*(const u32x4*)(xo + off), x0, x1);
                        *(u32x4*)(xo + off) = pack8(x0 + g0 * acc[ai][bj][m][0], x1 + g1 * acc[ai][bj][m][1]);
                    }
            }
        }
    }
};

template <int NPN, bool GATH>
struct MoeOrder {
    static constexpr bool GATHER = GATH, FP8 = true;
    __device__ __forceinline__ int scale_w() const { return 0x7a7a7a7a; }
    __device__ __forceinline__ int scale_x() const { return 0x7f7f7f7f; }
    int G, c, nunits; const LAS int* texp; const char* A; const char* W; size_t wstride; const int* rowmap;
    __device__ __forceinline__ int arow(const Unit& u, int r) const { const int rm = rowmap[u.pm * 256 + r]; return rm < 0 ? 0 : rm >> 2; }
    __device__ __forceinline__ int araw(const Unit& u, int r) const { return rowmap[u.pm * 256 + r]; }
    __device__ bool next(int i, Unit& u) const {
        constexpr int RT = 32 / NPN;
        const int xcd = c & 7, idx = c >> 3, rt = idx / NPN;
        const int pm = (i * RT + rt) * 8 + xcd; if (pm * NPN >= nunits) return false;
        u.pm = pm; u.pn = idx % NPN; u.z = texp[pm]; return true;
    }
    __device__ __forceinline__ const char* abase(const Unit& u) const { return GATH ? A : A + (size_t)u.pm * (256 * 1024); }
    __device__ __forceinline__ const char* bbase(const Unit& u) const { return W + (size_t)u.z * wstride + (size_t)u.pn * (256 * 1024); }
};
struct EpiUp {
    static constexpr bool CHAIN = false, TWICE = false;
    const float* bup; unsigned char* act;
    __device__ __forceinline__ void operator()(const AccT& acc, const Unit& u, int wr, int wc, int fr, int fq) const {
        const int colt = u.pn * 128 + wc * 32 + 8 * fq;
        const float* bb = bup + (size_t)u.z * 2048 + colt;
        const f32x4 bg0 = *(const f32x4*)(bb), bg1 = *(const f32x4*)(bb + 4), bl0 = *(const f32x4*)(bb + 1024) + 1.f, bl1 = *(const f32x4*)(bb + 1028) + 1.f;
        unsigned char* base = act + (size_t)(u.pm * 256 + wr * 64 + fr) * 1024 + colt;
#pragma unroll
        for (int ai = 0; ai < 2; ++ai)
#pragma unroll
            for (int m = 0; m < 4; ++m) {
                f32x4 o0, o1;
#pragma unroll
                for (int j = 0; j < 4; ++j) {
                    float g = fminf(acc[ai][0][m][0][j] + bg0[j], 7.f), li = fminf(fmaxf(acc[ai][1][m][0][j] + bl0[j], -6.f), 8.f);
                    o0[j] = g * sigmoidf_(1.702f * g) * li;
                    g = fminf(acc[ai][0][m][1][j] + bg1[j], 7.f); li = fminf(fmaxf(acc[ai][1][m][1][j] + bl1[j], -6.f), 8.f);
                    o1[j] = g * sigmoidf_(1.702f * g) * li;
                }
                int w0 = 0, w1 = 0;
                w0 = __builtin_amdgcn_cvt_pk_fp8_f32(o0[0], o0[1], w0, false); w0 = __builtin_amdgcn_cvt_pk_fp8_f32(o0[2], o0[3], w0, true);
                w1 = __builtin_amdgcn_cvt_pk_fp8_f32(o1[0], o1[1], w1, false); w1 = __builtin_amdgcn_cvt_pk_fp8_f32(o1[2], o1[3], w1, true);
                *(u32x2*)(base + (size_t)(ai * 128 + m * 16) * 1024) = (u32x2){(unsigned)w0, (unsigned)w1};
            }
    }
};
struct EpiDown {
    static constexpr bool CHAIN = false, TWICE = false;
    const float* bdn; const float* gslot; unsigned char* ybuf;
    __device__ __forceinline__ void operator()(const AccT& acc, const Unit& u, int wr, int wc, int fr, int fq) const {
        const int colt = u.pn * 256 + wc * 32 + 8 * fq;
        const float* bb = bdn + (size_t)u.z * 1024 + colt;
        const f32x4 b00 = *(const f32x4*)(bb), b01 = *(const f32x4*)(bb + 4), b10 = *(const f32x4*)(bb + 128), b11 = *(const f32x4*)(bb + 132);
        const int row0 = u.pm * 256 + wr * 64 + fr;
        float gtv[2][4];
#pragma unroll
        for (int ai = 0; ai < 2; ++ai)
#pragma unroll
            for (int m = 0; m < 4; ++m) gtv[ai][m] = gslot[row0 + ai * 128 + m * 16];
#pragma unroll
        for (int ai = 0; ai < 2; ++ai)
#pragma unroll
            for (int m = 0; m < 4; ++m) {
                const float gt = gtv[ai][m] * YSCL;
                unsigned char* yp = ybuf + (size_t)(row0 + ai * 128 + m * 16) * 1024 + colt;
                *(u32x2*)(yp) = pack8f8((acc[ai][0][m][0] + b00) * gt, (acc[ai][0][m][1] + b01) * gt);
                *(u32x2*)(yp + 128) = pack8f8((acc[ai][1][m][0] + b10) * gt, (acc[ai][1][m][1] + b11) * gt);
            }
    }
};
__device__ __forceinline__ void xpose_tile(const float* __restrict__ src, int ld, int valid, bf16_t* __restrict__ dst, int Kd, LAS float* scr, int lane) {
    const int c4 = (lane & 15) * 4, kr = lane >> 4;
    f32x4 v[16];
#pragma unroll
    for (int i = 0; i < 16; ++i) v[i] = (c4 < valid) ? *(const f32x4*)(src + (size_t)(i * 4 + kr) * ld + c4) : (f32x4){0.f, 0.f, 0.f, 0.f};
#pragma unroll
    for (int i = 0; i < 16; ++i) { LAS float* s = scr + (i * 4 + kr) * 65 + c4; s[0] = v[i][0]; s[1] = v[i][1]; s[2] = v[i][2]; s[3] = v[i][3]; }
    LDS_WAIT(); asm volatile("" ::: "memory");
    const int c = lane & 7;
#pragma unroll
    for (int j = 0; j < 8; ++j) { const int n = (lane >> 3) + 8 * j; const LAS float* s = scr + (8 * c) * 65 + n;
        u32x4 o; o.x = cvt_pk(s[0 * 65], s[1 * 65]); o.y = cvt_pk(s[2 * 65], s[3 * 65]); o.z = cvt_pk(s[4 * 65], s[5 * 65]); o.w = cvt_pk(s[6 * 65], s[7 * 65]);
        *(u32x4*)(dst + (size_t)n * Kd + 8 * c) = o; }
    LDS_WAIT(); asm volatile("" ::: "memory");
}

__device__ __forceinline__ void xpose_tile8(const float* __restrict__ src, int ld, unsigned char* __restrict__ dst, int Kd, LAS float* scr, int lane) {
    const int c4 = (lane & 7) * 4, kr = lane >> 3;
    const float* sp = src + (size_t)kr * ld + c4; const size_t rstep = (size_t)8 * ld;
    f32x4 v[16];
#pragma unroll
    for (int i = 0; i < 16; ++i) v[i] = *(const f32x4*)(sp + i * rstep);
    LAS float* sw = scr + kr * 33 + c4;
#pragma unroll
    for (int i = 0; i < 16; ++i) { LAS float* s = sw + i * (8 * 33); s[0] = v[i][0]; s[1] = v[i][1]; s[2] = v[i][2]; s[3] = v[i][3]; }
    LDS_WAIT(); asm volatile("" ::: "memory");
    const int c = lane & 7;
#pragma unroll
    for (int j = 0; j < 4; ++j) { const int n = (lane >> 3) + 8 * j; const LAS float* s = scr + (16 * c) * 33 + n;
#define F8W(q_) __builtin_amdgcn_cvt_pk_fp8_f32(s[(4 * (q_) + 2) * 33] * 32.f, s[(4 * (q_) + 3) * 33] * 32.f, __builtin_amdgcn_cvt_pk_fp8_f32(s[(4 * (q_)) * 33] * 32.f, s[(4 * (q_) + 1) * 33] * 32.f, 0, false), true)
        const int w0 = F8W(0), w1 = F8W(1), w2 = F8W(2), w3 = F8W(3);
#undef F8W
        *(u32x4*)(dst + (size_t)n * Kd + 16 * c) = (u32x4){(unsigned)w0, (unsigned)w1, (unsigned)w2, (unsigned)w3}; }
    LDS_WAIT(); asm volatile("" ::: "memory");
}

__device__ __forceinline__ void p_prologue(const Frame& F, const Args& a) {
    LAS float* scr = (LAS float*)(F.lds + F.wave * 16896);
    const int gw = F.blk * 8 + F.wave, NGW = GRID * 8;
    constexpr int N_IN = 16 * 112, N_BR = 4 * 4 * 16, N_O = 256, N_UP = 32 * 16 * 32, N_DN = 32 * 16 * 16, N_L = N_IN + N_BR + N_O + N_UP + N_DN;
    for (int it = gw; it < 2 * N_L; it += NGW) {
        const int l = it / N_L; int r = it - l * N_L;
        if (r < N_IN) {
            const int kt = r / 112, ntile = r - kt * 112, n0 = ntile * 64;
            int src0, valid;
            if (n0 < 2816) { src0 = n0; valid = 64; } else if (n0 == 2816) { src0 = 2816; valid = 16; } else if (n0 < 3072) { src0 = 0; valid = 0; } else { src0 = n0 - 240; valid = 64; }
            if (n0 < 3072) xpose_tile(F.in[I_WIN] + (size_t)l * 1024 * 6928 + (size_t)(kt * 64) * 6928 + src0, 6928, valid,
                       (bf16_t*)(F.ws + WS_WIN) + (size_t)l * 7168 * 1024 + (size_t)n0 * 1024 + kt * 64, 1024, scr, F.lane);
            else { const int k8 = (kt >> 1) * 128, ns = (kt & 1) * 32;
                xpose_tile8(F.in[I_WIN] + (size_t)l * 1024 * 6928 + (size_t)k8 * 6928 + src0 + ns, 6928,
                       (unsigned char*)(F.ws + WS_WG8) + (size_t)l * 4096 * 1024 + (size_t)(n0 - 3072 + ns) * 1024 + k8, 1024, scr, F.lane); }
            continue; }
        r -= N_IN;
        if (r < N_BR) {
            const int n = r >> 6, rr = r & 63, kt = rr >> 4, ntile = rr & 15;
            xpose_tile(F.in[I_WBR] + ((size_t)(l * 4 + n) * 256 + kt * 64) * 1024 + ntile * 64, 1024, 64,
                       (bf16_t*)(F.ws + WS_WBR) + (size_t)(l * 4 + n) * 1024 * 256 + (size_t)(ntile * 64) * 256 + kt * 64, 256, scr, F.lane);
            continue; }
        r -= N_BR;
        if (r < N_O) {
            const int kt = r >> 4, ntile = r & 15;
            xpose_tile(F.in[I_WO] + ((size_t)l * 1024 + kt * 64) * 1024 + ntile * 64, 1024, 64,
                       (bf16_t*)(F.ws + WS_WO) + (size_t)l * 1024 * 1024 + (size_t)(ntile * 64) * 1024 + kt * 64, 1024, scr, F.lane);
            continue; }
        r -= N_O;
        if (r < N_UP) {
            const int e = r >> 9, rr = r & 511, kt = rr >> 5, ntile = rr & 31, k8 = (kt >> 1) * 128, n0 = ntile * 64 + (kt & 1) * 32;
            const int j = n0 >> 8, w = n0 & 255, src0 = (w < 128) ? (128 * j + w) : (1024 + 128 * j + (w - 128));
            xpose_tile8(F.in[I_WUP] + ((size_t)(l * 32 + e) * 1024 + k8) * 2048 + src0, 2048,
                        (unsigned char*)(F.ws + WS_WUP) + (size_t)(l * 32 + e) * 2048 * 1024 + (size_t)n0 * 1024 + k8, 1024, scr, F.lane);
            continue; }
        r -= N_UP;
        {
            const int e = r >> 8, rr = r & 255, kt = rr >> 4, ntile = rr & 15, k8 = (kt >> 1) * 128, n0 = ntile * 64 + (kt & 1) * 32;
            xpose_tile8(F.in[I_WDN] + ((size_t)(l * 32 + e) * 1024 + k8) * 1024 + n0, 1024,
                        (unsigned char*)(F.ws + WS_WDN) + (size_t)(l * 32 + e) * 1024 * 1024 + (size_t)n0 * 1024 + k8, 1024, scr, F.lane);
        }
    }
    { const int gt = F.blk * 512 + F.tid, NT = GRID * 512; const float* s = F.in[I_GMWS]; bf16_t* d = (bf16_t*)(F.ws + WS_GMWS);
      for (int i = gt; i < 2 * 4 * 128 * 128 / 4; i += NT) { const f32x4 v = *(const f32x4*)(s + (size_t)i * 4); u32x2 o; o.x = cvt_pk(v[0], v[1]); o.y = cvt_pk(v[2], v[3]); *(u32x2*)(d + (size_t)i * 4) = o; } }
    { const int gt = F.blk * 512 + F.tid;
      if (gt < 1536) {
          const int sel = gt >= 512, idx = sel ? gt - 512 : gt, Q = sel ? 16 : 8, pos = idx / Q, i = idx - pos * Q;
          const float inv = sel ? a.inv64[i] : a.inv32[i];
          const float af = (float)pos * inv;
          double x = (double)af; const double twopi = 6.283185307179586476925287;
          x -= twopi * rint(x / twopi);
          const double x2 = x * x;
          double sn = 1.0, cs = 1.0;
#pragma unroll
          for (int k = 13; k >= 1; --k) { sn = 1.0 - sn * x2 / (double)((2 * k) * (2 * k + 1)); cs = 1.0 - cs * x2 / (double)((2 * k - 1) * (2 * k)); }
          sn *= x;
          f32x2* T = (f32x2*)(F.ws + WS_ROPE);
          T[gt] = (f32x2){(float)cs, (float)sn};
      } }
    __syncthreads();
    if (F.blk < 192) {
        LAS float* s = (LAS float*)F.lds;
        LAS float* red = s + 17 * 1024;
        for (int idx = F.tid; idx < 17 * 1024; idx += 512) { const int i = idx >> 10, k = idx & 1023; const float c = (i < 16) ? F.in[I_C][i * 1024 + k] : F.in[I_CCTX][k]; s[idx] = siluf_(c); }
        __syncthreads();
        float* mod = (float*)(F.ws + WS_MOD);
        for (int item = F.blk; item < 192; item += GRID) {
            const int l = item / 96, j0 = (item - l * 96) * 64, jj = F.tid & 63, kp = F.tid >> 6;
            float acc[17];
#pragma unroll
            for (int i = 0; i < 17; ++i) acc[i] = 0.f;
            const float* w = F.in[I_WMOD] + (size_t)l * 1024 * 6144 + (size_t)(kp * 128) * 6144 + j0 + jj;
            const LAS float* sk = s + kp * 128;
#pragma unroll 2
            for (int k = 0; k < 128; k += 4) {
                const float w0 = w[(size_t)k * 6144], w1 = w[(size_t)(k + 1) * 6144], w2 = w[(size_t)(k + 2) * 6144], w3 = w[(size_t)(k + 3) * 6144];
#pragma unroll
                for (int i = 0; i < 17; ++i) { const f32x4 sv = *(const LAS f32x4*)(sk + i * 1024 + k); acc[i] += (sv[0] * w0 + sv[1] * w1) + (sv[2] * w2 + sv[3] * w3); } }
#pragma unroll
            for (int i = 0; i < 17; ++i) red[(kp * 17 + i) * 64 + jj] = acc[i];
            __syncthreads();
            for (int idx = F.tid; idx < 17 * 64; idx += 512) { const int i = idx >> 6, j = idx & 63;
                float t = F.in[I_BMOD][l * 6144 + j0 + j];
#pragma unroll
                for (int p8 = 0; p8 < 8; ++p8) t += red[(p8 * 17 + i) * 64 + j];
                mod[(size_t)(l * 17 + i) * 6144 + j0 + j] = t; }
            __syncthreads();
        }
    }
}
template <int MODE>
__device__ __forceinline__ void p_rowpass(const Frame& F, int l) {
    const int gw = F.blk * 8 + F.wave, NGW = GRID * 8;
    const unsigned char* ybuf = F.ar + A_YBUF; const unsigned* seli = (const unsigned*)(F.ws + WS_SELI);
    bf16_t* H = (bf16_t*)(F.ar + A_H); unsigned char* H8 = F.ar + A_H8;
    bf16_t* XB = (bf16_t*)(F.ws + WS_XB);
    constexpr int NQ = 2;
    const int lc = F.lane * 8;
    static_assert(NR % (GRID * 8 * NQ) == 0, "rows per wave");
    constexpr int RPW = NR / (GRID * 8);
    const int Rw0 = gw * RPW;
    int mcur = -1; f32x4 A1[4], B1[4], G2[4];
    u32x4 slv[NQ];
    if (MODE >= 1) {
#pragma unroll
        for (int q = 0; q < NQ; ++q) slv[q] = *(const u32x4*)(seli + (size_t)(Rw0 + q) * 4);
    }
    for (int R0 = Rw0; R0 < Rw0 + RPW; R0 += NQ) {
        f32x4 v[NQ][4]; u32x4 xw[NQ][2]; u32x2 yv[NQ][2][4]; int mir[NQ]; bool act[NQ];
        u32x4 sln[NQ];
        if (MODE >= 1) { const int Rn = (R0 + NQ < Rw0 + RPW) ? R0 + NQ : R0;
#pragma unroll
            for (int q = 0; q < NQ; ++q) sln[q] = *(const u32x4*)(seli + (size_t)(Rn + q) * 4); }
#pragma unroll
        for (int q = 0; q < NQ; ++q) {
            const int R = R0 + q;
            const int b = R / TPB, p = R - b * TPB; const bool isctx = p < CTXL; mir[q] = isctx ? 16 : b;
            act[q] = !(MODE == 2 && isctx);
            if (MODE == 0) {
                const float* xin = isctx ? F.in[I_CTX] + ((size_t)b * 256 + p) * 1024 : F.in[I_X] + ((size_t)b * 4096 + (p - 256)) * 1024;
#pragma unroll
                for (int c = 0; c < 2; ++c) { v[q][2 * c] = *(const f32x4*)(xin + lc + 512 * c); v[q][2 * c + 1] = *(const f32x4*)(xin + lc + 512 * c + 4); }
            } else if (act[q]) {
#pragma unroll
                for (int c = 0; c < 2; ++c) xw[q][c] = *(const u32x4*)(XB + (size_t)R * 1024 + lc + 512 * c);
                const u32x4 sl = slv[q];
#pragma unroll
                for (int c = 0; c < 2; ++c) {
                    yv[q][c][0] = *(const u32x2*)(ybuf + (size_t)sl.x * 1024 + lc + 512 * c); yv[q][c][1] = *(const u32x2*)(ybuf + (size_t)sl.y * 1024 + lc + 512 * c);
                    yv[q][c][2] = *(const u32x2*)(ybuf + (size_t)sl.z * 1024 + lc + 512 * c); yv[q][c][3] = *(const u32x2*)(ybuf + (size_t)sl.w * 1024 + lc + 512 * c); }
            }
        }
#pragma unroll
        for (int q = 0; q < NQ; ++q) {
            if (!act[q]) continue;
            const int R = R0 + q;
            if (mir[q] != mcur) {
                mcur = mir[q];
                if (MODE >= 1) { const float* g2 = modv(F, l - 1, mcur, 5);
#pragma unroll
                    for (int c = 0; c < 2; ++c) { G2[2 * c] = *(const f32x4*)(g2 + lc + 512 * c) * (1.f / YSCL); G2[2 * c + 1] = *(const f32x4*)(g2 + lc + 512 * c + 4) * (1.f / YSCL); } }
                if (MODE <= 1) { const float* gn = F.in[I_N1G] + l * 1024; const float* sh = modv(F, l, mcur, 0); const float* sc = modv(F, l, mcur, 1);
#pragma unroll
                    for (int c = 0; c < 2; ++c) { const int cc = lc + 512 * c;
                        A1[2 * c] = *(const f32x4*)(gn + cc) * (*(const f32x4*)(sc + cc) + 1.f); A1[2 * c + 1] = *(const f32x4*)(gn + cc + 4) * (*(const f32x4*)(sc + cc + 4) + 1.f);
                        B1[2 * c] = *(const f32x4*)(sh + cc); B1[2 * c + 1] = *(const f32x4*)(sh + cc + 4); } }
            }
            if (MODE >= 1) {
#pragma unroll
                for (int c = 0; c < 2; ++c) {
                    f32x4 s0 = (f32x4){0.f, 0.f, 0.f, 0.f}, s1 = s0;
#pragma unroll
                    for (int k = 0; k < 4; ++k) { f32x4 a0, a1; unpack8f8(yv[q][c][k], a0, a1); s0 += a0; s1 += a1; }
                    f32x4 x0, x1; unpack8(xw[q][c], x0, x1);
                    v[q][2 * c] = x0 + G2[2 * c] * s0; v[q][2 * c + 1] = x1 + G2[2 * c + 1] * s1;
                    if (MODE == 1) *(u32x4*)(XB + (size_t)R * 1024 + lc + 512 * c) = pack8(v[q][2 * c], v[q][2 * c + 1]);
                    else { const int b = R / TPB, p = R - b * TPB; float* xo = F.out + ((size_t)b * 4096 + (p - 256)) * 1024 + lc + 512 * c;
                        *(f32x4*)xo = v[q][2 * c]; *(f32x4*)(xo + 4) = v[q][2 * c + 1]; }
                }
            }
            if (MODE <= 1) {
                float ss = 0.f;
#pragma unroll
                for (int j = 0; j < 4; ++j) ss += (v[q][j][0] * v[q][j][0] + v[q][j][1] * v[q][j][1]) + (v[q][j][2] * v[q][j][2] + v[q][j][3] * v[q][j][3]);
                const float rstd = rsqrtf(wave_sum(ss) * (1.f / 1024.f) + EPS);
#pragma unroll
                for (int c = 0; c < 2; ++c) { const int cc = lc + 512 * c;
                    const f32x4 h0 = (v[q][2 * c] * rstd) * A1[2 * c] + B1[2 * c];
                    const f32x4 h1 = (v[q][2 * c + 1] * rstd) * A1[2 * c + 1] + B1[2 * c + 1];
                    *(u32x4*)(H + (size_t)R * 1024 + cc) = pack8(h0, h1);
                    int w0 = 0, w1 = 0; w0 = __builtin_amdgcn_cvt_pk_fp8_f32(h0[0], h0[1], w0, false); w0 = __builtin_amdgcn_cvt_pk_fp8_f32(h0[2], h0[3], w0, true);
                    w1 = __builtin_amdgcn_cvt_pk_fp8_f32(h1[0], h1[1], w1, false); w1 = __builtin_amdgcn_cvt_pk_fp8_f32(h1[2], h1[3], w1, true);
                    *(u32x2*)(H8 + (size_t)R * 1024 + cc) = (u32x2){(unsigned)w0, (unsigned)w1}; }
            }
        }
        if (MODE >= 1) {
#pragma unroll
            for (int q = 0; q < NQ; ++q) slv[q] = sln[q]; }
    }
}

template <int HD>
__device__ __forceinline__ void qk_norm_rope(bf16_t* p, const float* gain, float post, int pos, const f32x2* rt, bf16_t* po = nullptr) {
    if (!po) po = p;
    float x[HD];
#pragma unroll
    for (int i = 0; i < HD / 8; ++i) { const u32x4 w = *(const u32x4*)(p + 8 * i); x[8 * i] = bf_lo(w.x); x[8 * i + 1] = bf_hi(w.x); x[8 * i + 2] = bf_lo(w.y); x[8 * i + 3] = bf_hi(w.y);
        x[8 * i + 4] = bf_lo(w.z); x[8 * i + 5] = bf_hi(w.z); x[8 * i + 6] = bf_lo(w.w); x[8 * i + 7] = bf_hi(w.w); }
    float ss = 0.f;
#pragma unroll
    for (int i = 0; i < HD; ++i) ss += x[i] * x[i];
    const float r = rsqrtf(ss * (1.f / HD) + EPS);
#pragma unroll
    for (int i = 0; i < HD; ++i) x[i] = x[i] * r * gain[i];
    if (pos >= 0) {
        constexpr int Q = HD / 4; const int row = pos >> 6, col = pos & 63;
#pragma unroll
        for (int i = 0; i < Q; ++i) {
            const f32x2 cr = rt[row * Q + i], cc = rt[col * Q + i];
            const float a = x[i], b = x[i + Q]; x[i] = a * cr[0] - b * cr[1]; x[i + Q] = b * cr[0] + a * cr[1];
            const float c = x[2 * Q + i], d = x[3 * Q + i]; x[2 * Q + i] = c * cc[0] - d * cc[1]; x[3 * Q + i] = d * cc[0] + c * cc[1];
        }
    }
#pragma unroll
    for (int i = 0; i < HD / 8; ++i) { u32x4 w; w.x = cvt_pk(x[8 * i] * post, x[8 * i + 1] * post); w.y = cvt_pk(x[8 * i + 2] * post, x[8 * i + 3] * post);
        w.z = cvt_pk(x[8 * i + 4] * post, x[8 * i + 5] * post); w.w = cvt_pk(x[8 * i + 6] * post, x[8 * i + 7] * post); *(u32x4*)(po + 8 * i) = w; }
}

template <bool gdn_only = false, bool dry = false>
__device__ __forceinline__ void p_prep(const Frame& F, int l) {
    bf16_t* dummy = (bf16_t*)(F.ar + A_CH);
    const int gt = F.blk * 512 + F.tid, NT = GRID * 512;
    const f32x2* rope = (const f32x2*)(F.ws + WS_ROPE);
    if (!gdn_only) for (int idx = gt; idx < NR * 8; idx += NT) {
        const int R = idx >> 3, grp = idx & 7, p = R % TPB; const int pos = (p < CTXL) ? -1 : p - CTXL;
        qk_norm_rope<32>(ptile(F, T_AK) + (size_t)R * 256 + grp * 32, F.in[I_DAKG] + l * 32, 1.f, pos, rope, dry ? dummy + (size_t)R * 256 + grp * 32 : nullptr);
    }
    if (!gdn_only) for (int idx = gt; idx < NR * 2; idx += NT) {
        const int R = idx >> 1, grp = idx & 1, p = R % TPB; const int pos = (p < CTXL) ? -1 : p - CTXL;
        qk_norm_rope<64>(ptile(F, T_GKV) + (size_t)R * 256 + grp * 64, F.in[I_GAKG] + l * 64, 1.f, pos, rope + 512, dry ? dummy + (size_t)R * 256 + grp * 64 : nullptr);
    }
    if (dry) return;
    const int gw = F.blk * 8 + F.wave, NGW = GRID * 8;
    bf16_t* Gq = (bf16_t*)(F.ar + A_H); bf16_t* Gk = Gq + (size_t)NR * 256; bf16_t* Gv = Gk + (size_t)NR * 256;
    float* GB = (float*)(F.ws + WS_GB);
    const float* cw = F.in[I_CONVW] + (size_t)l * 5 * 768;
    const int c = F.lane * 4;
    f32x4 cwv[5][3];
#pragma unroll
    for (int j = 0; j < 5; ++j)
#pragma unroll
        for (int part = 0; part < 3; ++part) cwv[j][part] = *(const f32x4*)(cw + j * 768 + part * 256 + c);
    const f32x4 vg = *(const f32x4*)(F.in[I_GMVG] + l * 256 + c);
    for (int G4 = gw; G4 < NR / 4; G4 += NGW) {
        const int R0 = G4 * 4, p0 = R0 % TPB, Rb = R0 - p0;
        const int lo = (p0 < CTXL) ? 0 : CTXL, hi = (p0 < CTXL) ? CTXL : TPB;
        u32x2 win[8][3];
#pragma unroll
        for (int w = 0; w < 8; ++w) { const int pp = p0 - 2 + w; const int pc = pp < lo ? lo : (pp >= hi ? hi - 1 : pp);
#pragma unroll
            for (int part = 0; part < 3; ++part) win[w][part] = *(const u32x2*)(ptile(F, T_DQ + part) + (size_t)(Rb + pc) * 256 + c); }
        u32x2 vw[4];
        if (!gdn_only) {
#pragma unroll
            for (int r = 0; r < 4; ++r) vw[r] = *(const u32x2*)(ptile(F, T_MV) + (size_t)(R0 + r) * 256 + c);
        }
        float ab; { const int rr = F.lane >> 4, cc = F.lane & 15; ab = bf2f(ptile(F, T_DAB)[(size_t)(R0 + rr) * 256 + cc]); }
#pragma unroll
        for (int w = 0; w < 8; ++w) { const int pp = p0 - 2 + w; if (pp < lo || pp >= hi) {
#pragma unroll
            for (int part = 0; part < 3; ++part) win[w][part] = (u32x2){0u, 0u}; } }
        if (!gdn_only) {
#pragma unroll
            for (int r = 0; r < 4; ++r) {
                const float v0 = gelu_erf(bf_lo(vw[r].x)), v1 = gelu_erf(bf_hi(vw[r].x)), v2 = gelu_erf(bf_lo(vw[r].y)), v3 = gelu_erf(bf_hi(vw[r].y));
                const float rs = rsqrtf(wave_sum((v0 * v0 + v1 * v1) + (v2 * v2 + v3 * v3)) * (1.f / 256.f) + EPS);
                u32x2 o; o.x = cvt_pk(v0 * rs * vg[0], v1 * rs * vg[1]); o.y = cvt_pk(v2 * rs * vg[2], v3 * rs * vg[3]); *(u32x2*)(ptile(F, T_MV) + (size_t)(R0 + r) * 256 + c) = o;
            }
        }
#pragma unroll
        for (int r = 0; r < 4; ++r) {
            float y[3][4];
#pragma unroll
            for (int part = 0; part < 3; ++part) {
                f32x4 a = (f32x4){0.f, 0.f, 0.f, 0.f};
#pragma unroll
                for (int j = 0; j < 5; ++j) { const u32x2 w = win[r + j][part]; a += (f32x4){bf_lo(w.x), bf_hi(w.x), bf_lo(w.y), bf_hi(w.y)} * cwv[j][part]; }
#pragma unroll
                for (int i = 0; i < 4; ++i) y[part][i] = siluf_(a[i]);
            }
            float sq = (y[0][0] * y[0][0] + y[0][1] * y[0][1]) + (y[0][2] * y[0][2] + y[0][3] * y[0][3]);
            float sk = (y[1][0] * y[1][0] + y[1][1] * y[1][1]) + (y[1][2] * y[1][2] + y[1][3] * y[1][3]);
            sq = sum16(sq); sk = sum16(sk);
            const float rq = rsqrtf(sq + EPS) * 0.125f, rk = rsqrtf(sk + EPS);
            const size_t off = (size_t)(R0 + r) * 256 + c;
            u32x2 o; o.x = cvt_pk(y[0][0] * rq, y[0][1] * rq); o.y = cvt_pk(y[0][2] * rq, y[0][3] * rq); *(u32x2*)(Gq + off) = o;
            o.x = cvt_pk(y[1][0] * rk, y[1][1] * rk); o.y = cvt_pk(y[1][2] * rk, y[1][3] * rk); *(u32x2*)(Gk + off) = o;
            o.x = cvt_pk(y[2][0], y[2][1]); o.y = cvt_pk(y[2][2], y[2][3]); *(u32x2*)(Gv + off) = o;
        }
        {
            const int rr = F.lane >> 4, cc = F.lane & 15;
            float r;
            if (cc < 8) { const float xx = ab + F.in[I_DTB][l * 8 + cc]; const float ex = __expf(fminf(xx, 20.f)); const float sp = (xx > 20.f) ? xx : ((xx < -4.f) ? ex * (1.f - ex * (0.5f - ex * (1.f / 3.f))) : __logf(1.f + ex)); r = -__expf(F.in[I_ALOG][l * 8 + cc]) * sp; }
            else r = sigmoidf_(ab);
            GB[(size_t)(R0 + rr) * 16 + cc] = r;
        }
    }
}
__device__ __forceinline__ s16x4 tr_read(const LAS unsigned char* p) { return __builtin_bit_cast(s16x4, __builtin_amdgcn_ds_read_tr16_b64_v4i16((LAS v4i16_t*)p)); }
__device__ __forceinline__ bf16x8 cat8(const s16x4 lo, const s16x4 hi) { return (bf16x8){lo[0], lo[1], lo[2], lo[3], hi[0], hi[1], hi[2], hi[3]}; }
#define MFMA32(a, b, c) __builtin_amdgcn_mfma_f32_32x32x16_bf16((a), (b), (c), 0, 0, 0)
#define MFMA16(a, b, c) __builtin_amdgcn_mfma_f32_16x16x32_bf16((a), (b), (c), 0, 0, 0)
constexpr int KP = 144, VP = 192;
constexpr int ATT_KT = 64;
constexpr int ATT_K_OFF = 0, ATT_V_OFF = ATT_KT * KP;

template <int HD>
__device__ __forceinline__ void q_prep(bf16x8 (&qf)[HD / 16], const bf16_t* qrow, const float* gain, float post, int pos, const f32x2* rt, int h2) {
    constexpr int NKS = HD / 16, Q = HD / 4;
    float x[NKS][8];
#pragma unroll
    for (int ks = 0; ks < NKS; ++ks) { const u32x4 w = *(const u32x4*)(qrow + 16 * ks + 8 * h2);
        x[ks][0] = bf_lo(w.x); x[ks][1] = bf_hi(w.x); x[ks][2] = bf_lo(w.y); x[ks][3] = bf_hi(w.y); x[ks][4] = bf_lo(w.z); x[ks][5] = bf_hi(w.z); x[ks][6] = bf_lo(w.w); x[ks][7] = bf_hi(w.w); }
    float ss = 0.f;
#pragma unroll
    for (int ks = 0; ks < NKS; ++ks)
#pragma unroll
        for (int j = 0; j < 8; ++j) ss += x[ks][j] * x[ks][j];
    const float rr = rsqrtf(add_xor32(ss) * (1.f / HD) + EPS);
#pragma unroll
    for (int ks = 0; ks < NKS; ++ks) { const f32x4 g0 = *(const f32x4*)(gain + 16 * ks + 8 * h2), g1 = *(const f32x4*)(gain + 16 * ks + 8 * h2 + 4);
#pragma unroll
        for (int j = 0; j < 4; ++j) { x[ks][j] *= rr * g0[j]; x[ks][4 + j] *= rr * g1[j]; } }
    if (pos >= 0) {
        const int row = pos >> 6, col = pos & 63;
        if (HD == 64) {
#pragma unroll
            for (int j = 0; j < 8; ++j) {
                const f32x2 cr = rt[row * Q + 8 * h2 + j], cc = rt[col * Q + 8 * h2 + j];
                const float a = x[0][j], b = x[1][j]; x[0][j] = a * cr[0] - b * cr[1]; x[1][j] = b * cr[0] + a * cr[1];
                const float c = x[NKS - 2][j], d = x[NKS - 1][j]; x[NKS - 2][j] = c * cc[0] - d * cc[1]; x[NKS - 1][j] = d * cc[0] + c * cc[1];
            }
        } else {
#pragma unroll
            for (int j = 0; j < 8; ++j) {
                const f32x2 cr = rt[row * Q + j], cc = rt[col * Q + j];
                const auto s0 = __builtin_amdgcn_permlane32_swap(__float_as_uint(x[0][j]), __float_as_uint(x[0][j]), false, false);
                const auto s1 = __builtin_amdgcn_permlane32_swap(__float_as_uint(x[1][j]), __float_as_uint(x[1][j]), false, false);
                const float pa = __uint_as_float(h2 ? s0[0] : s0[1]), pc = __uint_as_float(h2 ? s1[0] : s1[1]);
                x[0][j] = h2 ? (x[0][j] * cr[0] + pa * cr[1]) : (x[0][j] * cr[0] - pa * cr[1]);
                x[1][j] = h2 ? (x[1][j] * cc[0] + pc * cc[1]) : (x[1][j] * cc[0] - pc * cc[1]);
            }
        }
    }
#pragma unroll
    for (int ks = 0; ks < NKS; ++ks) { u32x4 w; w.x = cvt_pk(x[ks][0] * post, x[ks][1] * post); w.y = cvt_pk(x[ks][2] * post, x[ks][3] * post); w.z = cvt_pk(x[ks][4] * post, x[ks][5] * post); w.w = cvt_pk(x[ks][6] * post, x[ks][7] * post);
        qf[ks] = __builtin_bit_cast(bf16x8, w); }
}

template <int HD, int NMAP, bool DIFF>
__device__ __forceinline__ void attn_unit(const Frame& F, const bf16_t* Qb, int qcol, const bf16_t* Kb, int kcol, const bf16_t* Vb, int vcol, bf16_t* Ob, int ocol,
                                          int b, int qt, float lam, float fin_scale, const float* subg, const float* qgain, float qpost, const f32x2* qrt) {
    const int lane = F.lane, r = lane & 31, h2 = lane >> 5, x = lane & 15, g1 = (lane >> 4) & 1;
    const size_t R0 = (size_t)b * TPB + (size_t)qt * 256 + F.wave * 32;
    const int nkt = (qt == 0) ? 256 / ATT_KT : 4352 / ATT_KT;
    constexpr int NKS = HD / 16;
    constexpr int NST = ATT_KT / 64;
    const int skey = F.tid >> 3, sseg = F.tid & 7;
    const bf16_t* kg = Kb + ((size_t)b * TPB + skey) * 256 + kcol + sseg * 8;
    const bf16_t* vg = Vb + ((size_t)b * TPB + skey) * 256 + vcol + sseg * 8;
    u32x4 kreg[NST], vreg[NST];
#pragma unroll
    for (int i = 0; i < NST; ++i) { kreg[i] = *(const u32x4*)(kg + (size_t)(64 * i) * 256); vreg[i] = *(const u32x4*)(vg + (size_t)(64 * i) * 256); }
    bf16x8 qf[NMAP][NKS];
    { const int qpos = (qt == 0) ? -1 : (qt - 1) * 256 + F.wave * 32 + r;
#pragma unroll
      for (int m = 0; m < NMAP; ++m) q_prep<HD>(qf[m], Qb + (R0 + r) * 256 + qcol + m * HD, qgain, qpost, qpos, qrt, h2); }
    f32x16 O[NMAP][2]; f32x4 lacc[NMAP];
    bf16x8 onesA; { const int mrow = lane & 15, kg = lane >> 4; const unsigned o = ((mrow == 0 && (kg & 1) == 0) || (mrow == 1 && (kg & 1) == 1)) ? 0x3f803f80u : 0u; onesA = __builtin_bit_cast(bf16x8, (u32x4){o, o, o, o}); }
#pragma unroll
    for (int m = 0; m < NMAP; ++m) { lacc[m] = (f32x4){0.f, 0.f, 0.f, 0.f};
#pragma unroll
        for (int d = 0; d < 2; ++d)
#pragma unroll
            for (int i = 0; i < 16; ++i) O[m][d][i] = 0.f; }
    constexpr int ATT_BUF = ATT_KT * KP + ATT_KT * VP;
    __syncthreads();
#pragma unroll
    for (int i = 0; i < NST; ++i) { *(LAS u32x4*)(F.lds + ATT_K_OFF + (skey + 64 * i) * KP + sseg * 16) = kreg[i]; *(LAS u32x4*)(F.lds + ATT_V_OFF + (skey + 64 * i) * VP + sseg * 16) = vreg[i]; }
    __syncthreads();
    if (F.wave >= 4) __builtin_amdgcn_s_setprio(1);
    for (int kt = 0; kt < nkt; ++kt) {
        LAS unsigned char* Ks = F.lds + (kt & 1) * ATT_BUF + ATT_K_OFF; LAS unsigned char* Vs = F.lds + (kt & 1) * ATT_BUF + ATT_V_OFF;
        if (kt + 1 < nkt) {
#pragma unroll
            for (int i = 0; i < NST; ++i) { kreg[i] = *(const u32x4*)(kg + (size_t)((kt + 1) * ATT_KT + 64 * i) * 256); vreg[i] = *(const u32x4*)(vg + (size_t)((kt + 1) * ATT_KT + 64 * i) * 256); } }
#pragma unroll
        for (int grp = 0; grp < ATT_KT / 32; ++grp) {
            f32x16 S[2];
            constexpr int NKF = (NMAP == 2 && !DIFF) ? 1 : 2;
            bf16x8 kfr[NKF][NKS];
#pragma unroll
            for (int t = 0; t < NKF; ++t) {
                const int kb = (NMAP == 2) ? grp : t, m = (NMAP == 2) ? t : 0;
#pragma unroll
                for (int ks = 0; ks < NKS; ++ks) kfr[t][ks] = *(const LAS bf16x8*)(Ks + (kb * 32 + r) * KP + ((DIFF ? m * HD : 0) + 16 * ks + 8 * h2) * 2);
            }
#pragma unroll
            for (int t = 0; t < NKF; ++t)
#pragma unroll
                for (int ks = 0; ks < NKS; ++ks) { asm volatile("" : "+v"(kfr[t][ks])); }
#pragma unroll
            for (int t = 0; t < 2; ++t) {
                const int m = (NMAP == 2) ? t : 0;
                const f32x16 half16 = {0.5f, 0.5f, 0.5f, 0.5f, 0.5f, 0.5f, 0.5f, 0.5f, 0.5f, 0.5f, 0.5f, 0.5f, 0.5f, 0.5f, 0.5f, 0.5f};
                S[t] = MFMA32(kfr[t % NKF][0], qf[m][0], half16);
#pragma unroll
                for (int ks = 1; ks < NKS; ++ks) S[t] = MFMA32(kfr[t % NKF][ks], qf[m][ks], S[t]);
            }
            bf16x8 vf[(NMAP == 2) ? 1 : 2][2][2];
#pragma unroll
            for (int t = 0; t < ((NMAP == 2) ? 1 : 2); ++t) {
                const int kb = (NMAP == 2) ? grp : t;
#pragma unroll
                for (int d = 0; d < 2; ++d)
#pragma unroll
                    for (int s2 = 0; s2 < 2; ++s2) {
                        const LAS unsigned char* vp = Vs + (kb * 32 + 16 * s2 + 4 * h2 + (x >> 2)) * VP + (32 * d + 16 * g1 + 4 * (x & 3)) * 2;
                        vf[t][d][s2] = cat8(tr_read(vp), tr_read(vp + 8 * VP));
                    }
            }
#pragma unroll
            for (int t = 0; t < 2; ++t) {
                const int m = (NMAP == 2) ? t : 0, vt = (NMAP == 2) ? 0 : t;
                bf16x8 pb[2];
#pragma unroll
                for (int s2 = 0; s2 < 2; ++s2) {
                    unsigned w[4];
#pragma unroll
                    for (int j = 0; j < 4; ++j) w[j] = __builtin_bit_cast(unsigned, __builtin_amdgcn_cvt_pknorm_i16(S[t][8 * s2 + 2 * j], S[t][8 * s2 + 2 * j + 1]));
                    pb[s2] = __builtin_bit_cast(bf16x8, (u32x4){w[0], w[1], w[2], w[3]});
                    lacc[m] = MFMA16(onesA, pb[s2], lacc[m]);
                }
#pragma unroll
                for (int d = 0; d < 2; ++d)
#pragma unroll
                    for (int s2 = 0; s2 < 2; ++s2) O[m][d] = MFMA32(vf[vt][d][s2], pb[s2], O[m][d]);
            }
        }
        if (kt + 1 < nkt) { LAS unsigned char* nb = F.lds + ((kt + 1) & 1) * ATT_BUF;
#pragma unroll
            for (int i = 0; i < NST; ++i) { *(LAS u32x4*)(nb + ATT_K_OFF + (skey + 64 * i) * KP + sseg * 16) = kreg[i]; *(LAS u32x4*)(nb + ATT_V_OFF + (skey + 64 * i) * VP + sseg * 16) = vreg[i]; } }
        __syncthreads();
    }
    __builtin_amdgcn_s_setprio(0);
    float inv[NMAP];
#pragma unroll
    for (int m = 0; m < NMAP; ++m) {
        const float s0 = __int_as_float(__builtin_amdgcn_ds_bpermute((lane & 15) << 2, __float_as_int(lacc[m][0]))), s1 = __int_as_float(__builtin_amdgcn_ds_bpermute((lane & 15) << 2, __float_as_int(lacc[m][1])));
        inv[m] = 1.f / ((r < 16) ? s0 : s1); }
    bf16_t* op = Ob + (R0 + r) * 256 + ocol;
    if (DIFF) {
        float ss = 0.f;
#pragma unroll
        for (int d = 0; d < 2; ++d)
#pragma unroll
            for (int i = 0; i < 16; ++i) { const float v = O[0][d][i] * inv[0] - lam * (O[NMAP - 1][d][i] * inv[NMAP - 1]); O[0][d][i] = v; ss += v * v; }
        ss = add_xor32(ss);
        const float rr = rsqrtf(ss * (1.f / 64.f) + EPS) * fin_scale;
#pragma unroll
        for (int d = 0; d < 2; ++d)
#pragma unroll
            for (int g4 = 0; g4 < 4; ++g4) { const int dv0 = 32 * d + 8 * g4 + 4 * h2; const f32x4 sg = *(const f32x4*)(subg + dv0);
                u32x2 o; o.x = cvt_pk(O[0][d][4 * g4] * rr * sg[0], O[0][d][4 * g4 + 1] * rr * sg[1]); o.y = cvt_pk(O[0][d][4 * g4 + 2] * rr * sg[2], O[0][d][4 * g4 + 3] * rr * sg[3]);
                *(u32x2*)(op + dv0) = o; }
    } else {
#pragma unroll
        for (int m = 0; m < NMAP; ++m)
#pragma unroll
            for (int d = 0; d < 2; ++d)
#pragma unroll
                for (int g4 = 0; g4 < 4; ++g4) { const int dv0 = 32 * d + 8 * g4 + 4 * h2;
                    u32x2 o; o.x = cvt_pk(O[m][d][4 * g4] * inv[m], O[m][d][4 * g4 + 1] * inv[m]); o.y = cvt_pk(O[m][d][4 * g4 + 2] * inv[m], O[m][d][4 * g4 + 3] * inv[m]);
                    *(u32x2*)(op + m * HD + dv0) = o; }
    }
}

__device__ __forceinline__ void gmlp_unit(const Frame& F, int l, int b, int chunk, int g, bf16_t* dry = nullptr) {
    const int lane = F.lane, r = lane & 31, h2 = lane >> 5, x = lane & 15, g1 = (lane >> 4) & 1;
    const size_t R0 = (size_t)b * TPB + (size_t)chunk * 128;
    LAS unsigned char* Vs = F.lds;
    const bf16_t* vsrc = ptile(F, T_MV) + R0 * 256 + g * 64;
    __syncthreads();
#pragma unroll
    for (int i = 0; i < 2; ++i) { const int pc = F.tid + i * 512, q = pc >> 3, seg = pc & 7; *(LAS u32x4*)(Vs + q * VP + seg * 16) = *(const u32x4*)(vsrc + (size_t)q * 256 + seg * 8); }
    __syncthreads();
    const int cb = F.wave & 1, pb = F.wave >> 1;
    const bf16_t* ws = (const bf16_t*)(F.ws + WS_GMWS) + ((size_t)(l * 4 + g) * 128 + pb * 32 + r) * 128 + 8 * h2;
    f32x16 acc;
#pragma unroll
    for (int i = 0; i < 16; ++i) acc[i] = 0.f;
#pragma unroll
    for (int ks = 0; ks < 8; ++ks) {
        const LAS unsigned char* vp = Vs + (16 * ks + 8 * h2 + (x >> 2)) * VP + (32 * cb + 16 * g1 + 4 * (x & 3)) * 2;
        const bf16x8 af = cat8(tr_read(vp), tr_read(vp + 4 * VP));
        const bf16x8 bfr = *(const bf16x8*)(ws + 16 * ks);
        acc = MFMA32(af, bfr, acc);
    }
    const int pp = pb * 32 + r; const float bs = F.in[I_GMBS][(l * 4 + g) * 128 + pp];
    bf16_t* up = ptile(F, T_MU) + (R0 + pp) * 256 + g * 64 + cb * 32;
#pragma unroll
    for (int g4 = 0; g4 < 4; ++g4) { const int c0 = 8 * g4 + 4 * h2; const u32x2 uw = *(const u32x2*)(up + c0);
        u32x2 o; o.x = cvt_pk(gelu_erf(bf_lo(uw.x)) * (acc[4 * g4] + bs), gelu_erf(bf_hi(uw.x)) * (acc[4 * g4 + 1] + bs)); o.y = cvt_pk(gelu_erf(bf_lo(uw.y)) * (acc[4 * g4 + 2] + bs), gelu_erf(bf_hi(uw.y)) * (acc[4 * g4 + 3] + bs));
        *(u32x2*)((dry ? dry + (R0 + pp) * 256 + g * 64 + cb * 32 : up) + c0) = o; }
}
__device__ __forceinline__ int chunk_p(int dir, int n, int i) { const int f = 64 * n + i; return dir == 0 ? f : (n < 4 ? 255 - f : 4351 + 256 - f); }
__device__ __forceinline__ int crow16(int i, int h2) { return (i & 3) + 8 * (i >> 2) + 4 * h2; }
__device__ __forceinline__ int img_idx(int row, int k) { const int kk = k & 31; return (((row >> 4) * 2 + (k >> 5)) * 64 + ((kk >> 2) & 3) * 16 + (row & 15)) * 8 + 4 * (kk >> 4) + (kk & 3); }
constexpr int CH_NW = 0, CH_QD = 8192, CH_QK = 16384, CH_KDT = 24576, CH_U = 32768;

constexpr int CHS_BYTES = 33792;
__device__ __forceinline__ void gdn_chunk_phase(const Frame& F) {
    const int slot = F.wave >> 1, ws2 = F.wave & 1;
    LAS float* Am = (LAS float*)(F.lds + slot * CHS_BYTES); LAS float* gcv = Am + 4096; LAS float* btv = gcv + 64; LAS float* egv = btv + 64; LAS float* dkv = egv + 64;
    LAS bf16_t* kvt = (LAS bf16_t*)(F.lds + slot * CHS_BYTES + 17408);
    const bf16_t* Gq = (const bf16_t*)(F.ar + A_H); const bf16_t* Gk = Gq + (size_t)NR * 256; const bf16_t* Gv = Gk + (size_t)NR * 256;
    const float* GB = (const float*)(F.ws + WS_GB);
    float* CHG = (float*)(F.ws + WS_CHG);
    for (int it0 = F.blk * 4; it0 < 8704; it0 += GRID * 4) {
        int tq = F.tid; asm volatile("" : "+v"(tq));
        const int t2 = tq & 127, lane = tq & 63, r = lane & 31, h2 = lane >> 5;
        const int idx = it0 + slot, dir = idx & 1, rest = idx >> 1, m = rest % 68, h = (rest / 68) & 3, b = rest / 272;
        const int n = dir ? ((m < 4) ? 3 - m : 71 - m) : m; const int item = dir * 4352 + b * 272 + h * 68 + n;
        unsigned char* chp = F.ar + A_CH + (size_t)item * CH_ITEM;
        const size_t Rb = (size_t)b * TPB;
        __syncthreads();
        u32x4 stg[8];
#pragma unroll
        for (int j = 0; j < 8; ++j) { const int pc = t2 + 128 * j, i = pc >> 4, seg = pc & 15;
            stg[j] = *(const u32x4*)(((seg < 8) ? Gk : Gv) + (Rb + chunk_p(dir, n, i)) * 256 + 64 * h + (seg & 7) * 8); }
        bf16x8 qfr[2][4];
#pragma unroll
        for (int tI = 0; tI < 2; ++tI)
#pragma unroll
            for (int ks = 0; ks < 4; ++ks) qfr[tI][ks] = *(const bf16x8*)(Gq + (Rb + chunk_p(dir, n, 32 * tI + r)) * 256 + 64 * h + 8 * h2 + 16 * ks);
#pragma unroll
        for (int j = 0; j < 8; ++j) { const int pc = t2 + 128 * j, i = pc >> 4, seg = pc & 15; *(LAS u32x4*)(kvt + i * 128 + seg * 8) = stg[j]; }
        if (ws2 == 0) {
            const size_t R = Rb + chunk_p(dir, n, lane);
            float g = GB[R * 16 + dir * 4 + h]; const float bt = GB[R * 16 + 8 + dir * 4 + h];
#pragma unroll
            for (int o = 1; o < 64; o <<= 1) { const float t = __int_as_float(__builtin_amdgcn_ds_bpermute(((lane - o) & 63) << 2, __float_as_int(g))); if (lane >= o) g += t; }
            const float gl = __int_as_float(__builtin_amdgcn_readlane(__float_as_int(g), 63));
            gcv[lane] = g; btv[lane] = bt; egv[lane] = __expf(g); dkv[lane] = __expf(gl - g);
            if (lane == 0) CHG[item] = __expf(gl);
        }
        __syncthreads();
        u32x2 qpa[4], qpb[4];
#pragma unroll
        for (int t = 0; t < 4; ++t) { const int pidx = t2 + 128 * t, lp = pidx & 63, q4 = lp >> 4, row = lp & 15, rs = pidx >> 6, rb = rs >> 1, s2 = rs & 1;
            const bf16_t* qp = Gq + (Rb + chunk_p(dir, n, 16 * rb + row)) * 256 + 64 * h + 32 * s2 + 4 * q4;
            qpa[t] = *(const u32x2*)qp; qpb[t] = *(const u32x2*)(qp + 16); }
        if (ws2 == 0) {
#pragma unroll
            for (int tI = 0; tI < 2; ++tI)
#pragma unroll
                for (int tJ = 0; tJ <= tI; ++tJ) {
                    f32x16 acc;
#pragma unroll
                    for (int i = 0; i < 16; ++i) acc[i] = 0.f;
#pragma unroll
                    for (int ks = 0; ks < 4; ++ks) {
                        const bf16x8 af = *(const LAS bf16x8*)(kvt + (32 * tI + r) * 128 + 16 * ks + 8 * h2);
                        const bf16x8 bf = *(const LAS bf16x8*)(kvt + (32 * tJ + r) * 128 + 16 * ks + 8 * h2);
                        acc = MFMA32(af, bf, acc);
                    }
                    const int j = 32 * tJ + r; const float gj = gcv[j];
                    LAS float* ab = Am + (4 * h2) * 64 + j; const LAS float* gb = gcv + 4 * h2; const int dj = 4 * h2 - j;
#pragma unroll
                    for (int i = 0; i < 16; ++i) { const int io = 32 * tI + (i & 3) + 8 * (i >> 2);
                        const float val = gb[64 + io] * acc[i] * __expf(fminf(gb[io] - gj, 0.f));
                        ab[io * 64] = (io + dj > 0) ? val : 0.f; }
                }
        } else {
#pragma unroll
            for (int tJ = 0; tJ < 2; ++tJ)
#pragma unroll
                for (int tI = 0; tI < 2; ++tI) {
                    f32x16 acc;
#pragma unroll
                    for (int i = 0; i < 16; ++i) acc[i] = 0.f;
                    if (tJ <= tI) {
#pragma unroll
                        for (int ks = 0; ks < 4; ++ks) {
                            const bf16x8 af = *(const LAS bf16x8*)(kvt + (32 * tJ + r) * 128 + 16 * ks + 8 * h2);
                            acc = MFMA32(af, qfr[tI][ks], acc);
                        }
                    }
                    const int i = 32 * tI + r; const float gi = gcv[i];
                    const LAS float* gb = gcv + 4 * h2; const int di = i - 4 * h2;
                    unsigned char* qkp = chp + CH_QK + 2 * img_idx(i, 4 * h2);
#pragma unroll
                    for (int g4 = 0; g4 < 4; ++g4) {
                        float v[4];
#pragma unroll
                        for (int e = 0; e < 4; ++e) { const int jo = 32 * tJ + 8 * g4 + e; const float val = acc[4 * g4 + e] * __expf(fminf(gi - gb[jo], 0.f)); v[e] = (di >= jo) ? val : 0.f; }
                        u32x2 o; o.x = cvt_pk(v[0], v[1]); o.y = cvt_pk(v[2], v[3]);
                        *(u32x2*)(qkp + (tJ * 64 + ((2 * g4) & 3) * 16) * 16 + 8 * (g4 >> 1)) = o;
                    }
                }
        }
        __syncthreads();
        {
#pragma unroll
            for (int t = 0; t < 4; ++t) {
                const int pidx = t2 + 128 * t, lp = pidx & 63, q4 = lp >> 4, row = lp & 15, rs = pidx >> 6, rb = rs >> 1, s2 = rs & 1;
                const int i = 16 * rb + row, kdA = 32 * s2 + 4 * q4;
                const u32x2 qa = qpa[t], qb = qpb[t];
                const float eg = egv[i];
                u32x4 o; o.x = cvt_pk(bf_lo(qa.x) * eg, bf_hi(qa.x) * eg); o.y = cvt_pk(bf_lo(qa.y) * eg, bf_hi(qa.y) * eg); o.z = cvt_pk(bf_lo(qb.x) * eg, bf_hi(qb.x) * eg); o.w = cvt_pk(bf_lo(qb.y) * eg, bf_hi(qb.y) * eg);
                *(u32x4*)(chp + CH_QD + pidx * 16) = o;
                const int kd = i, cA = kdA;
                float kv[8];
#pragma unroll
                for (int e = 0; e < 8; ++e) { const int cc = cA + 16 * (e >> 2) + (e & 3); kv[e] = bf2f(kvt[cc * 128 + kd]) * dkv[cc]; }
                o.x = cvt_pk(kv[0], kv[1]); o.y = cvt_pk(kv[2], kv[3]); o.z = cvt_pk(kv[4], kv[5]); o.w = cvt_pk(kv[6], kv[7]);
                *(u32x4*)(chp + CH_KDT + pidx * 16) = o;
            }
        }
        {
            const int c = t2; const bool isw = c < 64;
            float X[64];
#pragma unroll
            for (int i = 0; i < 64; ++i) { const float val = bf2f(kvt[i * 128 + c]); X[i] = val * btv[i] * (isw ? egv[i] : 1.f); }
            __syncthreads();
            f32x4 ra[2][16];
#pragma unroll
            for (int q = 0; q < 1; ++q) ra[1][q] = *(const LAS f32x4*)(Am + 1 * 64 + 4 * q);
#pragma unroll
            for (int i = 1; i < 64; ++i) {
                if (i + 1 < 64) {
#pragma unroll
                    for (int q = 0; q < (i + 4) / 4; ++q) ra[(i + 1) & 1][q] = *(const LAS f32x4*)(Am + (i + 1) * 64 + 4 * q);
                }
#pragma unroll
                for (int q = 0; q < (i + 3) / 4; ++q) asm volatile("" : "+v"(ra[i & 1][q]));
                float s0 = X[i], s1 = 0.f;
#pragma unroll
                for (int j = 0; j < i; ++j) { if (j & 1) s1 -= ra[i & 1][j >> 2][j & 3] * X[j]; else s0 -= ra[i & 1][j >> 2][j & 3] * X[j]; }
                X[i] = s0 + s1;
            }
#pragma unroll
            for (int i = 0; i < 64; ++i) kvt[i * 128 + c] = f2bf(X[i]);
        }
        __syncthreads();
        {
#pragma unroll
            for (int t = 0; t < 4; ++t) {
                const int pidx = t2 + 128 * t, lp = pidx & 63, q4 = lp >> 4, row = lp & 15, rs = pidx >> 6, rb = rs >> 1, s2 = rs & 1;
                const int i = 16 * rb + row, kdA = 32 * s2 + 4 * q4;
                const u32x2 wa = *(const LAS u32x2*)(kvt + i * 128 + kdA), wb = *(const LAS u32x2*)(kvt + i * 128 + kdA + 16);
                u32x4 o; o.x = wa.x ^ 0x80008000u; o.y = wa.y ^ 0x80008000u; o.z = wb.x ^ 0x80008000u; o.w = wb.y ^ 0x80008000u;
                *(u32x4*)(chp + CH_NW + pidx * 16) = o;
            }
#pragma unroll
            for (int t = 0; t < 2; ++t) {
                const int pidx = t2 + 128 * t, sl = pidx >> 6, lp = pidx & 63, q4 = lp >> 4, vcol = 64 + 16 * sl + (lp & 15);
                unsigned w[8];
#pragma unroll
                for (int e = 0; e < 8; ++e) { const int i0 = 16 * (e >> 1) + 4 * q4 + 2 * (e & 1); w[e] = (unsigned)kvt[i0 * 128 + vcol] | ((unsigned)kvt[(i0 + 1) * 128 + vcol] << 16); }
                *(u32x4*)(chp + CH_U + pidx * 32) = (u32x4){w[0], w[1], w[2], w[3]}; *(u32x4*)(chp + CH_U + pidx * 32 + 16) = (u32x4){w[4], w[5], w[6], w[7]};
            }
        }
    }
}

__device__ __forceinline__ void gdn_scan_phase(const Frame& F, int l) {
    constexpr bool do_finish = true;
    const int lane = F.lane, q = lane >> 4, dir = F.wave >> 2, sl = F.wave & 3;
    const float* CHG = (const float*)(F.ws + WS_CHG);
    bf16_t* Ob0 = ptile(F, T_DQ); bf16_t* Ob1 = ptile(F, T_DK);
    for (int bh = F.blk; bh < 64; bh += GRID) {
        const int b = bh >> 2, h = bh & 3;
        const int item0d0 = ((0 * 16 + b) * 4 + h) * 68, item0d1 = ((1 * 16 + b) * 4 + h) * 68;
        const int item0 = dir ? item0d1 : item0d0;
        f32x4 S[4];
#pragma unroll
        for (int kb = 0; kb < 4; ++kb) S[kb] = (f32x4){0.f, 0.f, 0.f, 0.f};
        __syncthreads();
#define GDN_ISSUE(n_) do { _Pragma("unroll") for (int i_ = 0; i_ < 8; ++i_) { const int pc_ = F.wave * 8 + i_, d_ = pc_ >> 5, off_ = (pc_ & 31) * 1024; \
                const unsigned char* src_ = F.ar + A_CH + (size_t)((d_ ? item0d1 : item0d0) + (n_)) * CH_ITEM + off_ + lane * 16; \
                __builtin_amdgcn_global_load_lds((const unsigned*)src_, (LAS unsigned*)(F.lds + ((n_) & 1) * 65536 + d_ * 32768 + off_), 16, 0, 0); } } while (0)
        GDN_ISSUE(0);
        bf16_t* Ob = dir ? Ob1 : Ob0;
        for (int n = 0; n < 68; ++n) {
            const unsigned char* chp = F.ar + A_CH + (size_t)(item0 + n) * CH_ITEM;
            const u32x4 u0 = *(const u32x4*)(chp + CH_U + (sl * 64 + lane) * 32), u1 = *(const u32x4*)(chp + CH_U + (sl * 64 + lane) * 32 + 16);
            const float gl = CHG[item0 + n];
            VM_WAIT();
            __syncthreads();
            if (n + 1 < 68) GDN_ISSUE(n + 1);
            const LAS unsigned char* base = F.lds + (n & 1) * 65536 + dir * 32768 + lane * 16;
#define FRAG(mat, rb, s) (*(const LAS bf16x8*)(base + (mat) + ((rb) * 2 + (s)) * 1024))
            bf16x8 bS[2], bV[2];
#pragma unroll
            for (int s = 0; s < 2; ++s) { u32x4 w; w.x = cvt_pk(S[2 * s][0], S[2 * s][1]); w.y = cvt_pk(S[2 * s][2], S[2 * s][3]); w.z = cvt_pk(S[2 * s + 1][0], S[2 * s + 1][1]); w.w = cvt_pk(S[2 * s + 1][2], S[2 * s + 1][3]); bS[s] = __builtin_bit_cast(bf16x8, w); }
            f32x4 vn[4];
            vn[0] = (f32x4){bf_lo(u0.x), bf_hi(u0.x), bf_lo(u0.y), bf_hi(u0.y)}; vn[1] = (f32x4){bf_lo(u0.z), bf_hi(u0.z), bf_lo(u0.w), bf_hi(u0.w)};
            vn[2] = (f32x4){bf_lo(u1.x), bf_hi(u1.x), bf_lo(u1.y), bf_hi(u1.y)}; vn[3] = (f32x4){bf_lo(u1.z), bf_hi(u1.z), bf_lo(u1.w), bf_hi(u1.w)};
#pragma unroll
            for (int rb = 0; rb < 4; ++rb)
#pragma unroll
                for (int s = 0; s < 2; ++s) vn[rb] = MFMA16(FRAG(CH_NW, rb, s), bS[s], vn[rb]);
#pragma unroll
            for (int s = 0; s < 2; ++s) { u32x4 w; w.x = cvt_pk(vn[2 * s][0], vn[2 * s][1]); w.y = cvt_pk(vn[2 * s][2], vn[2 * s][3]); w.z = cvt_pk(vn[2 * s + 1][0], vn[2 * s + 1][1]); w.w = cvt_pk(vn[2 * s + 1][2], vn[2 * s + 1][3]); bV[s] = __builtin_bit_cast(bf16x8, w); }
            f32x4 o[4];
#pragma unroll
            for (int rb = 0; rb < 4; ++rb) { o[rb] = (f32x4){0.f, 0.f, 0.f, 0.f};
#pragma unroll
                for (int s = 0; s < 2; ++s) { o[rb] = MFMA16(FRAG(CH_QD, rb, s), bS[s], o[rb]); o[rb] = MFMA16(FRAG(CH_QK, rb, s), bV[s], o[rb]); } }
#pragma unroll
            for (int kb = 0; kb < 4; ++kb) { S[kb] = S[kb] * gl;
#pragma unroll
                for (int s = 0; s < 2; ++s) S[kb] = MFMA16(FRAG(CH_KDT, kb, s), bV[s], S[kb]); }
#undef FRAG
#pragma unroll
            for (int rb = 0; rb < 4; ++rb)
#pragma unroll
                for (int e = 0; e < 4; ++e) { const int i = 16 * rb + 4 * q + e;
                    Ob[((size_t)b * TPB + chunk_p(dir, n, i)) * 256 + 64 * h + 16 * sl + (lane & 15)] = f2bf(o[rb][e]); }
        }
        VM_WAIT();
        __syncthreads();
        if (do_finish) {
            const int sub = F.tid >> 4, c = (F.tid & 15) * 4;
            const f32x4 og = *(const f32x4*)(F.in[I_GDOUTG] + l * 64 + c);
            for (int p0 = sub; p0 < TPB; p0 += 128) {
                u32x2 a0[4], a1[4], gw[4];
#pragma unroll
                for (int t = 0; t < 4; ++t) { const size_t off = ((size_t)b * TPB + p0 + 32 * t) * 256 + 64 * h + c;
                    a0[t] = *(const u32x2*)(Ob0 + off); a1[t] = *(const u32x2*)(Ob1 + off); gw[t] = *(const u32x2*)(ptile(F, T_DG) + off); }
#pragma unroll
                for (int t = 0; t < 4; ++t) { const size_t off = ((size_t)b * TPB + p0 + 32 * t) * 256 + 64 * h + c;
                    const float o0 = bf_lo(a0[t].x) + bf_lo(a1[t].x), o1 = bf_hi(a0[t].x) + bf_hi(a1[t].x), o2 = bf_lo(a0[t].y) + bf_lo(a1[t].y), o3 = bf_hi(a0[t].y) + bf_hi(a1[t].y);
                    const float ss = sum16((o0 * o0 + o1 * o1) + (o2 * o2 + o3 * o3));
                    const float rr = rsqrtf(ss * (1.f / 64.f) + EPS);
                    u32x2 w; w.x = cvt_pk(o0 * rr * og[0] * siluf_(bf_lo(gw[t].x)), o1 * rr * og[1] * siluf_(bf_hi(gw[t].x))); w.y = cvt_pk(o2 * rr * og[2] * siluf_(bf_lo(gw[t].y)), o3 * rr * og[3] * siluf_(bf_hi(gw[t].y)));
                    *(u32x2*)(ptile(F, T_DG) + off) = w; }
            }
        }
    }
}
constexpr int WRP = 1032;
constexpr int RT_WLO_OFF = 32 * WRP * 2;
constexpr int RT_REC_OFF = 2 * RT_WLO_OFF;
constexpr int RT_CNT_OFF = RT_REC_OFF + 288 * 4 * 4;
static_assert(RT_CNT_OFF + 256 <= MISC_OFF, "router LDS");

__device__ __forceinline__ void p_route1(const Frame& F, int l, int cl) {
    LAS bf16_t* whi = (LAS bf16_t*)F.lds; LAS bf16_t* wlo = (LAS bf16_t*)(F.lds + RT_WLO_OFF);
    LAS int* rec = (LAS int*)(F.lds + RT_REC_OFF); LAS int* lcnt = (LAS int*)(F.lds + RT_CNT_OFF); LAS int* lbase = lcnt + 32;
    __syncthreads();
    { const float* wr = F.in[I_WR] + (size_t)l * 1024 * 32;
      f32x4 t[16];
#pragma unroll
      for (int i = 0; i < 16; ++i) t[i] = *(const f32x4*)(wr + (size_t)(F.tid + 512 * i) * 4);
#pragma unroll
      for (int i = 0; i < 16; ++i) { const int i4 = F.tid + 512 * i, k = i4 >> 3, e0 = (i4 & 7) * 4;
#pragma unroll
          for (int j = 0; j < 4; ++j) { const bf16_t h = f2bf(t[i][j]); whi[(e0 + j) * WRP + k] = h; wlo[(e0 + j) * WRP + k] = f2bf(t[i][j] - bf2f(h)); } } }
    if (F.tid < 32) lcnt[F.tid] = 0;
    __syncthreads();
    const int g0 = (l == 0) ? (F.blk * 2176) >> 8 : F.blk * 8, g1 = (l == 0) ? ((F.blk + 1) * 2176) >> 8 : F.blk * 8 + 8, ngrp = g1 - g0;
    bf16_t* H2 = (bf16_t*)(F.ar + A_H2); unsigned char* H2f8 = F.ar + A_H2F8;
    const bf16_t* XB = (const bf16_t*)(F.ws + WS_XB);
    int* rowmap = (int*)(F.ws + WS_ROWMAP); float* selg = (float*)(F.ws + WS_SELG);
    for (int i = F.blk * 512 + F.tid; i < MAXROWS; i += GRID * 512) rowmap[i] = -1;
    const int lane = F.lane;
    const float* gn = F.in[I_N2G] + l * 1024;
    int mcur = -1; f32x4 A2[4], B2[4];
    for (int rl0 = F.wave * 4; rl0 < ngrp * 32; rl0 += 32) {
        u32x4 xv[4][2]; float ss[4]; int Rr[4], mir[4];
#pragma unroll
        for (int q = 0; q < 4; ++q) {
            const int gr = g0 * 32 + rl0 + q;
            const int R = (l == 0) ? gr : (gr >> 12) * TPB + CTXL + (gr & 4095);
            const int b = R / TPB, p = R - b * TPB; const bool isctx = p < CTXL; Rr[q] = R; mir[q] = isctx ? 16 : b;
#pragma unroll
            for (int c = 0; c < 2; ++c) xv[q][c] = *(const u32x4*)(XB + (size_t)R * 1024 + lane * 8 + 512 * c);
        }
#pragma unroll
        for (int q = 0; q < 4; ++q) { ss[q] = 0.f;
#pragma unroll
            for (int c = 0; c < 2; ++c) { f32x4 a0, a1; unpack8(xv[q][c], a0, a1); ss[q] += ((a0[0] * a0[0] + a0[1] * a0[1]) + (a0[2] * a0[2] + a0[3] * a0[3])) + ((a1[0] * a1[0] + a1[1] * a1[1]) + (a1[2] * a1[2] + a1[3] * a1[3])); } }
#pragma unroll
        for (int q = 0; q < 4; ++q) {
            const float rstd = rsqrtf(wave_sum(ss[q]) * (1.f / 1024.f) + EPS);
            const int R = Rr[q];
            if (mir[q] != mcur) { mcur = mir[q]; const float* sh = modv(F, l, mcur, 3); const float* sc = modv(F, l, mcur, 4);
#pragma unroll
                for (int c = 0; c < 2; ++c) { const int cc = lane * 8 + 512 * c;
                    A2[2 * c] = *(const f32x4*)(gn + cc) * (*(const f32x4*)(sc + cc) + 1.f); A2[2 * c + 1] = *(const f32x4*)(gn + cc + 4) * (*(const f32x4*)(sc + cc + 4) + 1.f);
                    B2[2 * c] = *(const f32x4*)(sh + cc); B2[2 * c + 1] = *(const f32x4*)(sh + cc + 4); } }
#pragma unroll
            for (int c = 0; c < 2; ++c) { const int cc = lane * 8 + 512 * c;
                f32x4 a0, a1; unpack8(xv[q][c], a0, a1);
                const f32x4 h0 = (a0 * rstd) * A2[2 * c] + B2[2 * c];
                const f32x4 h1 = (a1 * rstd) * A2[2 * c + 1] + B2[2 * c + 1];
                *(u32x4*)(H2 + (size_t)R * 1024 + cc) = pack8(h0, h1);
                int w0 = 0, w1 = 0; w0 = __builtin_amdgcn_cvt_pk_fp8_f32(h0[0], h0[1], w0, false); w0 = __builtin_amdgcn_cvt_pk_fp8_f32(h0[2], h0[3], w0, true);
                w1 = __builtin_amdgcn_cvt_pk_fp8_f32(h1[0], h1[1], w1, false); w1 = __builtin_amdgcn_cvt_pk_fp8_f32(h1[2], h1[3], w1, true);
                *(u32x2*)(H2f8 + (size_t)R * 1024 + cc) = (u32x2){(unsigned)w0, (unsigned)w1}; }
        }
    }
    VM_WAIT();
    __syncthreads();
    const int r = lane & 31, h2 = lane >> 5;
    for (int grp = F.wave; grp < ngrp; grp += 8) {
        const int gr = (g0 + grp) * 32 + r;
        const int R = (l == 0) ? gr : (gr >> 12) * TPB + CTXL + (gr & 4095);
        const bf16_t* bh = H2 + (size_t)R * 1024 + 8 * h2;
        const LAS bf16_t* ah = whi + r * WRP + 8 * h2; const LAS bf16_t* al = wlo + r * WRP + 8 * h2;
        f32x16 acc;
#pragma unroll
        for (int i = 0; i < 16; ++i) acc[i] = 0.f;
        bf16x8 xh[2][8];
#pragma unroll
        for (int j = 0; j < 8; ++j) { xh[0][j] = *(const bf16x8*)(bh + 16 * j); }
#pragma unroll
        for (int kc = 0; kc < 8; ++kc) {
            if (kc + 1 < 8) {
#pragma unroll
                for (int j = 0; j < 8; ++j) { xh[(kc + 1) & 1][j] = *(const bf16x8*)(bh + 16 * (8 * (kc + 1) + j)); }
            }
#pragma unroll
            for (int j = 0; j < 8; ++j) { asm volatile("" : "+v"(xh[kc & 1][j])); }
#pragma unroll
            for (int j = 0; j < 8; ++j) { const int ks = 8 * kc + j;
                const bf16x8 wh = *(const LAS bf16x8*)(ah + 16 * ks), wl = *(const LAS bf16x8*)(al + 16 * ks);
                acc = MFMA32(wh, xh[kc & 1][j], acc); acc = MFMA32(wl, xh[kc & 1][j], acc); }
        }
        float lg[32];
#pragma unroll
        for (int i = 0; i < 16; ++i) { const auto rr = __builtin_amdgcn_permlane32_swap(__float_as_uint(acc[i]), __float_as_uint(acc[i]), false, false);
            const int e = (i & 3) + 8 * (i >> 2); lg[e] = __uint_as_float(rr[0]) + F.in[I_BR][l * 32 + e]; lg[e + 4] = __uint_as_float(rr[1]) + F.in[I_BR][l * 32 + e + 4]; }
        if (lane < 32) {
            const int rl = grp * 32 + r;
            unsigned used = 0u; int se[4]; float sv[4];
#pragma unroll
            for (int k = 0; k < 4; ++k) {
                float best = -INFINITY; int bi = 0;
#pragma unroll
                for (int e = 0; e < 32; ++e) { const bool ok = !((used >> e) & 1u) && lg[e] > best; best = ok ? lg[e] : best; bi = ok ? e : bi; }
                used |= 1u << bi; se[k] = bi; sv[k] = best;
            }
            const float e1 = __expf(sv[1] - sv[0]), e2 = __expf(sv[2] - sv[0]), e3 = __expf(sv[3] - sv[0]); const float den = 1.f / (1.f + e1 + e2 + e3);
            *(f32x4*)(selg + (size_t)R * 4) = (f32x4){den, e1 * den, e2 * den, e3 * den};
#pragma unroll
            for (int k = 0; k < 4; ++k) { const int pos = __hip_atomic_fetch_add(lcnt + se[k], 1, __ATOMIC_RELAXED, __HIP_MEMORY_SCOPE_WORKGROUP); rec[rl * 4 + k] = (pos << 5) | se[k]; }
        }
    }
    __syncthreads();
    if (F.tid < 32) lbase[F.tid] = (int)atomicAdd((unsigned*)(F.ws + WS_CTL) + CW_GCNT + cl * 32 + F.tid, (unsigned)lcnt[F.tid]);
    __syncthreads();
    int* seli = (int*)(F.ws + WS_SELI);
    for (int idx = F.tid; idx < ngrp * 32 * 4; idx += 512) {
        const int rl = idx >> 2, k = idx & 3;
        const int gr = g0 * 32 + rl;
        const int R = (l == 0) ? gr : (gr >> 12) * TPB + CTXL + (gr & 4095);
        const int e = rec[idx] & 31, pos = rec[idx] >> 5;
        seli[(size_t)R * 4 + k] = ((lbase[e] + pos) << 5) | e;
    }
}

__device__ __forceinline__ int moe_tables(const Frame& F, int l) {
    LAS int* off = (LAS int*)(F.lds + MISC_OFF + 64); LAS int* texp = (LAS int*)(F.lds + MISC_OFF + 256);
    __syncthreads();
    if (F.tid == 0) { const unsigned* gc = (const unsigned*)(F.ws + WS_CTL) + CW_GCNT + l * 32; int o = 0;
        for (int e = 0; e < 32; ++e) { off[e] = o; o += (int)((__hip_atomic_load(gc + e, __ATOMIC_RELAXED, __HIP_MEMORY_SCOPE_AGENT) + 255u) & ~255u); } off[32] = o; }
    __syncthreads();
    const int nt = off[32] >> 8;
    for (int pm = F.tid; pm < nt; pm += 512) { int e = 0;
#pragma unroll
        for (int k = 1; k < 32; ++k) e += (off[k] <= pm * 256) ? 1 : 0;
        texp[pm] = e; }
    __syncthreads();
    return nt;
}

__device__ __forceinline__ void p_route2(const Frame& F, int l) {
    (void)moe_tables(F, l);
    const LAS int* off = (const LAS int*)(F.lds + MISC_OFF + 64);
    int* seli = (int*)(F.ws + WS_SELI); const float* selg = (const float*)(F.ws + WS_SELG);
    int* rowmap = (int*)(F.ws + WS_ROWMAP); float* gslot = (float*)(F.ws + WS_GSLOT);
    for (int idx = F.blk * 512 + F.tid; idx < NR * 4; idx += GRID * 512) {
        const int R = idx >> 2;
        if (l == 1 && (R % TPB) < CTXL) continue;
        const int s = seli[idx]; const int e = s & 31, dst = off[e] + (s >> 5);
        rowmap[dst] = idx; gslot[dst] = selg[idx]; seli[idx] = dst;
    }
}
constexpr int NPH = 24;

__global__ void __launch_bounds__(512, 2) mega(Args args) {
    extern __shared__ __attribute__((aligned(16))) unsigned char lds_raw[];
    Frame F;
    F.lds = (LAS unsigned char*)lds_raw;
    F.in = args.in; F.out = args.out; F.ws = args.ws; F.ar = args.ws + WS_ARENA;
    F.tid = threadIdx.x; F.lane = F.tid & 63; F.wave = __builtin_amdgcn_readfirstlane(F.tid >> 6); F.blk = blockIdx.x;
    if (F.tid < 64) ((LAS unsigned*)(F.lds + MISC_OFF))[F.tid] = 0u;
    __syncthreads();
    const int lo = args.ph_lo, hi = args.ph_hi;
    XcdBarrier bar; bar.bar = (unsigned*)(F.ws + WS_CTL) + CW_BAR; bar.x = 0; bar.st = (volatile LAS unsigned*)(F.lds + MISC_OFF);
    if (hi - lo > 1) bar = xcd_barrier_post((unsigned*)(F.ws + WS_CTL) + CW_BAR, (volatile LAS unsigned*)(F.lds + MISC_OFF));
#ifndef PH_MASK
#define PH_MASK 0x1fff
#endif
#define KON(kind) (((PH_MASK) >> (kind)) & 1)
#define IN(k) (lo <= (k) && (k) < hi)
#define SEAM(k) do { if (IN(k) && IN((k) + 1)) xcd_barrier(bar); } while (0)
#define FRESH(FF) Frame FF = F; { int ln_; asm volatile("v_mbcnt_lo_u32_b32 %0, -1, 0\n\tv_mbcnt_hi_u32_b32 %0, -1, %0" : "=v"(ln_)); int wv_ = F.wave, bk_ = F.blk; asm volatile("" : "+s"(wv_), "+s"(bk_)); FF.lane = ln_; FF.wave = wv_; FF.blk = bk_; FF.tid = wv_ * 64 + ln_; }

    if (KON(0) && IN(0)) { FRESH(FF); p_prologue(FF, args); }
    SEAM(0);
    for (int l = 0; l < 2; ++l) {
        const int pb = 1 + 11 * l;
        if (KON(1) && IN(pb + 0)) { FRESH(FF); if (l == 0) p_rowpass<0>(FF, 0); else p_rowpass<1>(FF, 1); }
        SEAM(pb + 0);
        if (KON(2) && IN(pb + 1)) { FRESH(FF);
            EpiTiles E{ptile(FF, 0), FF.in[I_BGATE] + l * 4096};
            {
                pg8::DenseOrder S;
                if (l == 0) S.init(NRT, T_GATE, GRID, FF.blk, false, FF.ar + A_H, (const bf16_t*)(FF.ws + WS_WIN) + (size_t)l * 7168 * 1024, 1024);
                else { S.init(256, T_GATE, GRID, FF.blk, true, FF.ar + A_H, (const bf16_t*)(FF.ws + WS_WIN) + (size_t)l * 7168 * 1024, 1024); S.nctx = 16 * 7; }
#if PROBE_REP & 512
                if ((FF.blk >> 3) & 1) { __builtin_amdgcn_s_sleep(127); __builtin_amdgcn_s_sleep(127); __builtin_amdgcn_s_sleep(127); }
#endif
                pg8::gemm_phase<EpiTiles, pg8::DenseOrder>(FF.lds, FF.tid, 1024, S, E);
#if PROBE_REP & 1
                pg8::gemm_phase<EpiTiles, pg8::DenseOrder>(FF.lds, FF.tid, 1024, S, E);
#endif
            }
        }
        SEAM(pb + 1);
        if (KON(3) && IN(pb + 2)) { FRESH(FF);
#if PROBE_REP & 64
            p_prep<false, true>(FF, l);
#endif
#if PROBE_REP & 128
            p_prep<true, false>(FF, l);
#endif
            p_prep(FF, l); }
        SEAM(pb + 2);
        if (KON(4) && IN(pb + 3)) { FRESH(FF);
#if PROBE_REP & 32
            for (int u = FF.blk; u < 16 * 34 * 4; u += GRID) { const int g = u & 3, bc = u >> 2, b = bc / 34, chunk = bc - b * 34; gmlp_unit(FF, l, b, chunk, g, (bf16_t*)(FF.ar + A_H + 3 * PT_BYTES)); }
#endif
            for (int u = FF.blk; u < 16 * 34 * 4; u += GRID) { const int g = u & 3, bc = u >> 2, b = bc / 34, chunk = bc - b * 34; gmlp_unit(FF, l, b, chunk, g); }
            gdn_chunk_phase(FF);
#if PROBE_REP & 16
            gdn_chunk_phase(FF);
#endif
        }
        SEAM(pb + 3);
        if (KON(5) && IN(pb + 4)) { FRESH(FF);
            gdn_scan_phase(FF, l);
            float lam; { float d1 = 0.f, d2 = 0.f; for (int i = 0; i < 32; ++i) { d1 += FF.in[I_LQ1][l * 32 + i] * FF.in[I_LK1][l * 32 + i]; d2 += FF.in[I_LQ2][l * 32 + i] * FF.in[I_LK2][l * 32 + i]; } lam = expf(d1) - expf(d2) + args.lam_init[l]; }
            const int nq = (l == 0) ? 17 : 16, nda = 8 * nq, nga = 4 * nq, xq = FF.blk & 7;
            volatile LAS int* qslot = (volatile LAS int*)(FF.lds + MISC_OFF + 32);
            unsigned* qctr = (unsigned*)(FF.ws + WS_CTL) + CW_AQ + (l * 8 + xq) * 64;
            bf16_t* oda = ptile(FF, T_AQ); bf16_t* oga = ptile(FF, T_GQ);
            for (;;) {
                __syncthreads();
                if (FF.tid == 0) *qslot = (int)__hip_atomic_fetch_add(qctr, 1u, __ATOMIC_RELAXED, __HIP_MEMORY_SCOPE_AGENT);
                __syncthreads();
                int u = *qslot;
                if (u >= nda + nga) break;
                if (u < nda) {
                    const int g = u / nq, qi = u - g * nq, bh = xq * 8 + g, b = bh >> 2, h = bh & 3, qt = (qi < 16) ? qi + 1 : 0;
                    attn_unit<32, 2, true>(FF, ptile(FF, T_AQ), 64 * h, ptile(FF, T_AK), 64 * h, ptile(FF, T_AV), 64 * h, oda, 64 * h, b, qt, lam, 1.f - args.lam_init[l], FF.in[I_DASUBG] + l * 64, FF.in[I_DAQG] + l * 32, 0.17677669529663687f * LOG2E * QSC, (const f32x2*)(FF.ws + WS_ROPE));
                } else {
                    u -= nda; const int g = u / nq, qi = u - g * nq, bk = xq * 4 + g, b = bk >> 1, kv = bk & 1, qt = (qi < 16) ? qi + 1 : 0;
                    attn_unit<64, 2, false>(FF, ptile(FF, T_GQ), 128 * kv, ptile(FF, T_GKV), 64 * kv, ptile(FF, T_GKV), 128 + 64 * kv, oga, 128 * kv, b, qt, 0.f, 1.f, nullptr, FF.in[I_GAQG] + l * 64, 0.125f * LOG2E * QSC, (const f32x2*)(FF.ws + WS_ROPE) + 512);
                }
            }
            __syncthreads();
            {
                EpiTiles E{ptile(FF, 0), FF.in[I_BGATE] + l * 4096};
                pg8::DenseOrderT<true> S; S.init((l == 0) ? NRT : 256, 16, GRID, FF.blk, l == 1, FF.ar + A_H8, FF.ws + WS_WG8 + (size_t)l * 4096 * 1024, 1024); S.pn_off = T_GATE;
                constexpr int NDYN = 3;
                const int rounds = S.nwg / GRID; S.imax = rounds - NDYN;
                unsigned* gq = (unsigned*)(FF.ws + WS_CTL) + CW_GQ + (l * 8 + (FF.blk & 7)) * 64;
                if (FF.tid == 0) *qslot = (int)__hip_atomic_fetch_add(gq, 1u, __ATOMIC_RELAXED, __HIP_MEMORY_SCOPE_AGENT);
                for (int it = 0;; ++it) {
                    pg8::gemm_phase<EpiTiles, pg8::DenseOrderT<true>>(FF.lds, FF.tid, 1024, S, E);
                    __syncthreads();
                    const int v = *qslot;
                    if (v >= NDYN * (GRID / 8)) break;
                    S.single = (rounds - NDYN) * GRID + 8 * v + (FF.blk & 7);
                    __syncthreads();
                    if (FF.tid == 0) *qslot = (int)__hip_atomic_fetch_add(gq, 1u, __ATOMIC_RELAXED, __HIP_MEMORY_SCOPE_AGENT);
                }
#if PROBE_REP & 2
                pg8::gemm_phase<EpiTiles, pg8::DenseOrderT<true>>(FF.lds, FF.tid, 1024, S, E);
#endif
            }
        }
        SEAM(pb + 4);
        if (KON(6) && IN(pb + 5)) { FRESH(FF);
            MergeOrder S; S.G = GRID; S.c = FF.blk; S.skipctx = (l == 1); S.ntile = (l == 1) ? 1024 : 1088; S.P = (const char*)(FF.ar + A_P); S.Wbr = (const char*)((const bf16_t*)(FF.ws + WS_WBR) + (size_t)l * 4 * 1024 * 256);
            EpiMerge E{ptile(FF, 0), (bf16_t*)(FF.ar + A_MERGED)};
            pg8::gemm_phase<EpiMerge, MergeOrder>(FF.lds, FF.tid, 256, S, E);
        }
        SEAM(pb + 5);
        if (KON(7) && IN(pb + 6)) { FRESH(FF);
            pg8::DenseOrder S; S.init((l == 1) ? 256 : NRT, 4, GRID, FF.blk, l == 1, FF.ar + A_MERGED, (const bf16_t*)(FF.ws + WS_WO) + (size_t)l * 1024 * 1024, 1024);
            EpiWo E{(l == 0) ? FF.in[I_X] : nullptr, FF.in[I_CTX], (bf16_t*)(FF.ws + WS_XB), (const float*)(FF.ws + WS_MOD) + (size_t)l * 17 * 6144, 2};
            pg8::gemm_phase<EpiWo, pg8::DenseOrder>(FF.lds, FF.tid, 1024, S, E);
        }
        SEAM(pb + 6);
#if PROBE_REP & 256
        if (KON(8) && IN(pb + 7)) { FRESH(FF); p_route1(FF, l, l + 2); }
#endif
        if (KON(8) && IN(pb + 7)) { FRESH(FF); p_route1(FF, l, l); }
        SEAM(pb + 7);
        if (KON(9) && IN(pb + 8)) { FRESH(FF); p_route2(FF, l); }
        SEAM(pb + 8);
        if (KON(10) && IN(pb + 9)) { FRESH(FF);
            const int nt = moe_tables(FF, l);
            MoeOrder<8, true> S; S.G = GRID; S.c = FF.blk; S.nunits = nt * 8; S.texp = (const LAS int*)(FF.lds + MISC_OFF + 256); S.A = (const char*)(FF.ar + A_H2F8); S.rowmap = (const int*)(FF.ws + WS_ROWMAP);
            S.W = (const char*)(FF.ws + WS_WUP) + (size_t)l * 32 * 2048 * 1024; S.wstride = (size_t)2048 * 1024;
            EpiUp E{FF.in[I_BUP] + (size_t)l * 32 * 2048, (unsigned char*)(FF.ar + A_ACT)};
            pg8::gemm_phase<EpiUp, MoeOrder<8, true>>(FF.lds, FF.tid, 1024, S, E);
#if PROBE_REP & 4
            pg8::gemm_phase<EpiUp, MoeOrder<8, true>>(FF.lds, FF.tid, 1024, S, E);
#endif
        }
        SEAM(pb + 9);
        if (KON(11) && IN(pb + 10)) { FRESH(FF);
            const int nt = moe_tables(FF, l);
            MoeOrder<4, false> S; S.G = GRID; S.c = FF.blk; S.nunits = nt * 4; S.texp = (const LAS int*)(FF.lds + MISC_OFF + 256); S.A = (const char*)(FF.ar + A_ACT); S.rowmap = nullptr;
            S.W = (const char*)(FF.ws + WS_WDN) + (size_t)l * 32 * 1024 * 1024; S.wstride = (size_t)1024 * 1024;
            EpiDown E{FF.in[I_BDN] + (size_t)l * 32 * 1024, (const float*)(FF.ws + WS_GSLOT), FF.ar + A_YBUF};
            pg8::gemm_phase<EpiDown, MoeOrder<4, false>>(FF.lds, FF.tid, 1024, S, E);
#if PROBE_REP & 8
            pg8::gemm_phase<EpiDown, MoeOrder<4, false>>(FF.lds, FF.tid, 1024, S, E);
#endif
        }
        SEAM(pb + 10);
    }
    if (KON(12) && IN(23)) { FRESH(FF); p_rowpass<2>(FF, 2); }
#undef IN
#undef SEAM
}

extern "C" void kernel_launch(void* const* d_in, const int* in_sizes, int n_in, void* d_out, int out_size, void* d_ws, size_t ws_size, hipStream_t stream) {
    static int grid = 0;
    if (grid == 0) {
        if (n_in != 34 || out_size != NB * SEQ * D || ws_size < WS_NEED) { fprintf(stderr, "kernel_launch: unexpected shapes (n_in %d out %d ws %zu need %zu)\n", n_in, out_size, ws_size, (size_t)WS_NEED); grid = -1; return; }
        int dev = 0, cus = 0;
        if (hipGetDevice(&dev) != hipSuccess || hipDeviceGetAttribute(&cus, hipDeviceAttributeMultiprocessorCount, dev) != hipSuccess) { grid = -1; return; }
        if (hipFuncSetAttribute((const void*)mega, hipFuncAttributeMaxDynamicSharedMemorySize, LDS_BYTES) != hipSuccess) { fprintf(stderr, "kernel_launch: hipFuncSetAttribute failed\n"); grid = -1; return; }
        int per_cu = 0;
        (void)hipOccupancyMaxActiveBlocksPerMultiprocessor(&per_cu, (const void*)mega, 512, LDS_BYTES);
        (void)hipGetLastError();
        if (cus != 256 || per_cu < 1) { fprintf(stderr, "kernel_launch: needs 256 CUs with one resident workgroup each (cus %d, per_cu %d)\n", cus, per_cu); grid = -1; return; }
        grid = GRID;
    }
    if (grid < 0) return;
    (void)hipMemsetAsync((char*)d_ws + WS_CTL, 0, CTL_BYTES, stream);
    Args a;
    memset(&a, 0, sizeof(a));
    for (int i = 0; i < 34; ++i) a.in[i] = (const float*)d_in[i];
    a.out = (float*)d_out; a.ws = (unsigned char*)d_ws;
    for (int i = 0; i < 8; ++i) a.inv32[i] = (float)pow(10000.0, -(double)i / 8.0);
    for (int i = 0; i < 16; ++i) a.inv64[i] = (float)pow(10000.0, -(double)i / 16.0);
    for (int l = 0; l < 2; ++l) a.lam_init[l] = (float)(0.8 - 0.6 * exp(-0.3 * (double)l));
    a.ph_lo = 0; a.ph_hi = NPH;
    hipLaunchKernelGGL(mega, dim3(grid), dim3(512), LDS_BYTES, stream, a);
}
```
